# Optimizing an MI355X kernel written in HIP

```python
import math
import jax, jax.numpy as jnp
from jax import lax
import numpy as np

D_MODEL = 1024
BATCH = 8
SEQ = 2048
DEPTH = 1

PLE_DIM = 256
GRID_W = 64
H_DIFF = 4
DH_DIFF = 64
DV_DIFF = 2 * DH_DIFF
H_NA = 8
DH_NA = 64
WIN_R = 8
WIN_C = 16
N_BUCKETS = 32
MAX_DIST = 128
Q_BLOCK = 128
W_A = H_DIFF * DV_DIFF
W_B = H_NA * DH_NA
D_MIX = W_A + W_B
SPLITS = (
    2 * H_DIFF * DH_DIFF,
    2 * H_DIFF * DH_DIFF,
    W_A,
    W_A,
    W_B,
    W_B,
    W_B,
    W_B,
)
D_IN = sum(SPLITS)
EPS = 1e-6
NEG = -1e30

kernel_name = "hybrid_diffattn_natten_encoder_layer"


def rms_norm(x, g):
    xf = x.astype(jnp.float32)
    y = xf * lax.rsqrt(jnp.mean(xf * xf, axis=-1, keepdims=True) + EPS)
    return (y * g.astype(jnp.float32)).astype(x.dtype)


def t5_bucket(rel):
    half = N_BUCKETS // 2
    max_exact = half // 2
    ret = jnp.where(rel > 0, half, 0)
    n = jnp.abs(rel)
    nf = jnp.maximum(n, 1).astype(jnp.float32)
    large = max_exact + (jnp.log(nf / max_exact) / math.log(MAX_DIST / max_exact)
                         * (half - max_exact)).astype(jnp.int32)
    large = jnp.minimum(large, half - 1)
    return ret + jnp.where(n < max_exact, n, large)


def diff_attention(q1, q2, k1, k2, v, lam, t5_bias):
    B, H, S, dh = q1.shape
    nb = S // Q_BLOCK
    scale = dh ** -0.5
    q1b = q1.reshape(B, H, nb, Q_BLOCK, dh).transpose(2, 0, 1, 3, 4)
    q2b = q2.reshape(B, H, nb, Q_BLOCK, dh).transpose(2, 0, 1, 3, 4)
    kpos = jnp.arange(S)

    def block(args):
        qa, qc, start = args
        qpos = start + jnp.arange(Q_BLOCK)
        bias = t5_bias[t5_bucket(kpos[None, :] - qpos[:, None])]
        bias = bias.transpose(2, 0, 1).astype(jnp.float32)[None]
        s1 = jnp.einsum('bhqd,bhkd->bhqk', qa, k1).astype(jnp.float32) * scale + bias
        s2 = jnp.einsum('bhqd,bhkd->bhqk', qc, k2).astype(jnp.float32) * scale + bias
        a = jax.nn.softmax(s1, axis=-1) - lam * jax.nn.softmax(s2, axis=-1)
        return jnp.einsum('bhqk,bhkd->bhqd', a.astype(v.dtype), v)

    out = lax.map(block, (q1b, q2b, jnp.arange(nb) * Q_BLOCK))
    return out.transpose(1, 2, 0, 3, 4).reshape(B, H, S, v.shape[-1])


def neighbourhood_attention(q, k, v, rpb):
    B, S, H, d = q.shape
    R = S // GRID_W
    kr = min(WIN_R, R)
    to_grid = lambda t: t.reshape(B, R, GRID_W, H, d).transpose(0, 3, 1, 2, 4)
    qg, kgrid, vgrid = to_grid(q), to_grid(k), to_grid(v)
    rows = jnp.arange(R)
    rs = jnp.clip(rows - kr // 2, 0, R - kr)
    rows_idx = rs[:, None] + jnp.arange(kr)
    kg = kgrid[:, :, rows_idx]
    vg = vgrid[:, :, rows_idx]
    cols = jnp.arange(GRID_W)
    cs = jnp.clip(cols - WIN_C // 2, 0, GRID_W - WIN_C)
    valid = (cols[None, :] >= cs[:, None]) & (cols[None, :] < cs[:, None] + WIN_C)
    dr = rows_idx - rows[:, None] + (WIN_R - 1)
    dc = jnp.clip(cols[None, :] - cols[:, None], -(WIN_C - 1), WIN_C - 1) + (WIN_C - 1)
    bias = rpb[:, dr][..., dc]
    bias = bias.transpose(0, 1, 3, 2, 4).astype(jnp.float32)
    s = jnp.einsum('bhrcd,bhrikd->bhrcik', qg, kg).astype(jnp.float32) * (d ** -0.5) + bias[None]
    s = jnp.where(valid[:, None, :], s, NEG)
    pr = jax.nn.softmax(s.reshape(B, H, R, GRID_W, kr * GRID_W), axis=-1)
    pr = pr.reshape(B, H, R, GRID_W, kr, GRID_W)
    o = jnp.einsum('bhrcik,bhrikd->bhrcd', pr.astype(v.dtype), vg)
    return o.transpose(0, 2, 3, 1, 4).reshape(B, S, H * d)


def setup_inputs(seed: int = 0) -> dict:
    key = jax.random.key(seed)
    ks = jax.random.split(key, 20)
    nrm = lambda k, shape, s: jax.random.normal(k, shape, jnp.float32) * s
    return {
        "x": nrm(ks[0], (BATCH, SEQ, D_MODEL), 1.0),
        "p": nrm(ks[1], (DEPTH, BATCH, SEQ, PLE_DIM), 1.0),
        "norm_g": 1.0 + nrm(ks[2], (DEPTH, D_MODEL), 0.02),
        "w_in": nrm(ks[3], (DEPTH, D_MODEL, D_IN), D_MODEL ** -0.5),
        "w_out": nrm(ks[4], (DEPTH, D_MIX, D_MODEL), D_MIX ** -0.5),
        "q_norm_a": 1.0 + nrm(ks[5], (DEPTH, DH_DIFF), 0.02),
        "k_norm_a": 1.0 + nrm(ks[6], (DEPTH, DH_DIFF), 0.02),
        "lam_q1": nrm(ks[7], (DEPTH, DH_DIFF), 0.1),
        "lam_k1": nrm(ks[8], (DEPTH, DH_DIFF), 0.1),
        "lam_q2": nrm(ks[9], (DEPTH, DH_DIFF), 0.1),
        "lam_k2": nrm(ks[10], (DEPTH, DH_DIFF), 0.1),
        "subln_g": 1.0 + nrm(ks[11], (DEPTH, DV_DIFF), 0.02),
        "t5_bias": nrm(ks[12], (N_BUCKETS, H_DIFF), 0.5),
        "q_norm_b": 1.0 + nrm(ks[13], (DEPTH, DH_NA), 0.02),
        "k_norm_b": 1.0 + nrm(ks[14], (DEPTH, DH_NA), 0.02),
        "na_rpb": nrm(ks[15], (DEPTH, H_NA, 2 * WIN_R - 1, 2 * WIN_C - 1), 0.5),
        "w_ple_gate": nrm(ks[16], (DEPTH, D_MODEL, D_MODEL), D_MODEL ** -0.5),
        "w_ple_proj": nrm(ks[17], (DEPTH, PLE_DIM, D_MODEL), 0.5 * PLE_DIM ** -0.5),
    }


def reference(x, p, norm_g, w_in, w_out, q_norm_a, k_norm_a, lam_q1, lam_k1,
              lam_q2, lam_k2, subln_g, t5_bias, q_norm_b, k_norm_b, na_rpb,
              w_ple_gate, w_ple_proj):
    B, S, _ = x.shape
    cuts = list(np.cumsum(SPLITS)[:-1])
    for i in range(DEPTH):
        xn = rms_norm(x, norm_g[i])
        proj = jnp.einsum('bsd,de->bse', xn, w_in[i])
        qa, ka, va, za, qb, kb, vb, zb = jnp.split(proj, cuts, axis=-1)

        qa = rms_norm(qa.reshape(B, S, H_DIFF, 2, DH_DIFF), q_norm_a[i])
        ka = rms_norm(ka.reshape(B, S, H_DIFF, 2, DH_DIFF), k_norm_a[i])
        q1 = qa[..., 0, :].transpose(0, 2, 1, 3)
        q2 = qa[..., 1, :].transpose(0, 2, 1, 3)
        k1 = ka[..., 0, :].transpose(0, 2, 1, 3)
        k2 = ka[..., 1, :].transpose(0, 2, 1, 3)
        va_h = va.reshape(B, S, H_DIFF, DV_DIFF).transpose(0, 2, 1, 3)
        lam_init = 0.8 - 0.6 * math.exp(-0.3 * i)
        lam = (jnp.exp(jnp.sum(lam_q1[i].astype(jnp.float32) * lam_k1[i].astype(jnp.float32)))
               - jnp.exp(jnp.sum(lam_q2[i].astype(jnp.float32) * lam_k2[i].astype(jnp.float32)))
               + lam_init)
        oa = diff_attention(q1, q2, k1, k2, va_h, lam, t5_bias)
        oa = rms_norm(oa, subln_g[i]) * (1.0 - lam_init)
        ya = oa.transpose(0, 2, 1, 3).reshape(B, S, W_A) * jax.nn.silu(za)

        qb = rms_norm(qb.reshape(B, S, H_NA, DH_NA), q_norm_b[i])
        kb = rms_norm(kb.reshape(B, S, H_NA, DH_NA), k_norm_b[i])
        vb = vb.reshape(B, S, H_NA, DH_NA)
        yb = neighbourhood_attention(qb, kb, vb, na_rpb[i]) * jax.nn.silu(zb)

        y = jnp.einsum('bse,ed->bsd', jnp.concatenate([ya, yb], axis=-1), w_out[i])
        x = x + y

        gate = jax.nn.sigmoid(jnp.einsum('bsd,de->bse', x, w_ple_gate[i]))
        x = x + gate * jnp.einsum('bsp,pd->bsd', p[i], w_ple_proj[i])
    return x
```

```cpp
#include <hip/hip_runtime.h>
#include <hip/hip_bf16.h>
#include <cstdio>
#include <cstdint>
typedef __hip_bfloat16 bf16;
constexpr int NB = 8, S = 2048, D = 1024, M = NB * S, DIN = 4096, PLE = 256;
constexpr float EPS = 1e-6f;

__device__ __forceinline__ float tof(float v) { return v; }
__device__ __forceinline__ float tof(bf16 v) { return __bfloat162float(v); }

__global__ __launch_bounds__(256) void k_rmsnorm(const float* __restrict__ x, const float* __restrict__ g, float* __restrict__ y) {
  const int row = blockIdx.x * 4 + (threadIdx.x >> 6), lane = threadIdx.x & 63;
  const float* xr = x + (size_t)row * D;
  float v[16]; float s = 0.f;
#pragma unroll
  for (int j = 0; j < 16; ++j) { v[j] = xr[lane + 64 * j]; s += v[j] * v[j]; }
#pragma unroll
  for (int o = 32; o; o >>= 1) s += __shfl_xor(s, o);
  const float r = rsqrtf(s / D + EPS);
#pragma unroll
  for (int j = 0; j < 16; ++j) y[(size_t)row * D + lane + 64 * j] = v[j] * r * g[lane + 64 * j];
}

template <typename TA, int MODE>
__global__ __launch_bounds__(256) void k_gemm(const TA* __restrict__ A, int lda, const float* __restrict__ Bm, int ldb, float* __restrict__ C, int ldc, int K,
                                              const float* __restrict__ R, const float* __restrict__ PP) {
  __shared__ float As[16][64];
  __shared__ float Bs[16][64];
  const int tx = threadIdx.x & 15, ty = threadIdx.x >> 4;
  const int m0 = blockIdx.y * 64, n0 = blockIdx.x * 64;
  float acc[4][4];
#pragma unroll
  for (int i = 0; i < 4; ++i)
#pragma unroll
    for (int j = 0; j < 4; ++j) acc[i][j] = 0.f;
  for (int k0 = 0; k0 < K; k0 += 16) {
#pragma unroll
    for (int t = 0; t < 4; ++t) { const int i = threadIdx.x + 256 * t; const int m = i >> 4, k = i & 15; As[k][m] = tof(A[(size_t)(m0 + m) * lda + k0 + k]); }
#pragma unroll
    for (int t = 0; t < 4; ++t) { const int i = threadIdx.x + 256 * t; const int k = i >> 6, n = i & 63; Bs[k][n] = Bm[(size_t)(k0 + k) * ldb + n0 + n]; }
    __syncthreads();
#pragma unroll
    for (int k = 0; k < 16; ++k) {
      float a[4], b[4];
#pragma unroll
      for (int i = 0; i < 4; ++i) a[i] = As[k][ty * 4 + i];
#pragma unroll
      for (int j = 0; j < 4; ++j) b[j] = Bs[k][tx * 4 + j];
#pragma unroll
      for (int i = 0; i < 4; ++i)
#pragma unroll
        for (int j = 0; j < 4; ++j) acc[i][j] += a[i] * b[j];
    }
    __syncthreads();
  }
#pragma unroll
  for (int i = 0; i < 4; ++i)
#pragma unroll
    for (int j = 0; j < 4; ++j) {
      const size_t o = (size_t)(m0 + ty * 4 + i) * ldc + n0 + tx * 4 + j;
      float v = acc[i][j];
      if (MODE == 1) v += R[o];
      if (MODE == 2) v = R[o] + (1.f / (1.f + __expf(-v))) * PP[o];
      C[o] = v;
    }
}

__global__ __launch_bounds__(256) void k_post(const float* __restrict__ tmp, bf16* __restrict__ out, int type, const float* __restrict__ g) {
  const int t = blockIdx.x * 256 + threadIdx.x;
  const int row = t >> 3, grp = t & 7;
  const float* p = tmp + (size_t)row * 512 + grp * 64;
  bf16* o = out + (size_t)row * 512 + grp * 64;
  if (type == 0) {
    float s = 0.f;
    for (int d = 0; d < 64; ++d) s += p[d] * p[d];
    const float r = rsqrtf(s / 64.f + EPS);
    for (int d = 0; d < 64; ++d) o[d] = __float2bfloat16(p[d] * r * g[d]);
  } else if (type == 1) {
    for (int d = 0; d < 64; ++d) o[d] = __float2bfloat16(p[d]);
  } else {
    for (int d = 0; d < 64; ++d) { const float v = p[d]; o[d] = __float2bfloat16(v / (1.f + __expf(-v))); }
  }
}

__device__ __forceinline__ int t5_bucket(int rel) {
  int ret = rel > 0 ? 16 : 0;
  int n = rel < 0 ? -rel : rel;
  int v;
  if (n < 8) v = n;
  else { float nf = (float)n; int large = 8 + (int)(logf(nf / 8.f) / 2.772588722239781f * 8.f); v = large < 15 ? large : 15; }
  return ret + v;
}
__device__ __forceinline__ float wsum(float v) {
#pragma unroll
  for (int o = 32; o; o >>= 1) v += __shfl_xor(v, o);
  return v;
}
__device__ __forceinline__ float wmax(float v) {
#pragma unroll
  for (int o = 32; o; o >>= 1) v = fmaxf(v, __shfl_xor(v, o));
  return v;
}

__global__ __launch_bounds__(128) void k_diffattn(const bf16* __restrict__ QA, const bf16* __restrict__ KA, const bf16* __restrict__ VA, const bf16* __restrict__ ZA,
                                                  const float* __restrict__ t5, const float* __restrict__ lq1, const float* __restrict__ lk1, const float* __restrict__ lq2,
                                                  const float* __restrict__ lk2, const float* __restrict__ subg, bf16* __restrict__ CAT) {
  __shared__ float a_s[2][2048];
  __shared__ float b_s[2][2048];
  __shared__ float q_s[2][128];
  const int w = threadIdx.x >> 6, lane = threadIdx.x & 63;
  const int task = blockIdx.x * 2 + w;
  const int q = task % S, h = (task / S) % 4, b = task / (S * 4);
  const float lam = __expf(wsum(lq1[lane] * lk1[lane])) - __expf(wsum(lq2[lane] * lk2[lane])) + 0.2f;
  const size_t tok = (size_t)b * S + q;
  q_s[w][lane] = tof(QA[tok * 512 + h * 128 + lane]);
  q_s[w][64 + lane] = tof(QA[tok * 512 + h * 128 + 64 + lane]);
  __syncthreads();
  float m1 = -1e30f, m2 = -1e30f;
  for (int i = 0; i < 32; ++i) {
    const int k = lane + 64 * i;
    const bf16* kr = KA + ((size_t)b * S + k) * 512 + h * 128;
    float d1 = 0.f, d2 = 0.f;
    for (int d = 0; d < 64; ++d) { d1 += q_s[w][d] * tof(kr[d]); d2 += q_s[w][64 + d] * tof(kr[64 + d]); }
    const float bias = t5[t5_bucket(k - q) * 4 + h];
    d1 = d1 * 0.125f + bias; d2 = d2 * 0.125f + bias;
    a_s[w][k] = d1; b_s[w][k] = d2;
    m1 = fmaxf(m1, d1); m2 = fmaxf(m2, d2);
  }
  m1 = wmax(m1); m2 = wmax(m2);
  float l1 = 0.f, l2 = 0.f;
  for (int i = 0; i < 32; ++i) {
    const int k = lane + 64 * i;
    const float e1 = __expf(a_s[w][k] - m1); a_s[w][k] = e1; l1 += e1;
    const float e2 = __expf(b_s[w][k] - m2); b_s[w][k] = e2; l2 += e2;
  }
  l1 = wsum(l1); l2 = wsum(l2);
  const float i1 = 1.f / l1, i2 = lam / l2;
  for (int i = 0; i < 32; ++i) { const int k = lane + 64 * i; a_s[w][k] = a_s[w][k] * i1 - b_s[w][k] * i2; }
  __syncthreads();
  float o0 = 0.f, o1 = 0.f;
  const bf16* vb = VA + (size_t)b * S * 512 + h * 128;
  for (int k = 0; k < S; ++k) { const float a = a_s[w][k]; o0 += a * tof(vb[(size_t)k * 512 + lane]); o1 += a * tof(vb[(size_t)k * 512 + 64 + lane]); }
  const float ss = wsum(o0 * o0 + o1 * o1);
  const float r = rsqrtf(ss / 128.f + EPS) * 0.8f;
  const float y0 = o0 * r * subg[lane] * tof(ZA[tok * 512 + h * 128 + lane]);
  const float y1 = o1 * r * subg[64 + lane] * tof(ZA[tok * 512 + h * 128 + 64 + lane]);
  CAT[tok * 1024 + h * 128 + lane] = __float2bfloat16(y0);
  CAT[tok * 1024 + h * 128 + 64 + lane] = __float2bfloat16(y1);
}

__global__ __launch_bounds__(256) void k_na(const bf16* __restrict__ QB, const bf16* __restrict__ KB, const bf16* __restrict__ VB, const bf16* __restrict__ ZB,
                                            const float* __restrict__ rpb, bf16* __restrict__ CAT) {
  __shared__ float q_s[4][64];
  const int w = threadIdx.x >> 6, lane = threadIdx.x & 63;
  const int task = blockIdx.x * 4 + w;
  const int h = task & 7, tokl = task >> 3;
  const int b = tokl / S, s = tokl % S, r = s >> 6, c = s & 63;
  const int rs = min(max(r - 4, 0), 24), cs = min(max(c - 8, 0), 48);
  q_s[w][lane] = tof(QB[(size_t)tokl * 512 + h * 64 + lane]);
  __syncthreads();
  float sc[2]; int ktok[2];
#pragma unroll
  for (int t = 0; t < 2; ++t) {
    const int idx = lane + 64 * t, i = idx >> 4, j = idx & 15;
    const int krow = rs + i, kcol = cs + j;
    ktok[t] = b * S + krow * 64 + kcol;
    const bf16* kr = KB + (size_t)ktok[t] * 512 + h * 64;
    float d = 0.f;
    for (int e = 0; e < 64; ++e) d += q_s[w][e] * tof(kr[e]);
    int dc = kcol - c; dc = min(max(dc, -15), 15) + 15;
    sc[t] = d * 0.125f + rpb[(h * 15 + (krow - r + 7)) * 31 + dc];
  }
  const float mx = wmax(fmaxf(sc[0], sc[1]));
  const float p0 = __expf(sc[0] - mx), p1 = __expf(sc[1] - mx);
  const float l = wsum(p0 + p1);
  float o = 0.f;
  for (int idx = 0; idx < 128; ++idx) {
    const float p = __shfl(idx < 64 ? p0 : p1, idx & 63);
    const int kt = __shfl(idx < 64 ? ktok[0] : ktok[1], idx & 63);
    o += p * tof(VB[(size_t)kt * 512 + h * 64 + lane]);
  }
  const float y = o / l * tof(ZB[(size_t)tokl * 512 + h * 64 + lane]);
  CAT[(size_t)tokl * 1024 + 512 + h * 64 + lane] = __float2bfloat16(y);
}

extern "C" void kernel_launch(void* const* d_in, const int* in_sizes, int n_in, void* d_out, int out_size, void* d_ws, size_t ws_size, hipStream_t stream) {
  const float* x = (const float*)d_in[0]; const float* p = (const float*)d_in[1]; const float* norm_g = (const float*)d_in[2];
  const float* w_in = (const float*)d_in[3]; const float* w_out = (const float*)d_in[4];
  const float* q_norm_a = (const float*)d_in[5]; const float* k_norm_a = (const float*)d_in[6];
  const float* lq1 = (const float*)d_in[7]; const float* lk1 = (const float*)d_in[8]; const float* lq2 = (const float*)d_in[9]; const float* lk2 = (const float*)d_in[10];
  const float* subg = (const float*)d_in[11]; const float* t5 = (const float*)d_in[12];
  const float* q_norm_b = (const float*)d_in[13]; const float* k_norm_b = (const float*)d_in[14]; const float* rpb = (const float*)d_in[15];
  const float* w_gate = (const float*)d_in[16]; const float* w_proj = (const float*)d_in[17];
  float* out = (float*)d_out;
  char* ws = (char*)d_ws;
  const size_t MiB = 1u << 20;
  float* XN = (float*)(ws);
  float* TMP = (float*)(ws + 64 * MiB);
  bf16* BUF = (bf16*)(ws + 96 * MiB);
  bf16* CAT = (bf16*)(ws + 224 * MiB);
  float* X1 = XN; float* PPf = (float*)(ws + 96 * MiB);
  k_rmsnorm<<<M / 4, 256, 0, stream>>>(x, norm_g, XN);
  for (int s8 = 0; s8 < 8; ++s8) {
    k_gemm<float, 0><<<dim3(512 / 64, M / 64), 256, 0, stream>>>(XN, D, w_in + s8 * 512, DIN, TMP, 512, D, nullptr, nullptr);
    int type = 1; const float* g = nullptr;
    if (s8 == 0) { type = 0; g = q_norm_a; } else if (s8 == 1) { type = 0; g = k_norm_a; } else if (s8 == 4) { type = 0; g = q_norm_b; } else if (s8 == 5) { type = 0; g = k_norm_b; }
    else if (s8 == 3 || s8 == 7) type = 2;
    k_post<<<M * 8 / 256, 256, 0, stream>>>(TMP, BUF + (size_t)s8 * M * 512, type, g);
  }
  const size_t BS = (size_t)M * 512;
  k_diffattn<<<NB * 4 * S / 2, 128, 0, stream>>>(BUF, BUF + BS, BUF + 2 * BS, BUF + 3 * BS, t5, lq1, lk1, lq2, lk2, subg, CAT);
  k_na<<<M * 8 / 4, 256, 0, stream>>>(BUF + 4 * BS, BUF + 5 * BS, BUF + 6 * BS, BUF + 7 * BS, rpb, CAT);
  k_gemm<bf16, 1><<<dim3(D / 64, M / 64), 256, 0, stream>>>(CAT, D, w_out, D, X1, D, D, x, nullptr);
  k_gemm<float, 0><<<dim3(D / 64, M / 64), 256, 0, stream>>>(p, PLE, w_proj, D, PPf, D, PLE, nullptr, nullptr);
  k_gemm<float, 2><<<dim3(D / 64, M / 64), 256, 0, stream>>>(X1, D, w_gate, D, out, D, D, X1, PPf);
}
```

```cpp
#include <hip/hip_runtime.h>
#include <hip/hip_bf16.h>
#include <cstdio>
#include <cstdint>
#define MK_N_LAUNCHES 1
#if defined(MK_NAIVE_ATTN)
#if (MK_NAIVE_ATTN & 1)
#define MK_SKIP_DA
#endif
#if (MK_NAIVE_ATTN & 2)
#define MK_SKIP_NA
#endif
#endif
namespace pg8 {
#define PG8_LAS __attribute__((address_space(3)))
typedef unsigned short bf16_t;
typedef short bf16x8 __attribute__((ext_vector_type(8)));
typedef float f32x4 __attribute__((ext_vector_type(4)));
typedef unsigned u32x4 __attribute__((ext_vector_type(4)));
constexpr int BM = 256, BK = 64, HALF = 128, HTB = HALF * BK * 2  , STAGE_BYTES = 8 * HTB, NXCD = 8, WGM = 8;

__host__ __device__ __forceinline__ int lds_byte(int r, int c) { const int st = (r >> 4) * 2 + (c >> 5), rr = r & 15, cc = c & 31, ob = rr * 64 + cc * 2; return st * 1024 + (ob ^ (((ob >> 9) & 1) << 5)); }
__host__ __device__ __forceinline__ void stage_rc(int b, int& R, int& C) { const int st = b / 1024, sb = b % 1024, swz = sb ^ (((sb >> 9) & 1) << 5); R = (st >> 1) * 16 + swz / 64; C = (st & 1) * 32 + (swz % 64) / 2; }
__host__ __device__ __forceinline__ int perm32(int rho) { const int n = rho >> 4, i = rho & 15; return 8 * (i >> 2) + 4 * n + (i & 3); }

struct Unit { int pm, pn; };
struct Gemm { const bf16_t* A; const bf16_t* Bt; int M, N, K; };

struct StaticOrder {
    int nM, nN, nwg, G, c;
    __host__ __device__ void init(int M, int N, int G_, int c_) { nM = M / BM; nN = N / BM; nwg = nM * nN; G = G_; c = c_; }
    __host__ __device__ bool next(int i, Unit& u) const {
        const long L = (long)i * G + c; if (L >= nwg) return false;
        int wgid = (int)L; { const int q = nwg / NXCD, r = nwg % NXCD, xcd = wgid % NXCD, off = wgid / NXCD; wgid = (xcd < r ? xcd * (q + 1) : r * (q + 1) + (xcd - r) * q) + off; }
        const int nig = WGM * nN, gid = wgid / nig, fm = gid * WGM, gsz = (nM - fm) < WGM ? (nM - fm) : WGM;
        u.pm = fm + ((wgid % nig) % gsz); u.pn = (wgid % nig) / gsz; return true;
    }
    __device__ __forceinline__ void a_ready(const Unit&) const {}
    __device__ __forceinline__ void done(const Unit&) const {}
};

__device__ __forceinline__ unsigned cvt_pk_bf16(float lo, float hi) { unsigned r; asm volatile("v_cvt_pk_bf16_f32 %0, %1, %2" : "=v"(r) : "v"(lo), "v"(hi)); return r; }
__device__ __forceinline__ float sigmoidf_fast(float v) { return __builtin_amdgcn_rcpf(1.0f + __builtin_amdgcn_exp2f(-1.4426950408889634f * v)); }
constexpr int M_ROWS = 16384;

struct EpiBf16Plain {
    static constexpr bool PERM = true, AFTER_DRAIN = false;
    bf16_t* O; int ldc;
    __device__ __forceinline__ void operator()(const f32x4 (&acc)[2][2][4][2], const Unit& u, int wr, int wc, int fr, int fq) const {
        const int row0 = u.pm * BM + wr * 64 + fr, col0 = u.pn * BM + wc * 32 + 8 * fq;
#pragma unroll
        for (int ai = 0; ai < 2; ++ai)
#pragma unroll
            for (int m = 0; m < 4; ++m) { bf16_t* rowp = O + (size_t)(row0 + ai * HALF + m * 16) * ldc + col0;
#pragma unroll
                for (int bj = 0; bj < 2; ++bj) { const f32x4 v0 = acc[ai][bj][m][0], v1 = acc[ai][bj][m][1];
                    u32x4 w; w.x = cvt_pk_bf16(v0[0], v0[1]); w.y = cvt_pk_bf16(v0[2], v0[3]); w.z = cvt_pk_bf16(v1[0], v1[1]); w.w = cvt_pk_bf16(v1[2], v1[3]);
                    *(u32x4*)(rowp + bj * HALF) = w; } }
    }
};

struct EpiProj {
    static constexpr bool PERM = true, AFTER_DRAIN = false;
    bf16_t* buf;
    const float* gains;
    __device__ __forceinline__ void operator()(const f32x4 (&acc)[2][2][4][2], const Unit& u, int wr, int wc, int fr, int fq) const {
        const int type = u.pn >> 1, half = u.pn & 1;
        bf16_t* base = buf + (size_t)type * ((size_t)M_ROWS * 512);
        const int row0 = u.pm * BM + wr * 64 + fr;
        const int lc0 = half * 256 + 64 * wc + 8 * fq;
        if (type == 0 || type == 1 || type == 4 || type == 5) {
            const float* g = gains + ((type & 1) + (type >> 2) * 2) * 64;
#pragma unroll
            for (int ai = 0; ai < 2; ++ai)
#pragma unroll
                for (int m = 0; m < 4; ++m) {
                    float ss = 0.f;
#pragma unroll
                    for (int bj = 0; bj < 2; ++bj)
#pragma unroll
                        for (int n = 0; n < 2; ++n) { const f32x4 x = acc[ai][bj][m][n]; ss += (x[0] * x[0] + x[1] * x[1]) + (x[2] * x[2] + x[3] * x[3]); }
                    ss += __shfl_xor(ss, 16); ss += __shfl_xor(ss, 32);
                    const float rs = rsqrtf(ss * (1.0f / 64.0f) + 1e-6f);
                    bf16_t* rowp = base + (size_t)(row0 + ai * HALF + m * 16) * 512 + lc0;
#pragma unroll
                    for (int bj = 0; bj < 2; ++bj) {
                        const f32x4 g0 = *(const f32x4*)(g + 32 * bj + 8 * fq), g1 = *(const f32x4*)(g + 32 * bj + 8 * fq + 4);
                        const f32x4 v0 = acc[ai][bj][m][0] * rs * g0, v1 = acc[ai][bj][m][1] * rs * g1;
                        u32x4 w; w.x = cvt_pk_bf16(v0[0], v0[1]); w.y = cvt_pk_bf16(v0[2], v0[3]); w.z = cvt_pk_bf16(v1[0], v1[1]); w.w = cvt_pk_bf16(v1[2], v1[3]);
                        *(u32x4*)(rowp + 32 * bj) = w; }
                    asm volatile("" ::: "memory");
                }
        } else {
            const bool act = (type == 3 || type == 7);
#pragma unroll
            for (int ai = 0; ai < 2; ++ai)
#pragma unroll
                for (int m = 0; m < 4; ++m) { bf16_t* rowp = base + (size_t)(row0 + ai * HALF + m * 16) * 512 + lc0;
#pragma unroll
                    for (int bj = 0; bj < 2; ++bj) { f32x4 v0 = acc[ai][bj][m][0], v1 = acc[ai][bj][m][1];
                        if (act) {
#pragma unroll
                            for (int e = 0; e < 4; ++e) { v0[e] = v0[e] * sigmoidf_fast(v0[e]); v1[e] = v1[e] * sigmoidf_fast(v1[e]); } }
                        u32x4 w; w.x = cvt_pk_bf16(v0[0], v0[1]); w.y = cvt_pk_bf16(v0[2], v0[3]); w.z = cvt_pk_bf16(v1[0], v1[1]); w.w = cvt_pk_bf16(v1[2], v1[3]);
                        *(u32x4*)(rowp + 32 * bj) = w; } }
        }
    }
};

struct EpiX1 {
    static constexpr bool PERM = true, AFTER_DRAIN = false;
    const float* x; float* x1; bf16_t* x1b;
    __device__ __forceinline__ void operator()(const f32x4 (&acc)[2][2][4][2], const Unit& u, int wr, int wc, int fr, int fq) const {
        const int row0 = u.pm * BM + wr * 64 + fr, col0 = u.pn * BM + wc * 32 + 8 * fq;
#pragma unroll
        for (int ai = 0; ai < 2; ++ai)
#pragma unroll
            for (int m = 0; m < 4; ++m) { const size_t off = (size_t)(row0 + ai * HALF + m * 16) * 1024 + col0;
#pragma unroll
                for (int bj = 0; bj < 2; ++bj) { const size_t o = off + bj * HALF;
                    const f32x4 v0 = acc[ai][bj][m][0] + *(const f32x4*)(x + o), v1 = acc[ai][bj][m][1] + *(const f32x4*)(x + o + 4);
                    *(f32x4*)(x1 + o) = v0; *(f32x4*)(x1 + o + 4) = v1;
                    u32x4 w; w.x = cvt_pk_bf16(v0[0], v0[1]); w.y = cvt_pk_bf16(v0[2], v0[3]); w.z = cvt_pk_bf16(v1[0], v1[1]); w.w = cvt_pk_bf16(v1[2], v1[3]);
                    *(u32x4*)(x1b + o) = w; } }
    }
};

struct EpiFinal {
    static constexpr bool PERM = true, AFTER_DRAIN = false;
    float* out; const bf16_t* pp;
    __device__ __forceinline__ void operator()(const f32x4 (&acc)[2][2][4][2], const Unit& u, int wr, int wc, int fr, int fq) const {
        const int row0 = u.pm * BM + wr * 64 + fr, col0 = u.pn * BM + wc * 32 + 8 * fq;
#pragma unroll
        for (int ai = 0; ai < 2; ++ai)
#pragma unroll
            for (int m = 0; m < 4; ++m) { const size_t off = (size_t)(row0 + ai * HALF + m * 16) * 1024 + col0;
#pragma unroll
                for (int bj = 0; bj < 2; ++bj) { const size_t o = off + bj * HALF;
                    const u32x4 pw = *(const u32x4*)(pp + o);
                    f32x4 p0, p1;
                    p0[0] = __uint_as_float(pw.x << 16); p0[1] = __uint_as_float(pw.x & 0xffff0000u); p0[2] = __uint_as_float(pw.y << 16); p0[3] = __uint_as_float(pw.y & 0xffff0000u);
                    p1[0] = __uint_as_float(pw.z << 16); p1[1] = __uint_as_float(pw.z & 0xffff0000u); p1[2] = __uint_as_float(pw.w << 16); p1[3] = __uint_as_float(pw.w & 0xffff0000u);
                    f32x4 v0 = *(const f32x4*)(out + o), v1 = *(const f32x4*)(out + o + 4);
                    const f32x4 a0 = acc[ai][bj][m][0], a1 = acc[ai][bj][m][1];
#pragma unroll
                    for (int e = 0; e < 4; ++e) { v0[e] += sigmoidf_fast(a0[e]) * p0[e]; v1[e] += sigmoidf_fast(a1[e]) * p1[e]; }
                    *(f32x4*)(out + o) = v0; *(f32x4*)(out + o + 4) = v1; } }
    }
};

template <class Epi, class Sched, bool ALIGN_EPI = false, bool SP2 = false>
__device__ __forceinline__ void gemm_phase(PG8_LAS unsigned char* lds, const Gemm g, const Sched& S, const Epi& E) {
    const int tid = threadIdx.x, wid = __builtin_amdgcn_readfirstlane(tid >> 6), lane = tid & 63, wr = wid >> 2, wc = wid & 3, fr = lane & 15, fq = lane >> 4;
    const int K = g.K, nt = K / BK;
    unsigned voffA[2], voffB[2];
#pragma unroll
    for (int i = 0; i < 2; ++i) { int R, C; stage_rc(tid * 16 + i * 8192, R, C); const int Rb = Epi::PERM ? ((R & ~31) + perm32(R & 31)) : R;
        voffA[i] = (unsigned)(R * K + C) * 2u; voffB[i] = (unsigned)(Rb * K + C) * 2u; }
    const size_t kstep = (size_t)(BK * 2);
    const size_t hstep = (size_t)HALF * K * 2;
    const size_t tstep = 2 * hstep;
    const unsigned ldsw = (unsigned)wid * 1024u;
    const int aoff = lds_byte(wr * 64 + fr, fq * 8), boff = lds_byte(wc * 32 + fr, fq * 8);
#define PG8_SA(b, h) (((b) * 2 + (h)) * HTB)
#define PG8_SB(b, h) ((4 + (b) * 2 + (h)) * HTB)
#define PG8_STAGE(bufoff, gbase, voff) do { _Pragma("unroll") for (int _i = 0; _i < 2; ++_i) \
        __builtin_amdgcn_global_load_lds((const unsigned*)((const char*)(gbase) + (voff)[_i]), (PG8_LAS unsigned*)(lds + (bufoff) + ldsw + _i * 8192), 16, 0, 0); } while (0)
#define PG8_LDA(dst, b, h) do { _Pragma("unroll") for (int m = 0; m < 4; ++m) _Pragma("unroll") for (int k = 0; k < 2; ++k) dst[m][k] = *(const PG8_LAS bf16x8*)(lds + PG8_SA(b, h) + aoff + m * 2048 + k * 1024); } while (0)
#define PG8_LDB(dst, b, h) do { _Pragma("unroll") for (int n = 0; n < 2; ++n) _Pragma("unroll") for (int k = 0; k < 2; ++k) dst[n][k] = *(const PG8_LAS bf16x8*)(lds + PG8_SB(b, h) + boff + n * 2048 + k * 1024); } while (0)
#define PG8_MMA(ai, bj, At, Bt) do { __builtin_amdgcn_s_setprio(1); _Pragma("unroll") for (int m = 0; m < 4; ++m) _Pragma("unroll") for (int n = 0; n < 2; ++n) _Pragma("unroll") for (int k = 0; k < 2; ++k) \
        acc[ai][bj][m][n] = __builtin_amdgcn_mfma_f32_16x16x32_bf16(Bt[n][k], At[m][k], acc[ai][bj][m][n], 0, 0, 0); __builtin_amdgcn_s_setprio(0); } while (0)
#define PG8_WAIT_V(n) asm volatile("s_waitcnt vmcnt(" #n ")" ::: "memory")
#define PG8_WAIT_L(n) asm volatile("s_waitcnt lgkmcnt(" #n ")" ::: "memory")
#define PG8_BAR __builtin_amdgcn_s_barrier()
#define PG8_SCHED __builtin_amdgcn_sched_barrier(0)
    Unit cur, nxt; int ui = 0;
    if (!S.next(0, cur)) return;
    f32x4 acc[2][2][4][2];
#pragma unroll
    for (int a = 0; a < 2; ++a)
#pragma unroll
        for (int b = 0; b < 2; ++b)
#pragma unroll
            for (int m = 0; m < 4; ++m)
#pragma unroll
                for (int n = 0; n < 2; ++n) acc[a][b][m][n] = (f32x4){0.f, 0.f, 0.f, 0.f};
    bf16x8 At[4][2], B0[2][2], B1[2][2];
    const char* cA = (const char*)g.A + (size_t)cur.pm * tstep; const char* cB = (const char*)g.Bt + (size_t)cur.pn * tstep;
    S.a_ready(cur);
    if constexpr (SP2) {
        PG8_STAGE(PG8_SB(0, 0), cB, voffB); PG8_STAGE(PG8_SB(0, 1), cB + hstep, voffB); PG8_STAGE(PG8_SA(0, 0), cA, voffA); PG8_STAGE(PG8_SA(0, 1), cA + hstep, voffA);
        if (wr == 1) PG8_BAR;
        PG8_WAIT_V(2); PG8_BAR;
        PG8_STAGE(PG8_SB(1, 0), cB + kstep, voffB); PG8_STAGE(PG8_SA(1, 0), cA + kstep, voffA); PG8_STAGE(PG8_SB(1, 1), cB + hstep + kstep, voffB);
        PG8_WAIT_V(6); PG8_BAR;
    } else {
        PG8_STAGE(PG8_SB(0, 0), cB, voffB); PG8_STAGE(PG8_SA(0, 0), cA, voffA); PG8_STAGE(PG8_SB(0, 1), cB + hstep, voffB); PG8_STAGE(PG8_SA(0, 1), cA + hstep, voffA);
        if (wr == 1) PG8_BAR;
        PG8_WAIT_V(4); PG8_BAR;
        PG8_STAGE(PG8_SB(1, 0), cB + kstep, voffB); PG8_STAGE(PG8_SA(1, 0), cA + kstep, voffA); PG8_STAGE(PG8_SB(1, 1), cB + hstep + kstep, voffB);
        PG8_WAIT_V(6); PG8_BAR;
    }
    for (;;) {
        const bool has_next = S.next(ui + 1, nxt);
        const char* nA = has_next ? (const char*)g.A + (size_t)nxt.pm * tstep : cA; const char* nB = has_next ? (const char*)g.Bt + (size_t)nxt.pn * tstep : cB;
        for (int t = 0; t < nt; t += 2) {
            const bool last = (t == nt - 2);
            const char* a1 = cA + (size_t)(t + 1) * kstep;
            const char* a2 = last ? nA : cA + (size_t)(t + 2) * kstep; const char* b2 = last ? nB : cB + (size_t)(t + 2) * kstep;
            const char* a3 = a2 + kstep; const char* b3 = b2 + kstep;
            if (last && has_next) S.a_ready(nxt);
            if constexpr (SP2) {
            PG8_LDB(B0, 0, 0); PG8_LDB(B1, 0, 1); PG8_SCHED; PG8_LDA(At, 0, 0); PG8_STAGE(PG8_SA(1, 1), a1 + hstep, voffA);
            PG8_WAIT_V(8); PG8_WAIT_L(0); PG8_BAR; PG8_MMA(0, 0, At, B0); PG8_MMA(0, 1, At, B1); PG8_BAR; PG8_SCHED;
            PG8_LDA(At, 0, 1); PG8_STAGE(PG8_SB(0, 0), b2, voffB); PG8_STAGE(PG8_SB(0, 1), b2 + hstep, voffB); PG8_STAGE(PG8_SA(0, 0), a2, voffA);
            PG8_WAIT_V(8); PG8_WAIT_L(0); PG8_BAR; PG8_MMA(1, 0, At, B0); PG8_MMA(1, 1, At, B1); PG8_BAR; PG8_SCHED;
            PG8_LDB(B0, 1, 0); PG8_LDB(B1, 1, 1); PG8_SCHED; PG8_LDA(At, 1, 0); PG8_STAGE(PG8_SA(0, 1), a2 + hstep, voffA);
            PG8_WAIT_V(8); PG8_WAIT_L(0); PG8_BAR; PG8_MMA(0, 0, At, B0); PG8_MMA(0, 1, At, B1); PG8_BAR; PG8_SCHED;
            PG8_LDA(At, 1, 1); PG8_STAGE(PG8_SB(1, 0), b3, voffB); PG8_STAGE(PG8_SB(1, 1), b3 + hstep, voffB); PG8_STAGE(PG8_SA(1, 0), a3, voffA);
            PG8_WAIT_V(8); PG8_WAIT_L(0); PG8_BAR; PG8_MMA(1, 0, At, B0); PG8_MMA(1, 1, At, B1); PG8_BAR; PG8_SCHED;
            } else {
            PG8_LDB(B0, 0, 0); PG8_SCHED; PG8_LDA(At, 0, 0); PG8_STAGE(PG8_SA(1, 1), a1 + hstep, voffA);
            PG8_WAIT_L(8); PG8_BAR; PG8_WAIT_L(0); PG8_MMA(0, 0, At, B0); PG8_BAR; PG8_SCHED;
            PG8_LDB(B1, 0, 1); PG8_STAGE(PG8_SB(0, 0), b2, voffB);
            PG8_BAR; PG8_WAIT_L(0); PG8_MMA(0, 1, At, B1); PG8_BAR;
            PG8_LDA(At, 0, 1); PG8_STAGE(PG8_SA(0, 0), a2, voffA);
            PG8_BAR; PG8_WAIT_L(0); PG8_MMA(1, 0, At, B0); PG8_BAR; PG8_SCHED;
            PG8_STAGE(PG8_SB(0, 1), b2 + hstep, voffB);
            PG8_WAIT_V(6); PG8_BAR; PG8_MMA(1, 1, At, B1); PG8_BAR;
            PG8_LDB(B0, 1, 0); PG8_SCHED; PG8_LDA(At, 1, 0); PG8_STAGE(PG8_SA(0, 1), a2 + hstep, voffA);
            PG8_WAIT_L(8); PG8_BAR; PG8_WAIT_L(0); PG8_MMA(0, 0, At, B0); PG8_BAR; PG8_SCHED;
            PG8_LDB(B1, 1, 1); PG8_STAGE(PG8_SB(1, 0), b3, voffB);
            PG8_BAR; PG8_WAIT_L(0); PG8_MMA(0, 1, At, B1); PG8_BAR;
            PG8_LDA(At, 1, 1); PG8_STAGE(PG8_SA(1, 0), a3, voffA);
            PG8_BAR; PG8_WAIT_L(0); PG8_MMA(1, 0, At, B0); PG8_BAR; PG8_SCHED;
            PG8_STAGE(PG8_SB(1, 1), b3 + hstep, voffB);
            PG8_WAIT_V(6); PG8_BAR; PG8_MMA(1, 1, At, B1); PG8_BAR;
            }
        }
        if constexpr (ALIGN_EPI) { if (wr == 0) PG8_BAR; }
        if constexpr (!Epi::AFTER_DRAIN) { E(acc, cur, wr, wc, fr, fq); S.done(cur); }
        if (!has_next) break;
#pragma unroll
        for (int a = 0; a < 2; ++a)
#pragma unroll
            for (int b = 0; b < 2; ++b)
#pragma unroll
                for (int m = 0; m < 4; ++m)
#pragma unroll
                    for (int n = 0; n < 2; ++n) acc[a][b][m][n] = (f32x4){0.f, 0.f, 0.f, 0.f};
        cur = nxt; cA = nA; cB = nB; ++ui;
        if constexpr (ALIGN_EPI) { if (wr == 1) PG8_BAR; }
    }
    PG8_WAIT_V(0);
    if constexpr (!ALIGN_EPI) { if (wr == 0) PG8_BAR; }
    PG8_BAR;
    if constexpr (Epi::AFTER_DRAIN) { E.fused(acc, cur, wr, wc, fr, fq, lds, wid, lane); S.done(cur); }
#undef PG8_SA
#undef PG8_SB
#undef PG8_STAGE
#undef PG8_LDA
#undef PG8_LDB
#undef PG8_MMA
#undef PG8_WAIT_V
#undef PG8_WAIT_L
#undef PG8_BAR
#undef PG8_SCHED
}
}
namespace da {
using bf16x8 = __attribute__((ext_vector_type(8))) short;
using s16x4  = __attribute__((ext_vector_type(4))) short;
using f32x16 = __attribute__((ext_vector_type(16))) float;
using f32x4  = __attribute__((ext_vector_type(4))) float;
using u32x4  = __attribute__((ext_vector_type(4))) unsigned;
typedef unsigned short bf16_t;
constexpr int SEQ = 2048, QROWS = 128, KVBLK = 64, NT = SEQ / KVBLK;
constexpr int SHM_V = 16384, SHM_K = 16384;
constexpr int LDS_V = 0, LDS_K = 2 * SHM_V, LDS_OST = 0, OSTRIDE = 132, LDS_TBL = 69632, LDS_WS = 71680, LDS_END = LDS_WS + 8 * 128;
constexpr float LOG2E = 1.4426950408889634f;
#define DA_KSWZ(row, colB) ((row) * 256 + ((colB) ^ (((row) & 7) << 4)))
#define DA_SBAR() __builtin_amdgcn_sched_barrier(0)
__device__ __forceinline__ int crow(int r, int hi) { return (r & 3) + 8 * (r >> 2) + 4 * hi; }
__device__ __forceinline__ unsigned cvtpk(float lo, float hi) { unsigned r; asm volatile("v_cvt_pk_bf16_f32 %0, %1, %2" : "=v"(r) : "v"(lo), "v"(hi)); return r; }
__device__ __forceinline__ float bf2f(unsigned short v) { return __uint_as_float(((unsigned)v) << 16); }
__device__ __forceinline__ int t5_bucket(int rel) {
    const int ret = rel > 0 ? 16 : 0; const int n = rel < 0 ? -rel : rel;
    int v;
    if (n < 8) v = n; else { const int l2 = 31 - __builtin_clz((unsigned)(n * n)); v = 8 + (l2 - 6); v = v < 15 ? v : 15; }
    return ret + v;
}
__device__ __forceinline__ void qkt(f32x16& p0, f32x16& p1, const char* Ks, const bf16x8* qr, int r32, int hi, int mapB, float c) {
#pragma unroll
    for (int r = 0; r < 16; ++r) { p0[r] = c; p1[r] = c; }
#pragma unroll
    for (int d0 = 0; d0 < 4; ++d0) { const int cb = mapB + (d0 * 16 + hi * 8) * 2;
        const bf16x8 b0 = *reinterpret_cast<const bf16x8*>(Ks + DA_KSWZ(r32, cb));
        const bf16x8 b1 = *reinterpret_cast<const bf16x8*>(Ks + DA_KSWZ(32 + r32, cb));
        p0 = __builtin_amdgcn_mfma_f32_32x32x16_bf16(b0, qr[d0], p0, 0, 0, 0);
        p1 = __builtin_amdgcn_mfma_f32_32x32x16_bf16(b1, qr[d0], p1, 0, 0, 0); }
}
__device__ __forceinline__ void addbias(f32x16& p0, f32x16& p1, const float* tbl, int tb) {
#pragma unroll
    for (int r = 0; r < 16; ++r) { p0[r] += tbl[tb + (r & 3) + 8 * (r >> 2)]; p1[r] += tbl[tb + 32 + (r & 3) + 8 * (r >> 2)]; }
}
__device__ __forceinline__ void exp_half(f32x16& p) {
#pragma unroll
    for (int r = 0; r < 16; ++r) p[r] = __builtin_amdgcn_exp2f(p[r]);
}
__device__ __forceinline__ void finishSM(f32x16& p0, f32x16& p1, float& l_reg, bf16x8& pa0, bf16x8& pa1, bf16x8& pa2, bf16x8& pa3) {
    exp_half(p1);
    float ps = 0.f;
#pragma unroll
    for (int r = 0; r < 16; ++r) ps += p0[r];
#pragma unroll
    for (int r = 0; r < 16; ++r) ps += p1[r];
    l_reg += ps;
#define DA_PK4(P, BASE, OUT) do { unsigned a0 = cvtpk(P[BASE + 0], P[BASE + 1]), a1 = cvtpk(P[BASE + 2], P[BASE + 3]);   \
    unsigned b0 = cvtpk(P[BASE + 4], P[BASE + 5]), b1 = cvtpk(P[BASE + 6], P[BASE + 7]);                              \
    auto r0 = __builtin_amdgcn_permlane32_swap(a0, b0, false, false); auto r1 = __builtin_amdgcn_permlane32_swap(a1, b1, false, false); \
    u32x4 w = {r0[0], r1[0], r0[1], r1[1]}; OUT = *reinterpret_cast<bf16x8*>(&w); } while (0)
    DA_PK4(p0, 0, pa0); DA_PK4(p0, 8, pa1); DA_PK4(p1, 0, pa2); DA_PK4(p1, 8, pa3);
#undef DA_PK4
}
__device__ __forceinline__ int v_st(int k, int c) { const int kk = (k & ~0xC) | ((k & 4) << 1) | ((k & 8) >> 1); return ((kk >> 3) * 4 + (c >> 5)) * 512 + ((kk & 7) * 32 + (c & 31)) * 2; }
__device__ __forceinline__ int v_rd_base(int lane) { return ((lane & 3) << 3) | (((lane >> 2) & 3) << 6) | (((lane >> 4) & 1) << 5) | (((lane >> 5) & 1) << 8); }
constexpr int v_rd_off(int d0, int ks, int half) { return d0 * 512 + ks * 4096 + half * 2048; }
template <int OFF> __device__ __forceinline__ s16x4 tr_read(int vb) {
    s16x4 r; asm volatile("ds_read_b64_tr_b16 %0, %1 offset:%2" : "=&v"(r) : "v"(vb), "i"(OFF) : "memory"); return r;
}
template <int D0> __device__ __forceinline__ void pv_one(f32x16& od, int vb, bf16x8 pa0, bf16x8 pa1, bf16x8 pa2, bf16x8 pa3) {
    const s16x4 l0 = tr_read<v_rd_off(D0, 0, 0)>(vb), h0 = tr_read<v_rd_off(D0, 0, 1)>(vb), l1 = tr_read<v_rd_off(D0, 1, 0)>(vb), h1 = tr_read<v_rd_off(D0, 1, 1)>(vb);
    const s16x4 l2 = tr_read<v_rd_off(D0, 2, 0)>(vb), h2 = tr_read<v_rd_off(D0, 2, 1)>(vb), l3 = tr_read<v_rd_off(D0, 3, 0)>(vb), h3 = tr_read<v_rd_off(D0, 3, 1)>(vb);
    asm volatile("s_waitcnt lgkmcnt(0)" ::: "memory"); DA_SBAR();
#define DA_PK(L, H) (bf16x8){L[0], L[1], L[2], L[3], H[0], H[1], H[2], H[3]}
    od = __builtin_amdgcn_mfma_f32_32x32x16_bf16(pa0, DA_PK(l0, h0), od, 0, 0, 0);
    od = __builtin_amdgcn_mfma_f32_32x32x16_bf16(pa1, DA_PK(l1, h1), od, 0, 0, 0);
    od = __builtin_amdgcn_mfma_f32_32x32x16_bf16(pa2, DA_PK(l2, h2), od, 0, 0, 0);
    od = __builtin_amdgcn_mfma_f32_32x32x16_bf16(pa3, DA_PK(l3, h3), od, 0, 0, 0);
#undef DA_PK
}
__device__ __forceinline__ void pv_d0(f32x16* o, int vb, bf16x8 pa0, bf16x8 pa1, bf16x8 pa2, bf16x8 pa3) {
    pv_one<0>(o[0], vb, pa0, pa1, pa2, pa3); pv_one<1>(o[1], vb, pa0, pa1, pa2, pa3); pv_one<2>(o[2], vb, pa0, pa1, pa2, pa3); pv_one<3>(o[3], vb, pa0, pa1, pa2, pa3);
}

struct Params {
    const bf16_t* QA; const bf16_t* KA; const bf16_t* VA; const bf16_t* ZA;
    const float* sc;
    const float* tblg;
    const float* subg;
    bf16_t* CAT;
};

__device__ __forceinline__ float wave_sum(float v) {
#pragma unroll
    for (int o = 1; o < 64; o <<= 1) v += __shfl_xor(v, o);
    return v;
}
__device__ __forceinline__ float wave_max(float v) {
#pragma unroll
    for (int o = 1; o < 64; o <<= 1) v = fmaxf(v, __shfl_xor(v, o));
    return v;
}

__device__ __forceinline__ void unit(const Params& P, int b, int h, int qb, char* lds) {
    int tid_ = threadIdx.x; asm volatile("" : "+v"(tid_));
    const int tid = tid_, lane = tid & 63, r32 = lane & 31, hi = lane >> 5;
    const int wid = __builtin_amdgcn_readfirstlane(tid >> 6), map = wid >> 2, wq = wid & 3;
    char* V_lds = lds + LDS_V; char* K_lds = lds + LDS_K;
    float* tbl = (float*)(lds + LDS_TBL); float* li_l = (float*)(lds + LDS_WS) + wid * 32;
    const int Q0 = qb * QROWS;
    const size_t tok0 = (size_t)b * SEQ;
    const float lam = P.sc[0], MB = P.sc[4 + h], cL = P.sc[8 + h], cR = P.sc[12 + h], cN = -MB;
    tbl[tid] = P.tblg[h * 512 + tid];
    bf16x8 qr[4];
    { const bf16_t* Qw = P.QA + (tok0 + Q0 + wq * 32 + r32) * 512 + h * 128 + map * 64 + hi * 8;
#pragma unroll
      for (int d0 = 0; d0 < 4; ++d0) qr[d0] = *reinterpret_cast<const bf16x8*>(Qw + d0 * 16); }
    const int mapB = map * 128;
    const char* Kh = (const char*)(P.KA + tok0 * 512 + h * 128); const char* Vh = (const char*)(P.VA + tok0 * 512 + h * 128);
    const int sr = tid >> 4, sc = (tid & 15) * 8, vst0 = v_st(sr, sc), vst1 = v_st(32 + sr, sc);
    const unsigned go0 = (unsigned)(sr * 512 + sc) * 2u, go1 = go0 + 32u * 512u * 2u;
    const int vb0 = (int)(uintptr_t)V_lds + v_rd_base(lane);
    const int tbase = -Q0 - 32 * wq - r32 + 4 * hi + 255;
    struct { bf16x8 vs0, vs1, ks0, ks1; } st_[1];
#define DA_SLOAD(i, k0) do { const char* vt_ = Vh + (size_t)(k0) * 1024; const char* kt_ = Kh + (size_t)(k0) * 1024; \
    st_[i].vs0 = *reinterpret_cast<const bf16x8*>(vt_ + go0); st_[i].vs1 = *reinterpret_cast<const bf16x8*>(vt_ + go1); \
    st_[i].ks0 = *reinterpret_cast<const bf16x8*>(kt_ + go0); st_[i].ks1 = *reinterpret_cast<const bf16x8*>(kt_ + go1); } while (0)
#define DA_SWRITE(bb, i) do { *(bf16x8*)(V_lds + (bb) * SHM_V + vst0) = st_[i].vs0; *(bf16x8*)(V_lds + (bb) * SHM_V + vst1) = st_[i].vs1; const int kc_ = sc * 2; \
    *(bf16x8*)(K_lds + (bb) * SHM_K + DA_KSWZ(sr, kc_)) = st_[i].ks0; *(bf16x8*)(K_lds + (bb) * SHM_K + DA_KSWZ(32 + sr, kc_)) = st_[i].ks1; } while (0)
#define DA_SWAIT() asm volatile("s_waitcnt vmcnt(0)" ::: "memory")
#define DA_CVAL(t) ((64 * (t) - Q0 <= -192) ? cL : ((64 * (t) - Q0 >= 256) ? cR : cN))
#define DA_NEAR(t) (64 * (t) - Q0 > -192 && 64 * (t) - Q0 < 256)
#define DA_PART(P0, P1, t) do { if (DA_NEAR(t)) addbias(P0, P1, tbl, tbase + 64 * (t)); exp_half(P0); } while (0)
    float l_reg = 0.f; f32x16 o[4];
#pragma unroll
    for (int d = 0; d < 4; ++d)
#pragma unroll
        for (int r = 0; r < 16; ++r) o[d][r] = 0.f;
    f32x16 pA0, pA1, pB0, pB1; bf16x8 pa0, pa1, pa2, pa3;
    DA_SLOAD(0, 0); asm volatile("s_waitcnt vmcnt(0)" ::: "memory"); DA_SWRITE(0, 0); __syncthreads();
    qkt(pA0, pA1, K_lds, qr, r32, hi, mapB, DA_CVAL(0)); DA_PART(pA0, pA1, 0);
    DA_SLOAD(0, KVBLK);
    DA_SWAIT(); DA_SWRITE(1, 0); __syncthreads();
    for (int j = 1; j + 1 < NT; j += 2) {
        DA_SBAR(); qkt(pB0, pB1, K_lds + SHM_K, qr, r32, hi, mapB, DA_CVAL(j));
        finishSM(pA0, pA1, l_reg, pa0, pa1, pa2, pa3); DA_SBAR();
        DA_SLOAD(0, (j + 1) * KVBLK); DA_SBAR();
        pv_d0(o, vb0, pa0, pa1, pa2, pa3); DA_PART(pB0, pB1, j);
        __syncthreads(); DA_SWAIT(); DA_SWRITE(0, 0);
        __syncthreads();
        DA_SBAR(); qkt(pA0, pA1, K_lds, qr, r32, hi, mapB, DA_CVAL(j + 1));
        finishSM(pB0, pB1, l_reg, pa0, pa1, pa2, pa3); DA_SBAR();
        DA_SLOAD(0, (j + 2) * KVBLK); DA_SBAR();
        pv_d0(o, vb0 + SHM_V, pa0, pa1, pa2, pa3); DA_PART(pA0, pA1, j + 1);
        __syncthreads(); DA_SWAIT(); DA_SWRITE(1, 0);
        __syncthreads();
    }
    DA_SBAR(); qkt(pB0, pB1, K_lds + SHM_K, qr, r32, hi, mapB, DA_CVAL(NT - 1));
    finishSM(pA0, pA1, l_reg, pa0, pa1, pa2, pa3); DA_SBAR();
    pv_d0(o, vb0, pa0, pa1, pa2, pa3); DA_PART(pB0, pB1, NT - 1);
    finishSM(pB0, pB1, l_reg, pa0, pa1, pa2, pa3); DA_SBAR();
    pv_d0(o, vb0 + SHM_V, pa0, pa1, pa2, pa3);
#undef DA_SLOAD
#undef DA_SWRITE
#undef DA_SWAIT
#undef DA_CVAL
#undef DA_NEAR
#undef DA_PART
    { auto rr = __builtin_amdgcn_permlane32_swap(__float_as_uint(l_reg), __float_as_uint(l_reg), false, false); l_reg = __uint_as_float(rr[0]) + __uint_as_float(rr[1]); }
    if (hi == 0) li_l[r32] = (map ? lam : 1.0f) / l_reg;
    __syncthreads();
    float* OST = (float*)(lds + LDS_OST);
    int te_ = threadIdx.x; asm volatile("" : "+v"(te_));
    const int elane = te_ & 63, er32 = elane & 31, ehi = elane >> 5;
    const float* lib = li_l + 4 * ehi;
    float* ob = OST + (wq * 32 + 4 * ehi) * OSTRIDE + er32;
    if (map == 1) {
#pragma unroll
        for (int r = 0; r < 16; ++r) { const float sc_ = lib[(r & 3) + 8 * (r >> 2)];
#pragma unroll
            for (int d0 = 0; d0 < 4; ++d0) ob[((r & 3) + 8 * (r >> 2)) * OSTRIDE + d0 * 32] = o[d0][r] * sc_; }
    }
    __syncthreads();
    if (map == 0) {
#pragma unroll
        for (int r = 0; r < 16; ++r) { const float sc_ = lib[(r & 3) + 8 * (r >> 2)];
#pragma unroll
            for (int d0 = 0; d0 < 4; ++d0) { float* pp_ = &ob[((r & 3) + 8 * (r >> 2)) * OSTRIDE + d0 * 32]; *pp_ = o[d0][r] * sc_ - *pp_; } }
    }
    __syncthreads();
    { const int row = wid * 16 + (elane >> 2), qtr = elane & 3;
      const float* rp = OST + row * OSTRIDE + 32 * qtr;
      f32x4 v[8]; float ss = 0.f;
#pragma unroll
      for (int i = 0; i < 8; ++i) { v[i] = *reinterpret_cast<const f32x4*>(rp + 4 * i); ss += (v[i][0] * v[i][0] + v[i][1] * v[i][1]) + (v[i][2] * v[i][2] + v[i][3] * v[i][3]); }
      ss += __shfl_xor(ss, 1); ss += __shfl_xor(ss, 2);
      const float rs = rsqrtf(ss * (1.0f / 128.0f) + 1e-6f) * 0.8f;
      const size_t tok = tok0 + Q0 + row;
      const bf16_t* zp = P.ZA + tok * 512 + h * 128 + 32 * qtr;
      bf16_t* cp = P.CAT + tok * 1024 + h * 128 + 32 * qtr;
      const float* gp = P.subg + 32 * qtr;
#pragma unroll
      for (int c8 = 0; c8 < 4; ++c8) {
          const u32x4 zw = *reinterpret_cast<const u32x4*>(zp + 8 * c8);
          const f32x4 g0 = *reinterpret_cast<const f32x4*>(gp + 8 * c8), g1 = *reinterpret_cast<const f32x4*>(gp + 8 * c8 + 4);
          const f32x4 a = v[2 * c8], bq = v[2 * c8 + 1];
          float y[8];
          y[0] = a[0] * rs * g0[0] * __uint_as_float(zw.x << 16); y[1] = a[1] * rs * g0[1] * __uint_as_float(zw.x & 0xffff0000u);
          y[2] = a[2] * rs * g0[2] * __uint_as_float(zw.y << 16); y[3] = a[3] * rs * g0[3] * __uint_as_float(zw.y & 0xffff0000u);
          y[4] = bq[0] * rs * g1[0] * __uint_as_float(zw.z << 16); y[5] = bq[1] * rs * g1[1] * __uint_as_float(zw.z & 0xffff0000u);
          y[6] = bq[2] * rs * g1[2] * __uint_as_float(zw.w << 16); y[7] = bq[3] * rs * g1[3] * __uint_as_float(zw.w & 0xffff0000u);
          u32x4 w; w.x = cvtpk(y[0], y[1]); w.y = cvtpk(y[2], y[3]); w.z = cvtpk(y[4], y[5]); w.w = cvtpk(y[6], y[7]);
          *reinterpret_cast<u32x4*>(cp + 8 * c8) = w; }
    }
    __syncthreads();
}
#undef DA_KSWZ
#undef DA_SBAR
}

namespace na {
using bf16x8 = __attribute__((ext_vector_type(8))) short;
using s16x4  = __attribute__((ext_vector_type(4))) short;
using f32x4  = __attribute__((ext_vector_type(4))) float;
using u32x4  = __attribute__((ext_vector_type(4))) unsigned;
using u32x2  = __attribute__((ext_vector_type(2))) unsigned;
typedef unsigned short bf16_t;
constexpr int SEQ = 2048, NSLOT = 9, SLOTB = 16384, LDS_RPB = NSLOT * SLOTB  , LDS_END = LDS_RPB + 15 * 32 * 4;
constexpr float LOG2E = 1.4426950408889634f;
__device__ __forceinline__ unsigned cvtpk(float lo, float hi) { unsigned r; asm volatile("v_cvt_pk_bf16_f32 %0, %1, %2" : "=v"(r) : "v"(lo), "v"(hi)); return r; }
__device__ __forceinline__ int clampi(int v, int lo, int hi) { return v < lo ? lo : (v > hi ? hi : v); }
__device__ __forceinline__ int rs_of(int r) { return clampi(r - 4, 0, 24); }
__device__ __forceinline__ s16x4 tr_read0(int addr) { s16x4 r; asm volatile("ds_read_b64_tr_b16 %0, %1" : "=&v"(r) : "v"(addr) : "memory"); return r; }
__device__ __forceinline__ float wave_max(float v) {
#pragma unroll
    for (int o = 1; o < 64; o <<= 1) v = fmaxf(v, __shfl_xor(v, o));
    return v;
}
struct Params {
    const bf16_t* QB; const bf16_t* KB; const bf16_t* VB; const bf16_t* ZB;
    const float* rpbg;
    const float* sc;
    bf16_t* CAT;
};

__device__ __forceinline__ void unit(const Params& P, int b, int h, int seg, char* lds) {
    const int tid = threadIdx.x, lane = tid & 63, l15 = lane & 15, g = lane >> 4;
    const int wid = __builtin_amdgcn_readfirstlane(tid >> 6), rr = wid >> 2, qt = wid & 3;
    float* RPB = (float*)(lds + LDS_RPB);
    const size_t tok0 = (size_t)b * SEQ;
    if (tid < 480) RPB[tid] = P.rpbg[h * 480 + tid];
    const float MB = P.sc[16 + h];
    const int r0 = seg * 8;
    const int c0 = 16 * qt, kc0 = clampi(c0 - 8, 0, 32);
    const int qc = c0 + l15, cs = clampi(qc - 8, 0, 48);
    int dci[2][4]; bool val[2][4];
#pragma unroll
    for (int blk = 0; blk < 2; ++blk)
#pragma unroll
        for (int e = 0; e < 4; ++e) { const int kc = kc0 + 16 * blk + 4 * g + e; val[blk][e] = (kc >= cs) && (kc < cs + 16); dci[blk][e] = clampi(kc - qc + 15, 0, 30); }
    const int skc = tid >> 3, sch = tid & 7;
    const int kst = skc * 128 + ((sch ^ (skc & 7)) << 4);
    const int vst = 8192 + skc * 128 + ((((sch >> 1) ^ ((skc >> 1) & 3)) << 5) | ((sch & 1) << 4));
    const bf16_t* Kh = P.KB + tok0 * 512 + h * 64 + (size_t)skc * 512 + sch * 8;
    const bf16_t* Vh = P.VB + tok0 * 512 + h * 64 + (size_t)skc * 512 + sch * 8;
    int kad[2][2];
#pragma unroll
    for (int blk = 0; blk < 2; ++blk)
#pragma unroll
        for (int ks = 0; ks < 2; ++ks) { const int row = kc0 + 16 * blk + l15; kad[blk][ks] = row * 128 + (((4 * ks + g) ^ (row & 7)) << 4); }
    int vrow[2], vsw[2];
#pragma unroll
    for (int blk = 0; blk < 2; ++blk) { const int row = kc0 + 16 * blk + 4 * g + (l15 >> 2); vrow[blk] = 8192 + row * 128 + 8 * (l15 & 3); vsw[blk] = (row >> 1) & 3; }
    const int lds0 = (int)(uintptr_t)lds;
    int loaded_hi = rs_of(r0) - 1;
    for (int t = 0; t < 4; ++t) {
        const int ra = r0 + 2 * t;
        const int need_hi = rs_of(ra + 1) + 7;
        __syncthreads();
        for (int kr = loaded_hi + 1; kr <= need_hi; ++kr) {
            const int slot = (kr % NSLOT) * SLOTB;
            const bf16x8 kv = *reinterpret_cast<const bf16x8*>(Kh + (size_t)kr * 64 * 512);
            const bf16x8 vv = *reinterpret_cast<const bf16x8*>(Vh + (size_t)kr * 64 * 512);
            *reinterpret_cast<bf16x8*>(lds + slot + kst) = kv;
            *reinterpret_cast<bf16x8*>(lds + slot + vst) = vv;
        }
        loaded_hi = need_hi;
        __syncthreads();
        const int r = ra + rr, rs = rs_of(r);
        const size_t qtok = tok0 + (size_t)r * 64 + c0 + l15;
        bf16x8 qf[2];
#pragma unroll
        for (int ks = 0; ks < 2; ++ks) qf[ks] = *reinterpret_cast<const bf16x8*>(P.QB + qtok * 512 + h * 64 + 32 * ks + 8 * g);
        f32x4 o[4];
#pragma unroll
        for (int d = 0; d < 4; ++d) o[d] = (f32x4){0.f, 0.f, 0.f, 0.f};
        float lsum = 0.f;
        for (int i = 0; i < 8; ++i) {
            const int kr = rs + i, slot = (kr % NSLOT) * SLOTB, dr = kr - r + 7;
            const char* sp = lds + slot;
            f32x4 s0 = (f32x4){-MB, -MB, -MB, -MB}, s1 = s0;
#pragma unroll
            for (int ks = 0; ks < 2; ++ks) {
                const bf16x8 k0 = *reinterpret_cast<const bf16x8*>(sp + kad[0][ks]);
                const bf16x8 k1 = *reinterpret_cast<const bf16x8*>(sp + kad[1][ks]);
                s0 = __builtin_amdgcn_mfma_f32_16x16x32_bf16(k0, qf[ks], s0, 0, 0, 0);
                s1 = __builtin_amdgcn_mfma_f32_16x16x32_bf16(k1, qf[ks], s1, 0, 0, 0);
            }
            const float* bp = RPB + dr * 32;
#pragma unroll
            for (int e = 0; e < 4; ++e) {
                const float e0 = __builtin_amdgcn_exp2f(s0[e] + bp[dci[0][e]]), e1 = __builtin_amdgcn_exp2f(s1[e] + bp[dci[1][e]]);
                s0[e] = val[0][e] ? e0 : 0.f; s1[e] = val[1][e] ? e1 : 0.f;
                lsum += s0[e] + s1[e];
            }
            u32x4 pw; pw.x = cvtpk(s0[0], s0[1]); pw.y = cvtpk(s0[2], s0[3]); pw.z = cvtpk(s1[0], s1[1]); pw.w = cvtpk(s1[2], s1[3]);
            const bf16x8 pb = *reinterpret_cast<const bf16x8*>(&pw);
            const int sb = lds0 + slot;
#pragma unroll
            for (int d = 0; d < 4; ++d) {
                const s16x4 lo = tr_read0(sb + vrow[0] + ((d ^ vsw[0]) << 5));
                const s16x4 hi_ = tr_read0(sb + vrow[1] + ((d ^ vsw[1]) << 5));
                asm volatile("s_waitcnt lgkmcnt(0)" ::: "memory"); __builtin_amdgcn_sched_barrier(0);
                const bf16x8 va = (bf16x8){lo[0], lo[1], lo[2], lo[3], hi_[0], hi_[1], hi_[2], hi_[3]};
                o[d] = __builtin_amdgcn_mfma_f32_16x16x32_bf16(va, pb, o[d], 0, 0, 0);
            }
        }
        lsum += __shfl_xor(lsum, 16); lsum += __shfl_xor(lsum, 32);
        const float inv = 1.0f / lsum;
        const bf16_t* zp = P.ZB + qtok * 512 + h * 64 + 4 * g;
        bf16_t* cp = P.CAT + qtok * 1024 + 512 + h * 64 + 4 * g;
#pragma unroll
        for (int d = 0; d < 4; ++d) {
            const u32x2 zw = *reinterpret_cast<const u32x2*>(zp + 16 * d);
            const float y0 = o[d][0] * inv * __uint_as_float(zw.x << 16), y1 = o[d][1] * inv * __uint_as_float(zw.x & 0xffff0000u);
            const float y2 = o[d][2] * inv * __uint_as_float(zw.y << 16), y3 = o[d][3] * inv * __uint_as_float(zw.y & 0xffff0000u);
            u32x2 w; w.x = cvtpk(y0, y1); w.y = cvtpk(y2, y3);
            *reinterpret_cast<u32x2*>(cp + 16 * d) = w;
        }
    }
    __syncthreads();
}
}

constexpr int NWAVES = 8;
#ifndef MK_N_LAUNCHES
#define MK_N_LAUNCHES 1
#endif
constexpr int N_LAUNCHES = MK_N_LAUNCHES;
constexpr int PER_PHASE = 5;
constexpr int BATCH = 8, SEQ = 2048, D = 1024, M = BATCH * SEQ, DIN = 4096, PLE = 256;
constexpr size_t MiB = 1u << 20;
constexpr size_t WS_CTL = 0, CTL_ZERO_BYTES = 64 * 1024;
constexpr size_t WS_WIN = 1 * MiB, WS_WOUT = 9 * MiB, WS_WG = 11 * MiB, WS_WP = 13 * MiB;
constexpr size_t WS_PB = 14 * MiB;
constexpr size_t WS_XN = 22 * MiB;
constexpr size_t WS_BUF = 54 * MiB;
constexpr size_t WS_CAT = 182 * MiB;
constexpr size_t WS_PP = 214 * MiB;
constexpr size_t WS_END = 246 * MiB;
constexpr size_t WS_GAINS = 128 * 1024;
constexpr size_t WS_SCAL = WS_GAINS + 1024, WS_TBLA = WS_GAINS + 4096, WS_RPBG = WS_GAINS + 16384;
constexpr int CW_BAR = 1024;
constexpr int RING_BYTES = 147456;
constexpr int NA_EXTRA = 2048;
constexpr int MISC_OFF = RING_BYTES + NA_EXTRA;
constexpr int LDS_BYTES = MISC_OFF + 256;
static_assert(pg8::STAGE_BYTES <= RING_BYTES && da::LDS_END <= RING_BYTES && na::LDS_END <= MISC_OFF && LDS_BYTES <= 163840, "LDS map");

#define GAS __attribute__((address_space(1)))
#define LAS __attribute__((address_space(3)))
typedef unsigned short bf16;
typedef unsigned v4u __attribute__((ext_vector_type(4)));
typedef float f32x4 __attribute__((ext_vector_type(4)));
#define LDS_WAIT() asm volatile("s_waitcnt lgkmcnt(0)" ::: "memory")
__device__ __forceinline__ unsigned f2bf(float f) { unsigned u = __builtin_bit_cast(unsigned, f); return (u + 0x7fffu + ((u >> 16) & 1u)) >> 16; }
__device__ __forceinline__ unsigned pk2(float lo, float hi) { return f2bf(lo) | (f2bf(hi) << 16); }

#define XB_TMO      128
#define XB_XCNT(j)  (256  + 64 * (j))
#define XB_XSUB(j)  (1280 + 64 * (j))
#define XB_XGEN(j)  (2304 + 64 * (j))
#define XB_TOP      3328
#define XB_TOPGEN   3392
#define XCD_BAR_WORDS 3456
#define XB_SPIN_CAP (1u << 18)
__device__ __forceinline__ unsigned xb_ld(unsigned* p)              { return __hip_atomic_load(p, __ATOMIC_RELAXED, __HIP_MEMORY_SCOPE_AGENT); }
__device__ __forceinline__ unsigned xb_add(unsigned* p, unsigned v) { return __hip_atomic_fetch_add(p, v, __ATOMIC_RELAXED, __HIP_MEMORY_SCOPE_AGENT); }
__device__ __forceinline__ unsigned xb_xcc_id() { return (unsigned)__builtin_amdgcn_s_getreg((3 << 11) | 20) & 0xFu; }
#define XB_SPIN(cond, bar) do { unsigned _sp = 0; while (cond) { __builtin_amdgcn_s_sleep(1); \
    if ((++_sp & 255u) == 0u) { if (xb_ld(&(bar)[XB_TMO])) break; if (_sp > XB_SPIN_CAP) { atomicAdd(&(bar)[XB_TMO], 1u); break; } } } } while (0)
struct XcdBarrier { unsigned* bar; unsigned x; volatile LAS unsigned* st; };
__device__ __forceinline__ XcdBarrier xcd_barrier_post(unsigned* bar, volatile LAS unsigned* st) {
    XcdBarrier b; b.bar = bar; b.x = xb_xcc_id(); b.st = st;
    if (threadIdx.x == 0) (void)xb_add(&bar[XB_XCNT(b.x)], 1u);
    return b;
}
__device__ __forceinline__ void xcd_barrier_complete(unsigned* bar, unsigned x, unsigned& nloc, unsigned& nx) {
    const unsigned G = gridDim.x * gridDim.y * gridDim.z;
    unsigned sum, cnt, mine, sp = 0u;
    for (;;) {
        sum = 0u; cnt = 0u; mine = 0u;
#pragma unroll
        for (unsigned j = 0; j < 16; ++j) { const unsigned c = xb_ld(&bar[XB_XCNT(j)]); sum += c; cnt += (c > 0u) ? 1u : 0u; mine = (j == x) ? c : mine; }
        if (sum == G) break;
        __builtin_amdgcn_s_sleep(1);
        if ((++sp & 255u) == 0u) { if (xb_ld(&bar[XB_TMO])) break; if (sp > XB_SPIN_CAP) { atomicAdd(&bar[XB_TMO], 1u); break; } }
    }
    nloc = mine > 0u ? mine : 1u; nx = cnt > 0u ? cnt : 1u;
}
__device__ __forceinline__ void xcd_barrier(const XcdBarrier& b) {
    asm volatile("s_waitcnt vmcnt(0)" ::: "memory");
    __syncthreads();
    if (threadIdx.x == 0) {
        unsigned* bar = b.bar;
        __builtin_amdgcn_s_waitcnt(0);
        unsigned nloc = b.st[0], nx = b.st[1];
        if (nloc == 0u) { xcd_barrier_complete(bar, b.x, nloc, nx); b.st[0] = nloc; b.st[1] = nx; }
        const unsigned old = xb_add(&bar[XB_XSUB(b.x)], 1u);
        const unsigned gen = old / nloc;
        if (old + 1u == (gen + 1u) * nloc) {
            __builtin_amdgcn_fence(__ATOMIC_RELEASE, "agent");
            asm volatile("s_waitcnt vmcnt(0)" ::: "memory");
            const unsigned og = xb_add(&bar[XB_TOP], 1u);
            const unsigned tg = og / nx;
            if (og + 1u == (tg + 1u) * nx) xb_add(&bar[XB_TOPGEN], 1u);
            else XB_SPIN(xb_ld(&bar[XB_TOPGEN]) == tg, bar);
            __builtin_amdgcn_fence(__ATOMIC_ACQUIRE, "agent");
            xb_add(&bar[XB_XGEN(b.x)], 1u);
            asm volatile("s_waitcnt vmcnt(0)" ::: "memory");
        } else {
            XB_SPIN(xb_ld(&bar[XB_XGEN(b.x)]) == gen, bar);
            __builtin_amdgcn_fence(__ATOMIC_ACQUIRE, "agent");
            asm volatile("s_waitcnt vmcnt(0)" ::: "memory");
        }
    }
    __syncthreads();
}

__device__ __forceinline__ float wave_sum_f(float v) {
#pragma unroll
    for (int o = 1; o < 64; o <<= 1) v += __shfl_xor(v, o);
    return v;
}
__device__ __forceinline__ float wave_max_f(float v) {
#pragma unroll
    for (int o = 1; o < 64; o <<= 1) v = fmaxf(v, __shfl_xor(v, o));
    return v;
}
template <bool PERMW>
__device__ __forceinline__ void p0_transpose_item(const float* W, int K, int N, bf16* WT, LAS float* scr, int item, int lane) {
    const int nblk = N / 32, kb = item / nblk, nb = item % nblk, k0 = 64 * kb, n0 = 32 * nb;
    int r0 = n0;
    if (PERMW) { const int l = n0 & 255, wc = l >> 6, bj = (l >> 5) & 1; r0 = (n0 & ~255) + 128 * bj + 32 * wc; }
#pragma unroll 8
    for (int i = 0; i < 32; ++i) { const int kk = 2 * i + (lane >> 5); scr[kk * 33 + (lane & 31)] = W[(size_t)(k0 + kk) * N + n0 + (lane & 31)]; }
    LDS_WAIT(); asm volatile("" ::: "memory");
    const int c = lane & 7;
#pragma unroll
    for (int j = 0; j < 4; ++j) { const int n = (lane >> 3) + 8 * j; const LAS float* s = scr + (8 * c) * 33 + n;
        v4u o; o.x = pk2(s[0 * 33], s[1 * 33]); o.y = pk2(s[2 * 33], s[3 * 33]); o.z = pk2(s[4 * 33], s[5 * 33]); o.w = pk2(s[6 * 33], s[7 * 33]);
        *(GAS v4u*)(WT + (size_t)(r0 + n) * K + k0 + 8 * c) = o; }
    LDS_WAIT(); asm volatile("" ::: "memory");
}
__device__ __forceinline__ void rms_row_to_bf16(const float* xrow, const float* g, bf16* orow, int lane) {
    const GAS f32x4* xr = (const GAS f32x4*)xrow + lane; const GAS f32x4* gr = (const GAS f32x4*)g + lane;
    f32x4 v[4]; float s = 0.f;
#pragma unroll
    for (int j = 0; j < 4; ++j) { v[j] = xr[64 * j]; s += (v[j].x * v[j].x + v[j].y * v[j].y) + (v[j].z * v[j].z + v[j].w * v[j].w); }
    const float rstd = rsqrtf(wave_sum_f(s) * (1.f / D) + 1e-6f);
    GAS unsigned long long* o8 = (GAS unsigned long long*)orow + lane;
#pragma unroll
    for (int j = 0; j < 4; ++j) { const f32x4 gg = gr[64 * j];
        o8[64 * j] = (unsigned long long)pk2(v[j].x * rstd * gg.x, v[j].y * rstd * gg.y) | ((unsigned long long)pk2(v[j].z * rstd * gg.z, v[j].w * rstd * gg.w) << 32); }
}

struct Args { const float* in[18]; float* out; unsigned char* ws; int ph_lo, ph_hi, li, pad; };

__global__ void __launch_bounds__(NWAVES * 64, 2) mk_fwd(Args args) {
    extern __shared__ __attribute__((aligned(16))) unsigned char lds[];
    const int tid = threadIdx.x, lane = tid & 63, wave = __builtin_amdgcn_readfirstlane(tid >> 6);
    const int G = gridDim.x; const int bx = blockIdx.x; const int vcu = (G % 8 == 0) ? (bx % 8) * (G / 8) + bx / 8 : bx;
    unsigned char* ws = args.ws;
    volatile LAS unsigned* MISC = (volatile LAS unsigned*)((LAS unsigned char*)lds + MISC_OFF);
    for (int u = tid; u < (LDS_BYTES - MISC_OFF) / 4; u += NWAVES * 64) MISC[u] = 0u;
    __syncthreads();
    XcdBarrier bar; bar.bar = (unsigned*)(ws + WS_CTL) + CW_BAR; bar.x = 0; bar.st = nullptr;
    if (N_LAUNCHES != PER_PHASE) bar = xcd_barrier_post((unsigned*)(ws + WS_CTL) + CW_BAR, MISC + 8);
    const int lo = args.ph_lo, hi = args.ph_hi;
#ifdef MK_ONLY_PHASE
#define IN(k) ((k) == MK_ONLY_PHASE && lo <= (k) && (k) < hi)
#else
#define IN(k) (lo <= (k) && (k) < hi)
#endif
#define BOTH(k) (IN(k) && IN((k) + 1))
    const float* x = args.in[0]; const float* p = args.in[1]; const float* norm_g = args.in[2]; const float* w_in = args.in[3]; const float* w_out = args.in[4];
    const float* w_gate = args.in[16]; const float* w_proj = args.in[17];
    bf16* Win_t = (bf16*)(ws + WS_WIN); bf16* Wout_t = (bf16*)(ws + WS_WOUT); bf16* Wg_t = (bf16*)(ws + WS_WG); bf16* Wp_t = (bf16*)(ws + WS_WP);
    bf16* PB = (bf16*)(ws + WS_PB); bf16* XN = (bf16*)(ws + WS_XN); bf16* BUF = (bf16*)(ws + WS_BUF); bf16* CAT = (bf16*)(ws + WS_CAT); bf16* PP = (bf16*)(ws + WS_PP);
    constexpr size_t BS = (size_t)M * 512;

    if (IN(0)) {
        LAS float* scr = (LAS float*)((LAS unsigned char*)lds + wave * 16384);
        const int gw = vcu * NWAVES + wave, NGW = G * NWAVES;
        constexpr int I_IN = (D / 64) * (DIN / 32), I_SQ = (D / 64) * (D / 32), I_P = (PLE / 64) * (D / 32);
        constexpr int NITEMS = I_IN + 2 * I_SQ + I_P;
        for (int it = gw; it < NITEMS; it += NGW) {
            int r = it;
            if (r < I_IN) { p0_transpose_item<true>(w_in, D, DIN, Win_t, scr, r, lane); continue; } r -= I_IN;
            if (r < I_SQ) { p0_transpose_item<false>(w_out, D, D, Wout_t, scr, r, lane); continue; } r -= I_SQ;
            if (r < I_SQ) { p0_transpose_item<false>(w_gate, D, D, Wg_t, scr, r, lane); continue; } r -= I_SQ;
            p0_transpose_item<false>(w_proj, PLE, D, Wp_t, scr, r, lane);
        }
        if (gw == 0) { float* GN = (float*)(ws + WS_GAINS); const float qs = 0.125f * 1.4426950408889634f;
            GN[lane] = args.in[5][lane] * qs; GN[64 + lane] = args.in[6][lane]; GN[128 + lane] = args.in[13][lane] * qs; GN[192 + lane] = args.in[14][lane]; }
        if (gw == 1) {
            const float L2E = 1.4426950408889634f; float* SC = (float*)(ws + WS_SCAL);
            const float lam = __expf(wave_sum_f(args.in[7][lane] * args.in[8][lane])) - __expf(wave_sum_f(args.in[9][lane] * args.in[10][lane])) + 0.2f;
            const float ga = wave_max_f(fabsf(args.in[5][lane])) * wave_max_f(fabsf(args.in[6][lane])), gb = wave_max_f(fabsf(args.in[13][lane])) * wave_max_f(fabsf(args.in[14][lane]));
            if (lane == 0) SC[0] = lam;
            for (int h = 0; h < 4; ++h) { const float tm = wave_max_f(fabsf(args.in[12][(lane & 31) * 4 + h]));
                const float MB = fminf(8.0f * L2E * ga * 1.01f + tm * L2E + 0.1f, 64.0f);
                if (lane == 0) { SC[4 + h] = MB; SC[8 + h] = args.in[12][15 * 4 + h] * L2E - MB; SC[12 + h] = args.in[12][31 * 4 + h] * L2E - MB; } }
            for (int h = 0; h < 8; ++h) { float bm = 0.f; for (int i = lane; i < 465; i += 64) bm = fmaxf(bm, fabsf(args.in[15][h * 465 + i])); bm = wave_max_f(bm);
                if (lane == 0) SC[16 + h] = fminf(8.0f * L2E * gb * 1.01f + bm * L2E + 0.1f, 64.0f); }
        }
        if (gw == 2) { float* TB = (float*)(ws + WS_TBLA);
            for (int i = lane; i < 2048; i += 64) { const int h = i >> 9, idx = i & 511; TB[i] = args.in[12][da::t5_bucket(idx - 255) * 4 + h] * 1.4426950408889634f; } }
        if (gw == 3) { float* RB = (float*)(ws + WS_RPBG);
            for (int i = lane; i < 8 * 480; i += 64) { const int h = i / 480, r = i % 480, dr = r >> 5, dc = r & 31; RB[i] = dc < 31 ? args.in[15][(h * 15 + dr) * 31 + dc] * 1.4426950408889634f : 0.f; } }
        for (int m = gw; m < M; m += NGW) {
            rms_row_to_bf16(x + (size_t)m * D, norm_g, XN + (size_t)m * D, lane);
            const f32x4 pv = *((const GAS f32x4*)(p + (size_t)m * PLE) + lane);
            *((GAS unsigned long long*)(PB + (size_t)m * PLE) + lane) = (unsigned long long)pk2(pv.x, pv.y) | ((unsigned long long)pk2(pv.z, pv.w) << 32);
        }
        if (BOTH(0)) xcd_barrier(bar);
    }
    if (IN(1)) {
        { pg8::Gemm g{XN, Win_t, M, DIN, D}; pg8::StaticOrder S; S.init(M, DIN, G, bx);
          pg8::EpiProj E{BUF, (const float*)(ws + WS_GAINS)};
          pg8::gemm_phase<pg8::EpiProj, pg8::StaticOrder, true, true>((LAS unsigned char*)lds, g, S, E); }
        { pg8::Gemm g{PB, Wp_t, M, D, PLE}; pg8::StaticOrder S; S.init(M, D, G, bx);
          pg8::EpiBf16Plain E{PP, D};
          pg8::gemm_phase<pg8::EpiBf16Plain, pg8::StaticOrder, true, true>((LAS unsigned char*)lds, g, S, E); }
        if (BOTH(1)) xcd_barrier(bar);
    }
    if (IN(2)) {
#ifndef MK_SKIP_DA
        { da::Params P{BUF, BUF + BS, BUF + 2 * BS, BUF + 3 * BS, (const float*)(ws + WS_SCAL), (const float*)(ws + WS_TBLA), args.in[11], CAT};
          for (int i = 0; i < 2; ++i) { const int uidx = i * G + vcu; if (uidx >= 512) break; const int bh = uidx >> 4, qb = uidx & 15; da::unit(P, bh >> 2, bh & 3, qb, (char*)lds); } }
#endif
#ifndef MK_SKIP_NA
        { na::Params P{BUF + 4 * BS, BUF + 5 * BS, BUF + 6 * BS, BUF + 7 * BS, (const float*)(ws + WS_RPBG), (const float*)(ws + WS_SCAL), CAT};
          for (int uidx = vcu; uidx < 256; uidx += G) { const int bh = uidx >> 2, seg = uidx & 3; na::unit(P, bh >> 3, bh & 7, seg, (char*)lds); } }
#endif
        if (BOTH(2)) xcd_barrier(bar);
    }
    if (IN(3)) {
        pg8::Gemm g{CAT, Wout_t, M, D, D}; pg8::StaticOrder S; S.init(M, D, G, bx);
        pg8::EpiX1 E{x, args.out, XN};
        pg8::gemm_phase<pg8::EpiX1, pg8::StaticOrder, true, true>((LAS unsigned char*)lds, g, S, E);
        if (BOTH(3)) xcd_barrier(bar);
    }
    if (IN(4)) {
        pg8::Gemm g{XN, Wg_t, M, D, D}; pg8::StaticOrder S; S.init(M, D, G, bx);
        pg8::EpiFinal E{args.out, PP};
        pg8::gemm_phase<pg8::EpiFinal, pg8::StaticOrder, true, true>((LAS unsigned char*)lds, g, S, E);
    }
#undef IN
#undef BOTH
}

#if defined(MK_NAIVE_ATTN)
namespace dbg {
typedef __hip_bfloat16 hb;
__device__ __forceinline__ float tof(hb v) { return __bfloat162float(v); }
__device__ __forceinline__ float wsum(float v) {
#pragma unroll
  for (int o = 32; o; o >>= 1) v += __shfl_xor(v, o);
  return v;
}
__device__ __forceinline__ float wmax(float v) {
#pragma unroll
  for (int o = 32; o; o >>= 1) v = fmaxf(v, __shfl_xor(v, o));
  return v;
}
__device__ __forceinline__ int t5b(int rel) {
  int ret = rel > 0 ? 16 : 0; int n = rel < 0 ? -rel : rel; int v;
  if (n < 8) v = n; else { float nf = (float)n; int large = 8 + (int)(logf(nf / 8.f) / 2.772588722239781f * 8.f); v = large < 15 ? large : 15; }
  return ret + v;
}
constexpr int S = 2048;
constexpr float QKS = 0.6931471805599453f;
__global__ __launch_bounds__(128) void k_diffattn(const hb* __restrict__ QA, const hb* __restrict__ KA, const hb* __restrict__ VA, const hb* __restrict__ ZA,
                                                  const float* __restrict__ t5, const float* __restrict__ lq1, const float* __restrict__ lk1, const float* __restrict__ lq2,
                                                  const float* __restrict__ lk2, const float* __restrict__ subg, hb* __restrict__ CAT) {
  __shared__ float a_s[2][2048];
  __shared__ float b_s[2][2048];
  __shared__ float q_s[2][128];
  const int w = threadIdx.x >> 6, lane = threadIdx.x & 63;
  const int task = blockIdx.x * 2 + w;
  const int q = task % S, h = (task / S) % 4, b = task / (S * 4);
  const float lam = __expf(wsum(lq1[lane] * lk1[lane])) - __expf(wsum(lq2[lane] * lk2[lane])) + 0.2f;
  const size_t tok = (size_t)b * S + q;
  q_s[w][lane] = tof(QA[tok * 512 + h * 128 + lane]);
  q_s[w][64 + lane] = tof(QA[tok * 512 + h * 128 + 64 + lane]);
  __syncthreads();
  float m1 = -1e30f, m2 = -1e30f;
  for (int i = 0; i < 32; ++i) {
    const int k = lane + 64 * i;
    const hb* kr = KA + ((size_t)b * S + k) * 512 + h * 128;
    float d1 = 0.f, d2 = 0.f;
    for (int d = 0; d < 64; ++d) { d1 += q_s[w][d] * tof(kr[d]); d2 += q_s[w][64 + d] * tof(kr[64 + d]); }
    const float bias = t5[t5b(k - q) * 4 + h];
    d1 = d1 * QKS + bias; d2 = d2 * QKS + bias;
    a_s[w][k] = d1; b_s[w][k] = d2;
    m1 = fmaxf(m1, d1); m2 = fmaxf(m2, d2);
  }
  m1 = wmax(m1); m2 = wmax(m2);
  float l1 = 0.f, l2 = 0.f;
  for (int i = 0; i < 32; ++i) {
    const int k = lane + 64 * i;
    const float e1 = __expf(a_s[w][k] - m1); a_s[w][k] = e1; l1 += e1;
    const float e2 = __expf(b_s[w][k] - m2); b_s[w][k] = e2; l2 += e2;
  }
  l1 = wsum(l1); l2 = wsum(l2);
  const float i1 = 1.f / l1, i2 = lam / l2;
  for (int i = 0; i < 32; ++i) { const int k = lane + 64 * i; a_s[w][k] = a_s[w][k] * i1 - b_s[w][k] * i2; }
  __syncthreads();
  float o0 = 0.f, o1 = 0.f;
  const hb* vb = VA + (size_t)b * S * 512 + h * 128;
  for (int k = 0; k < S; ++k) { const float a = a_s[w][k]; o0 += a * tof(vb[(size_t)k * 512 + lane]); o1 += a * tof(vb[(size_t)k * 512 + 64 + lane]); }
  const float ss = wsum(o0 * o0 + o1 * o1);
  const float r = rsqrtf(ss / 128.f + 1e-6f) * 0.8f;
  const float y0 = o0 * r * subg[lane] * tof(ZA[tok * 512 + h * 128 + lane]);
  const float y1 = o1 * r * subg[64 + lane] * tof(ZA[tok * 512 + h * 128 + 64 + lane]);
  CAT[tok * 1024 + h * 128 + lane] = __float2bfloat16(y0);
  CAT[tok * 1024 + h * 128 + 64 + lane] = __float2bfloat16(y1);
}
__global__ __launch_bounds__(256) void k_na(const hb* __restrict__ QB, const hb* __restrict__ KB, const hb* __restrict__ VB, const hb* __restrict__ ZB,
                                            const float* __restrict__ rpb, hb* __restrict__ CAT) {
  __shared__ float q_s[4][64];
  const int w = threadIdx.x >> 6, lane = threadIdx.x & 63;
  const int task = blockIdx.x * 4 + w;
  const int h = task & 7, tokl = task >> 3;
  const int b = tokl / S, s = tokl % S, r = s >> 6, c = s & 63;
  const int rs = min(max(r - 4, 0), 24), cs = min(max(c - 8, 0), 48);
  q_s[w][lane] = tof(QB[(size_t)tokl * 512 + h * 64 + lane]);
  __syncthreads();
  float sc[2]; int ktok[2];
#pragma unroll
  for (int t = 0; t < 2; ++t) {
    const int idx = lane + 64 * t, i = idx >> 4, j = idx & 15;
    const int krow = rs + i, kcol = cs + j;
    ktok[t] = b * S + krow * 64 + kcol;
    const hb* kr = KB + (size_t)ktok[t] * 512 + h * 64;
    float d = 0.f;
    for (int e = 0; e < 64; ++e) d += q_s[w][e] * tof(kr[e]);
    int dc = kcol - c; dc = min(max(dc, -15), 15) + 15;
    sc[t] = d * QKS + rpb[(h * 15 + (krow - r + 7)) * 31 + dc];
  }
  const float mx = wmax(fmaxf(sc[0], sc[1]));
  const float p0 = __expf(sc[0] - mx), p1 = __expf(sc[1] - mx);
  const float l = wsum(p0 + p1);
  float o = 0.f;
  for (int idx = 0; idx < 128; ++idx) {
    const float pp_ = __shfl(idx < 64 ? p0 : p1, idx & 63);
    const int kt = __shfl(idx < 64 ? ktok[0] : ktok[1], idx & 63);
    o += pp_ * tof(VB[(size_t)kt * 512 + h * 64 + lane]);
  }
  const float y = o / l * tof(ZB[(size_t)tokl * 512 + h * 64 + lane]);
  CAT[(size_t)tokl * 1024 + 512 + h * 64 + lane] = __float2bfloat16(y);
}
}
#endif

extern "C" void kernel_launch(void* const* d_in, const int* in_sizes, int n_in, void* d_out, int out_size, void* d_ws, size_t ws_size, hipStream_t stream) {
    static int grid = 0;
    if (grid == 0) {
        if (n_in != 18 || in_sizes[0] != M * D || out_size != M * D || ws_size < WS_END) { fprintf(stderr, "kernel_launch: unexpected shapes (n_in %d, in0 %d, out %d, ws %zu); nothing launched\n", n_in, n_in > 0 ? in_sizes[0] : -1, out_size, ws_size); grid = -1; return; }
        int dev = 0, cus = 0, per_cu = 0;
        if (hipGetDevice(&dev) != hipSuccess || hipDeviceGetAttribute(&cus, hipDeviceAttributeMultiprocessorCount, dev) != hipSuccess) { fprintf(stderr, "kernel_launch: device query failed\n"); grid = -1; return; }
        if (hipFuncSetAttribute((const void*)mk_fwd, hipFuncAttributeMaxDynamicSharedMemorySize, LDS_BYTES) != hipSuccess) { fprintf(stderr, "kernel_launch: hipFuncSetAttribute failed\n"); grid = -1; return; }
        if (hipOccupancyMaxActiveBlocksPerMultiprocessor(&per_cu, (const void*)mk_fwd, NWAVES * 64, LDS_BYTES) != hipSuccess || per_cu < 1) fprintf(stderr, "kernel_launch: note: occupancy query reports %d blocks per CU\n", per_cu);
        (void)hipGetLastError();
        grid = cus;
    }
    if (grid < 0) return;
    if (hipMemsetAsync((char*)d_ws + WS_CTL, 0, CTL_ZERO_BYTES, stream) != hipSuccess) { fprintf(stderr, "kernel_launch: memset failed\n"); return; }
    Args a{};
    for (int i = 0; i < 18; ++i) a.in[i] = (const float*)d_in[i];
    a.out = (float*)d_out; a.ws = (unsigned char*)d_ws;
#if MK_N_LAUNCHES == 1
    a.ph_lo = 0; a.ph_hi = PER_PHASE; a.li = 0;
    hipLaunchKernelGGL(mk_fwd, dim3(grid), dim3(NWAVES * 64), LDS_BYTES, stream, a);
#else
    for (int ph = 0; ph < PER_PHASE; ++ph) {
        a.ph_lo = ph; a.ph_hi = ph + 1; a.li = ph;
        hipLaunchKernelGGL(mk_fwd, dim3(grid), dim3(NWAVES * 64), LDS_BYTES, stream, a);
#if defined(MK_NAIVE_ATTN)
        if (ph == 2) {
            typedef dbg::hb hb; hb* BUFh = (hb*)((char*)d_ws + WS_BUF); hb* CATh = (hb*)((char*)d_ws + WS_CAT); const size_t BS = (size_t)M * 512;
            if (MK_NAIVE_ATTN & 1) dbg::k_diffattn<<<BATCH * 4 * SEQ / 2, 128, 0, stream>>>(BUFh, BUFh + BS, BUFh + 2 * BS, BUFh + 3 * BS, (const float*)d_in[12], (const float*)d_in[7], (const float*)d_in[8], (const float*)d_in[9], (const float*)d_in[10], (const float*)d_in[11], CATh);
            if (MK_NAIVE_ATTN & 2) dbg::k_na<<<M * 8 / 4, 256, 0, stream>>>(BUFh + 4 * BS, BUFh + 5 * BS, BUFh + 6 * BS, BUFh + 7 * BS, (const float*)d_in[15], CATh);
        }
#endif
    }
#endif
    const hipError_t le = hipPeekAtLastError();
    if (le != hipSuccess) fprintf(stderr, "kernel_launch: launch failed: %s (grid %d)\n", hipGetErrorName(le), grid);
}
```

```cpp
#include <hip/hip_runtime.h>
#include <hip/hip_bf16.h>
#include <cstdio>
#include <cstdint>
__device__ __forceinline__ int mk_lane() { int l; asm volatile("v_mbcnt_lo_u32_b32 %0, -1, 0\n\tv_mbcnt_hi_u32_b32 %0, -1, %0" : "=v"(l)); return l; }
#define MK_N_LAUNCHES 1
#define MK_FLATBAR 2
#define MK_XLOCAL
#define MK_XNP
#define MK_TAILPF
#define MK_PP_STAGGER 1
#define MK_P0T64
#define MK_P0SPREAD 2
#define MK_LATEREG
#define MK_EPIBATCH
#define MK_EPIFAST
#if defined(MK_NAIVE_ATTN)
#if (MK_NAIVE_ATTN & 1)
#define MK_SKIP_DA
#endif
#if (MK_NAIVE_ATTN & 2)
#define MK_SKIP_NA
#endif
#endif
namespace pg8 {
#define PG8_LAS __attribute__((address_space(3)))
typedef unsigned short bf16_t;
typedef short bf16x8 __attribute__((ext_vector_type(8)));
typedef float f32x4 __attribute__((ext_vector_type(4)));
typedef unsigned u32x4 __attribute__((ext_vector_type(4)));
constexpr int BM = 256, BK = 64, HALF = 128, HTB = HALF * BK * 2  , STAGE_BYTES = 8 * HTB, NXCD = 8, WGM = 8;

__host__ __device__ __forceinline__ int lds_byte(int r, int c) { const int st = (r >> 4) * 2 + (c >> 5), rr = r & 15, cc = c & 31, ob = rr * 64 + cc * 2; return st * 1024 + (ob ^ (((ob >> 9) & 1) << 5)); }
__host__ __device__ __forceinline__ void stage_rc(int b, int& R, int& C) { const int st = b / 1024, sb = b % 1024, swz = sb ^ (((sb >> 9) & 1) << 5); R = (st >> 1) * 16 + swz / 64; C = (st & 1) * 32 + (swz % 64) / 2; }
__host__ __device__ __forceinline__ int perm32(int rho) { const int n = rho >> 4, i = rho & 15; return 8 * (i >> 2) + 4 * n + (i & 3); }

struct Unit { int pm, pn; int skip; };
struct Gemm { const bf16_t* A; const bf16_t* Bt; int M, N, K; int k0 = 0; };

struct StaticOrder {
    int nM, nN, nwg, G, c, rot;
    __host__ __device__ void init(int M, int N, int G_, int c_, int rot_ = 0) { nM = M / BM; nN = N / BM; nwg = nM * nN; G = G_; c = c_; rot = rot_; }
    __host__ __device__ bool next(int i, Unit& u) const {
        const long L = (long)i * G + c; if (L >= nwg) return false;
        int wgid = (int)L; { const int q = nwg / NXCD, r = nwg % NXCD, xcd = wgid % NXCD, off = wgid / NXCD; wgid = (xcd < r ? xcd * (q + 1) : r * (q + 1) + (xcd - r) * q) + off; }
        const int nig = WGM * nN, gid = wgid / nig, fm = gid * WGM, gsz = (nM - fm) < WGM ? (nM - fm) : WGM;
        u.pm = fm + ((wgid % nig) % gsz); u.pn = ((wgid % nig) / gsz + rot) % nN; u.skip = 0; return true;
    }
    __device__ __forceinline__ void a_ready(const Unit&) const {}
    __device__ __forceinline__ void done(const Unit&) const {}
};
struct DupOrder : StaticOrder {
    __host__ __device__ bool next(int i, Unit& u) const { const bool r = StaticOrder::next(i >> 1, u); u.skip = (i & 1) ? 0 : 1; return r; }
};
__device__ __forceinline__ unsigned cvt_pk_bf16(float lo, float hi) { unsigned r; asm volatile("v_cvt_pk_bf16_f32 %0, %1, %2" : "=v"(r) : "v"(lo), "v"(hi)); return r; }
__device__ __forceinline__ float sigmoidf_fast(float v) { return __builtin_amdgcn_rcpf(1.0f + __builtin_amdgcn_exp2f(-1.4426950408889634f * v)); }
constexpr int M_ROWS = 16384;
__device__ __forceinline__ void store16_sc1(void* p, u32x4 v) { asm volatile("global_store_dwordx4 %0, %1, off sc1\n\ts_nop 1" :: "v"(p), "v"(v) : "memory"); }

struct EpiBf16Plain {
    static constexpr bool PERM = true, AFTER_DRAIN = false; static constexpr int NSTORES = 16;
    bf16_t* O; int ldc;
    __device__ __forceinline__ const char* tail_a(const Unit&, const char* d) const { return d; }
    __device__ __forceinline__ const char* tail_b(const Unit&, const char* d) const { return d; }
    __device__ __forceinline__ void operator()(const f32x4 (&acc)[2][2][4][2], const Unit& u, int wr, int wc, int fr, int fq) const {
        const int row0 = u.pm * BM + wr * 64 + fr, col0 = u.pn * BM + wc * 32 + 8 * fq;
#pragma unroll
        for (int ai = 0; ai < 2; ++ai)
#pragma unroll
            for (int m = 0; m < 4; ++m) { bf16_t* rowp = O + (size_t)(row0 + ai * HALF + m * 16) * ldc + col0;
#pragma unroll
                for (int bj = 0; bj < 2; ++bj) { const f32x4 v0 = acc[ai][bj][m][0], v1 = acc[ai][bj][m][1];
                    u32x4 w; w.x = cvt_pk_bf16(v0[0], v0[1]); w.y = cvt_pk_bf16(v0[2], v0[3]); w.z = cvt_pk_bf16(v1[0], v1[1]); w.w = cvt_pk_bf16(v1[2], v1[3]);
                    *(u32x4*)(rowp + bj * HALF) = w; } }
    }
};

struct EpiProj {
    static constexpr bool PERM = true, AFTER_DRAIN = false; static constexpr int NSTORES = 16;
    bf16_t* buf;
    const float* gains;
    __device__ __forceinline__ const char* tail_a(const Unit&, const char* d) const { return d; }
    __device__ __forceinline__ const char* tail_b(const Unit&, const char* d) const { return d; }
    __device__ __forceinline__ void operator()(const f32x4 (&acc)[2][2][4][2], const Unit& u, int wr, int wc, int fr, int fq) const {
#if defined(MK_TBAL)
        const int t0_ = u.pn >> 1, type = t0_ >= 6 ? (t0_ ^ 1) : t0_, half = u.pn & 1;
#else
        const int type = u.pn >> 1, half = u.pn & 1;
#endif
        if (u.skip) return;
        bf16_t* base = buf + (size_t)type * ((size_t)M_ROWS * 512);
        const int row0 = u.pm * BM + wr * 64 + fr;
        const int lc0 = half * 256 + 64 * wc + 8 * fq;
        if (type == 0 || type == 1 || type == 4 || type == 5) {
            const float* g = gains + ((type & 1) + (type >> 2) * 2) * 64;
#if defined(MK_EPIBATCH)
            f32x4 gq_[2][2];
#pragma unroll
            for (int bj = 0; bj < 2; ++bj) { gq_[bj][0] = *(const f32x4*)(g + 32 * bj + 8 * fq); gq_[bj][1] = *(const f32x4*)(g + 32 * bj + 8 * fq + 4); }
#endif
#if defined(MK_EPIFAST)
            float rs_[2][4];
#pragma unroll
            for (int ai = 0; ai < 2; ++ai)
#pragma unroll
                for (int m = 0; m < 4; ++m) { float ss = 0.f;
#pragma unroll
                    for (int bj = 0; bj < 2; ++bj)
#pragma unroll
                        for (int n = 0; n < 2; ++n) { const f32x4 x = acc[ai][bj][m][n]; ss += (x[0] * x[0] + x[1] * x[1]) + (x[2] * x[2] + x[3] * x[3]); }
                    typedef unsigned u32x2_ __attribute__((ext_vector_type(2)));
                    const u32x2_ r1 = __builtin_amdgcn_permlane16_swap(__float_as_uint(ss), __float_as_uint(ss), false, false);
                    const float t1 = __uint_as_float(r1.x) + __uint_as_float(r1.y);
                    const u32x2_ r2 = __builtin_amdgcn_permlane32_swap(__float_as_uint(t1), __float_as_uint(t1), false, false);
                    rs_[ai][m] = rsqrtf((__uint_as_float(r2.x) + __uint_as_float(r2.y)) * (1.0f / 64.0f) + 1e-6f); }
#pragma unroll
            for (int ai = 0; ai < 2; ++ai)
#pragma unroll
                for (int m = 0; m < 4; ++m) { const float rs = rs_[ai][m];
                    bf16_t* rowp = base + (size_t)(row0 + ai * HALF + m * 16) * 512 + lc0;
#pragma unroll
                    for (int bj = 0; bj < 2; ++bj) {
                        const f32x4 g0 = gq_[bj][0], g1 = gq_[bj][1];
                        const f32x4 v0 = acc[ai][bj][m][0] * rs * g0, v1 = acc[ai][bj][m][1] * rs * g1;
                        u32x4 w; w.x = cvt_pk_bf16(v0[0], v0[1]); w.y = cvt_pk_bf16(v0[2], v0[3]); w.z = cvt_pk_bf16(v1[0], v1[1]); w.w = cvt_pk_bf16(v1[2], v1[3]);
                        *(u32x4*)(rowp + 32 * bj) = w; } }
#else
#pragma unroll
            for (int ai = 0; ai < 2; ++ai)
#pragma unroll
                for (int m = 0; m < 4; ++m) {
                    float ss = 0.f;
#pragma unroll
                    for (int bj = 0; bj < 2; ++bj)
#pragma unroll
                        for (int n = 0; n < 2; ++n) { const f32x4 x = acc[ai][bj][m][n]; ss += (x[0] * x[0] + x[1] * x[1]) + (x[2] * x[2] + x[3] * x[3]); }
                    ss += __shfl_xor(ss, 16); ss += __shfl_xor(ss, 32);
                    const float rs = rsqrtf(ss * (1.0f / 64.0f) + 1e-6f);
                    bf16_t* rowp = base + (size_t)(row0 + ai * HALF + m * 16) * 512 + lc0;
#pragma unroll
                    for (int bj = 0; bj < 2; ++bj) {
#if defined(MK_EPIBATCH)
                        const f32x4 g0 = gq_[bj][0], g1 = gq_[bj][1];
#else
                        const f32x4 g0 = *(const f32x4*)(g + 32 * bj + 8 * fq), g1 = *(const f32x4*)(g + 32 * bj + 8 * fq + 4);
#endif
                        const f32x4 v0 = acc[ai][bj][m][0] * rs * g0, v1 = acc[ai][bj][m][1] * rs * g1;
                        u32x4 w; w.x = cvt_pk_bf16(v0[0], v0[1]); w.y = cvt_pk_bf16(v0[2], v0[3]); w.z = cvt_pk_bf16(v1[0], v1[1]); w.w = cvt_pk_bf16(v1[2], v1[3]);
                        *(u32x4*)(rowp + 32 * bj) = w; }
                    asm volatile("" ::: "memory");
                }
#endif
        } else {
            const bool act = (type == 3 || type == 7);
#pragma unroll
            for (int ai = 0; ai < 2; ++ai)
#pragma unroll
                for (int m = 0; m < 4; ++m) { bf16_t* rowp = base + (size_t)(row0 + ai * HALF + m * 16) * 512 + lc0;
#pragma unroll
                    for (int bj = 0; bj < 2; ++bj) { f32x4 v0 = acc[ai][bj][m][0], v1 = acc[ai][bj][m][1];
                        if (act) {
#pragma unroll
                            for (int e = 0; e < 4; ++e) { v0[e] = v0[e] * sigmoidf_fast(v0[e]); v1[e] = v1[e] * sigmoidf_fast(v1[e]); } }
                        u32x4 w; w.x = cvt_pk_bf16(v0[0], v0[1]); w.y = cvt_pk_bf16(v0[2], v0[3]); w.z = cvt_pk_bf16(v1[0], v1[1]); w.w = cvt_pk_bf16(v1[2], v1[3]);
                        *(u32x4*)(rowp + 32 * bj) = w; } }
        }
    }
};

struct EpiX1 {
    static constexpr bool PERM = true, AFTER_DRAIN = false; static constexpr int NSTORES = 16;
    const float* x; float* x1; bf16_t* x1b; const float* inv;
#if defined(MK_TAILPF) && defined(MK_XNP) && !defined(MK_XNP_NOEPI)
    __device__ __forceinline__ const char* tail_b(const Unit& u, const char*) const { return (const char*)(x1b + (size_t)u.pm * BM * 1024 + (size_t)u.pn * BM); }
    __device__ __forceinline__ const char* tail_a(const Unit& u, const char*) const { return (const char*)(x1b + (size_t)u.pm * BM * 1024 + (size_t)u.pn * BM) + 256; }
#else
    __device__ __forceinline__ const char* tail_a(const Unit&, const char* d) const { return d; }
    __device__ __forceinline__ const char* tail_b(const Unit&, const char* d) const { return d; }
#endif
    __device__ __forceinline__ void operator()(const f32x4 (&acc)[2][2][4][2], const Unit& u, int wr, int wc, int fr, int fq) const {
        if (u.skip) return;
        const int row0 = u.pm * BM + wr * 64 + fr, col0 = u.pn * BM + wc * 32 + 8 * fq;
#if defined(MK_EPIBATCH) && defined(MK_XNP) && !defined(MK_XNP_NOEPI)
        u32x4 xw_[2][4][2]; float sc_[2][4];
#pragma unroll
        for (int ai = 0; ai < 2; ++ai)
#pragma unroll
            for (int m = 0; m < 4; ++m) { const size_t off = (size_t)(row0 + ai * HALF + m * 16) * 1024 + col0; sc_[ai][m] = inv[row0 + ai * HALF + m * 16];
#pragma unroll
                for (int bj = 0; bj < 2; ++bj) xw_[ai][m][bj] = __builtin_nontemporal_load((const u32x4*)(x1b + off + bj * HALF)); }
        asm volatile("" ::: "memory");
#pragma unroll
        for (int ai = 0; ai < 2; ++ai)
#pragma unroll
            for (int m = 0; m < 4; ++m) { const size_t off = (size_t)(row0 + ai * HALF + m * 16) * 1024 + col0; const float sc = sc_[ai][m];
#pragma unroll
                for (int bj = 0; bj < 2; ++bj) { const size_t o = off + bj * HALF; const u32x4 xw = xw_[ai][m][bj];
                    f32x4 v0 = acc[ai][bj][m][0], v1 = acc[ai][bj][m][1];
                    v0[0] += __uint_as_float(xw.x << 16) * sc; v0[1] += __uint_as_float(xw.x & 0xffff0000u) * sc; v0[2] += __uint_as_float(xw.y << 16) * sc; v0[3] += __uint_as_float(xw.y & 0xffff0000u) * sc;
                    v1[0] += __uint_as_float(xw.z << 16) * sc; v1[1] += __uint_as_float(xw.z & 0xffff0000u) * sc; v1[2] += __uint_as_float(xw.w << 16) * sc; v1[3] += __uint_as_float(xw.w & 0xffff0000u) * sc;
                    u32x4 w; w.x = cvt_pk_bf16(v0[0], v0[1]); w.y = cvt_pk_bf16(v0[2], v0[3]); w.z = cvt_pk_bf16(v1[0], v1[1]); w.w = cvt_pk_bf16(v1[2], v1[3]);
#if defined(MK_X1B_NT)
                    __builtin_nontemporal_store(w, (u32x4*)(x1b + o)); } }
#else
                    *(u32x4*)(x1b + o) = w; } }
#endif
        return;
#endif
#pragma unroll
        for (int ai = 0; ai < 2; ++ai)
#pragma unroll
            for (int m = 0; m < 4; ++m) { const size_t off = (size_t)(row0 + ai * HALF + m * 16) * 1024 + col0;
#if defined(MK_XNP) && !defined(MK_XNP_NOEPI)
                const float sc = inv[row0 + ai * HALF + m * 16];
#endif
#pragma unroll
                for (int bj = 0; bj < 2; ++bj) { const size_t o = off + bj * HALF;
#if defined(MK_XNP) && !defined(MK_XNP_NOEPI)
                    const u32x4 xw = __builtin_nontemporal_load((const u32x4*)(x1b + o));
                    f32x4 v0 = acc[ai][bj][m][0], v1 = acc[ai][bj][m][1];
                    v0[0] += __uint_as_float(xw.x << 16) * sc; v0[1] += __uint_as_float(xw.x & 0xffff0000u) * sc; v0[2] += __uint_as_float(xw.y << 16) * sc; v0[3] += __uint_as_float(xw.y & 0xffff0000u) * sc;
                    v1[0] += __uint_as_float(xw.z << 16) * sc; v1[1] += __uint_as_float(xw.z & 0xffff0000u) * sc; v1[2] += __uint_as_float(xw.w << 16) * sc; v1[3] += __uint_as_float(xw.w & 0xffff0000u) * sc;
#else
                    const f32x4 v0 = acc[ai][bj][m][0] + __builtin_nontemporal_load((const f32x4*)(x + o)), v1 = acc[ai][bj][m][1] + __builtin_nontemporal_load((const f32x4*)(x + o + 4));
#endif
#if defined(MK_X1_F32)
                    *(f32x4*)(x1 + o) = v0; *(f32x4*)(x1 + o + 4) = v1;
#endif
                    u32x4 w; w.x = cvt_pk_bf16(v0[0], v0[1]); w.y = cvt_pk_bf16(v0[2], v0[3]); w.z = cvt_pk_bf16(v1[0], v1[1]); w.w = cvt_pk_bf16(v1[2], v1[3]);
                    *(u32x4*)(x1b + o) = w; } }
    }
};

struct EpiFinal {
    static constexpr bool PERM = true, AFTER_DRAIN = false; static constexpr int NSTORES = 16;
    float* out; const bf16_t* pp; const bf16_t* x1b;
#if defined(MK_TAILPF)
    __device__ __forceinline__ const char* tail_b(const Unit& u, const char*) const { return (const char*)(pp + (size_t)u.pm * BM * 1024 + (size_t)u.pn * BM); }
    __device__ __forceinline__ const char* tail_a(const Unit& u, const char*) const { return (const char*)(pp + (size_t)u.pm * BM * 1024 + (size_t)u.pn * BM) + 256; }
#else
    __device__ __forceinline__ const char* tail_a(const Unit&, const char* d) const { return d; }
    __device__ __forceinline__ const char* tail_b(const Unit&, const char* d) const { return d; }
#endif
    __device__ __forceinline__ void operator()(const f32x4 (&acc)[2][2][4][2], const Unit& u, int wr, int wc, int fr, int fq) const {
        if (u.skip) return;
        const int row0 = u.pm * BM + wr * 64 + fr, col0 = u.pn * BM + wc * 32 + 8 * fq;
#if defined(MK_EPIBATCH) && !defined(MK_X1_F32)
#ifndef MK_DUPEPI4
#define MK_DUPEPI4 1
#endif
#pragma unroll
        for (int de_ = 0; de_ < MK_DUPEPI4; ++de_)
#pragma unroll
        for (int ai = 0; ai < 2; ++ai) {
            u32x4 pw_[4][2], xq_[4][2];
#pragma unroll
            for (int m = 0; m < 4; ++m) { const size_t off = (size_t)(row0 + ai * HALF + m * 16) * 1024 + col0;
#pragma unroll
                for (int bj = 0; bj < 2; ++bj) { pw_[m][bj] = __builtin_nontemporal_load((const u32x4*)(pp + off + bj * HALF)); xq_[m][bj] = *(const u32x4*)(x1b + off + bj * HALF); } }
            asm volatile("" ::: "memory");
#pragma unroll
            for (int m = 0; m < 4; ++m) { const size_t off = (size_t)(row0 + ai * HALF + m * 16) * 1024 + col0;
#pragma unroll
                for (int bj = 0; bj < 2; ++bj) { const size_t o = off + bj * HALF; const u32x4 pw = pw_[m][bj], xw = xq_[m][bj];
                    f32x4 p0, p1, v0, v1;
                    p0[0] = __uint_as_float(pw.x << 16); p0[1] = __uint_as_float(pw.x & 0xffff0000u); p0[2] = __uint_as_float(pw.y << 16); p0[3] = __uint_as_float(pw.y & 0xffff0000u);
                    p1[0] = __uint_as_float(pw.z << 16); p1[1] = __uint_as_float(pw.z & 0xffff0000u); p1[2] = __uint_as_float(pw.w << 16); p1[3] = __uint_as_float(pw.w & 0xffff0000u);
                    v0[0] = __uint_as_float(xw.x << 16); v0[1] = __uint_as_float(xw.x & 0xffff0000u); v0[2] = __uint_as_float(xw.y << 16); v0[3] = __uint_as_float(xw.y & 0xffff0000u);
                    v1[0] = __uint_as_float(xw.z << 16); v1[1] = __uint_as_float(xw.z & 0xffff0000u); v1[2] = __uint_as_float(xw.w << 16); v1[3] = __uint_as_float(xw.w & 0xffff0000u);
                    const f32x4 a0 = acc[ai][bj][m][0], a1 = acc[ai][bj][m][1];
#pragma unroll
                    for (int e_ = 0; e_ < 4; ++e_) { v0[e_] += sigmoidf_fast(a0[e_]) * p0[e_]; v1[e_] += sigmoidf_fast(a1[e_]) * p1[e_]; }
#if defined(MK_OUT_PLAIN)
                    *(f32x4*)(out + o) = v0; *(f32x4*)(out + o + 4) = v1; } }
#elif defined(MK_OUTSWZ)
                    { typedef unsigned u32x2_ __attribute__((ext_vector_type(2)));
                      f32x4 w0, w1;
#pragma unroll
                      for (int e_ = 0; e_ < 4; ++e_) { const u32x2_ s1 = __builtin_amdgcn_permlane16_swap(__float_as_uint(v0[e_]), __float_as_uint(v1[e_]), false, false);
                          const u32x2_ s2 = __builtin_amdgcn_permlane32_swap(s1.x, s1.y, false, false); w0[e_] = __uint_as_float(s2.x); w1[e_] = __uint_as_float(s2.y); }
                      float* ob = out + (o - 8 * fq) + 4 * fq;
                      __builtin_nontemporal_store(w0, (f32x4*)ob); __builtin_nontemporal_store(w1, (f32x4*)(ob + 16)); } } }
#else
                    __builtin_nontemporal_store(v0, (f32x4*)(out + o)); __builtin_nontemporal_store(v1, (f32x4*)(out + o + 4)); } }
#endif
        }
        return;
#endif
#pragma unroll
        for (int ai = 0; ai < 2; ++ai)
#pragma unroll
            for (int m = 0; m < 4; ++m) { const size_t off = (size_t)(row0 + ai * HALF + m * 16) * 1024 + col0;
#pragma unroll
                for (int bj = 0; bj < 2; ++bj) { const size_t o = off + bj * HALF;
                    const u32x4 pw = __builtin_nontemporal_load((const u32x4*)(pp + o));
                    f32x4 p0, p1;
                    p0[0] = __uint_as_float(pw.x << 16); p0[1] = __uint_as_float(pw.x & 0xffff0000u); p0[2] = __uint_as_float(pw.y << 16); p0[3] = __uint_as_float(pw.y & 0xffff0000u);
                    p1[0] = __uint_as_float(pw.z << 16); p1[1] = __uint_as_float(pw.z & 0xffff0000u); p1[2] = __uint_as_float(pw.w << 16); p1[3] = __uint_as_float(pw.w & 0xffff0000u);
#if defined(MK_X1_F32)
                    f32x4 v0 = *(const f32x4*)(out + o), v1 = *(const f32x4*)(out + o + 4);
#else
                    const u32x4 xw = *(const u32x4*)(x1b + o);
                    f32x4 v0, v1;
                    v0[0] = __uint_as_float(xw.x << 16); v0[1] = __uint_as_float(xw.x & 0xffff0000u); v0[2] = __uint_as_float(xw.y << 16); v0[3] = __uint_as_float(xw.y & 0xffff0000u);
                    v1[0] = __uint_as_float(xw.z << 16); v1[1] = __uint_as_float(xw.z & 0xffff0000u); v1[2] = __uint_as_float(xw.w << 16); v1[3] = __uint_as_float(xw.w & 0xffff0000u);
#endif
                    const f32x4 a0 = acc[ai][bj][m][0], a1 = acc[ai][bj][m][1];
#pragma unroll
                    for (int e = 0; e < 4; ++e) { v0[e] += sigmoidf_fast(a0[e]) * p0[e]; v1[e] += sigmoidf_fast(a1[e]) * p1[e]; }
                    __builtin_nontemporal_store(v0, (f32x4*)(out + o)); __builtin_nontemporal_store(v1, (f32x4*)(out + o + 4)); } }
    }
};

template <class Epi, class Sched, bool ALIGN_EPI = false, bool SP2 = false>
__device__ __forceinline__ void gemm_phase(PG8_LAS unsigned char* lds, const Gemm g, const Sched& S, const Epi& E, const int wave_id) {
    const int wid = wave_id, lane = mk_lane(), tid = wid * 64 + lane, wr = wid >> 2, wc = wid & 3, fr = lane & 15, fq = lane >> 4;
    const int K = g.K, nt = K / BK;
    unsigned voffA[2], voffB[2];
#pragma unroll
    for (int i = 0; i < 2; ++i) { int R, C; stage_rc(tid * 16 + i * 8192, R, C); const int Rb = Epi::PERM ? ((R & ~31) + perm32(R & 31)) : R;
        voffA[i] = (unsigned)(R * K + C) * 2u; voffB[i] = (unsigned)(Rb * K + C) * 2u; }
    const size_t kstep = (size_t)(BK * 2);
    const int k0r = g.k0; const ptrdiff_t krot = (ptrdiff_t)k0r * (ptrdiff_t)kstep;
#define PG8_KOFF(j) ((ptrdiff_t)((((j) + k0r) & (nt - 1))) * (ptrdiff_t)kstep - krot)
    const size_t hstep = (size_t)HALF * K * 2;
    const size_t tstep = 2 * hstep;
    const unsigned ldsw = (unsigned)wid * 1024u;
    const int aoff = lds_byte(wr * 64 + fr, fq * 8), boff = lds_byte(wc * 32 + fr, fq * 8);
#define PG8_SA(b, h) (((b) * 2 + (h)) * HTB)
#define PG8_SB(b, h) ((4 + (b) * 2 + (h)) * HTB)
#define PG8_STAGE(bufoff, gbase, voff) do { _Pragma("unroll") for (int _i = 0; _i < 2; ++_i) \
        __builtin_amdgcn_global_load_lds((const unsigned*)((const char*)(gbase) + (voff)[_i]), (PG8_LAS unsigned*)(lds + (bufoff) + ldsw + _i * 8192), 16, 0, 0); } while (0)
#define PG8_LDA(dst, b, h) do { _Pragma("unroll") for (int m = 0; m < 4; ++m) _Pragma("unroll") for (int k = 0; k < 2; ++k) dst[m][k] = *(const PG8_LAS bf16x8*)(lds + PG8_SA(b, h) + aoff + m * 2048 + k * 1024); } while (0)
#define PG8_LDB(dst, b, h) do { _Pragma("unroll") for (int n = 0; n < 2; ++n) _Pragma("unroll") for (int k = 0; k < 2; ++k) dst[n][k] = *(const PG8_LAS bf16x8*)(lds + PG8_SB(b, h) + boff + n * 2048 + k * 1024); } while (0)
#define PG8_MMA(ai, bj, At, Bt) do { __builtin_amdgcn_s_setprio(1); _Pragma("unroll") for (int m = 0; m < 4; ++m) _Pragma("unroll") for (int n = 0; n < 2; ++n) _Pragma("unroll") for (int k = 0; k < 2; ++k) \
        acc[ai][bj][m][n] = __builtin_amdgcn_mfma_f32_16x16x32_bf16(Bt[n][k], At[m][k], acc[ai][bj][m][n], 0, 0, 0); __builtin_amdgcn_s_setprio(0); } while (0)
#define PG8_WAIT_V(n) asm volatile("s_waitcnt vmcnt(" #n ")" ::: "memory")
#define PG8_WAIT_V8E(f) do { static_assert(Epi::NSTORES == 16, "epilogue stores per lane"); asm volatile("s_cmp_eq_u32 %0, 0\n\ts_cbranch_scc1 1f\n\ts_waitcnt vmcnt(24)\n\ts_branch 2f\n1:\n\ts_waitcnt vmcnt(8)\n2:" :: "s"(f) : "scc", "memory"); } while (0)
#define PG8_WAIT_L(n) asm volatile("s_waitcnt lgkmcnt(" #n ")" ::: "memory")
#define PG8_BAR __builtin_amdgcn_s_barrier()
#define PG8_SCHED __builtin_amdgcn_sched_barrier(0)
    Unit cur, nxt; int ui = 0;
    if (!S.next(0, cur)) return;
    f32x4 acc[2][2][4][2];
#pragma unroll
    for (int a = 0; a < 2; ++a)
#pragma unroll
        for (int b = 0; b < 2; ++b)
#pragma unroll
            for (int m = 0; m < 4; ++m)
#pragma unroll
                for (int n = 0; n < 2; ++n) acc[a][b][m][n] = (f32x4){0.f, 0.f, 0.f, 0.f};
    bf16x8 At[4][2], B0[2][2], B1[2][2];
    const char* cA = (const char*)g.A + (size_t)cur.pm * tstep + krot; const char* cB = (const char*)g.Bt + (size_t)cur.pn * tstep + krot;
    S.a_ready(cur);
    if constexpr (SP2) {
        PG8_STAGE(PG8_SB(0, 0), cB, voffB); PG8_STAGE(PG8_SB(0, 1), cB + hstep, voffB); PG8_STAGE(PG8_SA(0, 0), cA, voffA); PG8_STAGE(PG8_SA(0, 1), cA + hstep, voffA);
        if (wr == 1) PG8_BAR;
        PG8_WAIT_V(2); PG8_BAR;
        PG8_STAGE(PG8_SB(1, 0), cB + kstep, voffB); PG8_STAGE(PG8_SA(1, 0), cA + kstep, voffA); PG8_STAGE(PG8_SB(1, 1), cB + hstep + kstep, voffB);
        PG8_WAIT_V(6); PG8_BAR;
    } else {
        PG8_STAGE(PG8_SB(0, 0), cB, voffB); PG8_STAGE(PG8_SA(0, 0), cA, voffA); PG8_STAGE(PG8_SB(0, 1), cB + hstep, voffB); PG8_STAGE(PG8_SA(0, 1), cA + hstep, voffA);
        if (wr == 1) PG8_BAR;
        PG8_WAIT_V(4); PG8_BAR;
        PG8_STAGE(PG8_SB(1, 0), cB + kstep, voffB); PG8_STAGE(PG8_SA(1, 0), cA + kstep, voffA); PG8_STAGE(PG8_SB(1, 1), cB + hstep + kstep, voffB);
        PG8_WAIT_V(6); PG8_BAR;
    }
    for (;;) {
        const bool has_next = S.next(ui + 1, nxt);
        const char* nA = has_next ? (const char*)g.A + (size_t)nxt.pm * tstep + krot : E.tail_a(cur, cA); const char* nB = has_next ? (const char*)g.Bt + (size_t)nxt.pn * tstep + krot : E.tail_b(cur, cB);
        for (int t = 0; t < nt; t += 2) {
            const bool last = (t == nt - 2);
            const char* a1 = cA + PG8_KOFF(t + 1);
            const char* a2 = last ? nA : cA + PG8_KOFF(t + 2); const char* b2 = last ? nB : cB + PG8_KOFF(t + 2);
            const char* a3 = a2 + kstep; const char* b3 = b2 + kstep;
            if (last && has_next) S.a_ready(nxt);
#if defined(MK_VMRELAX)
            const int fae_ = __builtin_amdgcn_readfirstlane((t == 0 && ui > 0) ? 1 : 0);
#else
            const int fae_ = 0;
#endif
            if constexpr (SP2) {
            PG8_LDB(B0, 0, 0); PG8_LDB(B1, 0, 1); PG8_SCHED; PG8_LDA(At, 0, 0); PG8_STAGE(PG8_SA(1, 1), a1 + hstep, voffA);
            PG8_WAIT_V8E(fae_); PG8_WAIT_L(0); PG8_BAR; PG8_MMA(0, 0, At, B0); PG8_MMA(0, 1, At, B1); PG8_BAR; PG8_SCHED;
            PG8_LDA(At, 0, 1); PG8_STAGE(PG8_SB(0, 0), b2, voffB); PG8_STAGE(PG8_SB(0, 1), b2 + hstep, voffB); PG8_STAGE(PG8_SA(0, 0), a2, voffA);
            PG8_WAIT_V8E(fae_); PG8_WAIT_L(0); PG8_BAR; PG8_MMA(1, 0, At, B0); PG8_MMA(1, 1, At, B1); PG8_BAR; PG8_SCHED;
            PG8_LDB(B0, 1, 0); PG8_LDB(B1, 1, 1); PG8_SCHED; PG8_LDA(At, 1, 0); PG8_STAGE(PG8_SA(0, 1), a2 + hstep, voffA);
            PG8_WAIT_V(8); PG8_WAIT_L(0); PG8_BAR; PG8_MMA(0, 0, At, B0); PG8_MMA(0, 1, At, B1); PG8_BAR; PG8_SCHED;
            PG8_LDA(At, 1, 1); PG8_STAGE(PG8_SB(1, 0), b3, voffB); PG8_STAGE(PG8_SB(1, 1), b3 + hstep, voffB); PG8_STAGE(PG8_SA(1, 0), a3, voffA);
            PG8_WAIT_V(8); PG8_WAIT_L(0); PG8_BAR; PG8_MMA(1, 0, At, B0); PG8_MMA(1, 1, At, B1); PG8_BAR; PG8_SCHED;
            } else {
            PG8_LDB(B0, 0, 0); PG8_SCHED; PG8_LDA(At, 0, 0); PG8_STAGE(PG8_SA(1, 1), a1 + hstep, voffA);
            PG8_WAIT_L(8); PG8_BAR; PG8_WAIT_L(0); PG8_MMA(0, 0, At, B0); PG8_BAR; PG8_SCHED;
            PG8_LDB(B1, 0, 1); PG8_STAGE(PG8_SB(0, 0), b2, voffB);
            PG8_BAR; PG8_WAIT_L(0); PG8_MMA(0, 1, At, B1); PG8_BAR;
            PG8_LDA(At, 0, 1); PG8_STAGE(PG8_SA(0, 0), a2, voffA);
            PG8_BAR; PG8_WAIT_L(0); PG8_MMA(1, 0, At, B0); PG8_BAR; PG8_SCHED;
            PG8_STAGE(PG8_SB(0, 1), b2 + hstep, voffB);
            PG8_WAIT_V(6); PG8_BAR; PG8_MMA(1, 1, At, B1); PG8_BAR;
            PG8_LDB(B0, 1, 0); PG8_SCHED; PG8_LDA(At, 1, 0); PG8_STAGE(PG8_SA(0, 1), a2 + hstep, voffA);
            PG8_WAIT_L(8); PG8_BAR; PG8_WAIT_L(0); PG8_MMA(0, 0, At, B0); PG8_BAR; PG8_SCHED;
            PG8_LDB(B1, 1, 1); PG8_STAGE(PG8_SB(1, 0), b3, voffB);
            PG8_BAR; PG8_WAIT_L(0); PG8_MMA(0, 1, At, B1); PG8_BAR;
            PG8_LDA(At, 1, 1); PG8_STAGE(PG8_SA(1, 0), a3, voffA);
            PG8_BAR; PG8_WAIT_L(0); PG8_MMA(1, 0, At, B0); PG8_BAR; PG8_SCHED;
            PG8_STAGE(PG8_SB(1, 1), b3 + hstep, voffB);
            PG8_WAIT_V(6); PG8_BAR; PG8_MMA(1, 1, At, B1); PG8_BAR;
            }
        }
        if constexpr (ALIGN_EPI) { if (wr == 0) PG8_BAR; }
        if constexpr (!Epi::AFTER_DRAIN) { E(acc, cur, wr, wc, fr, fq); S.done(cur); }
        if (!has_next) break;
#pragma unroll
        for (int a = 0; a < 2; ++a)
#pragma unroll
            for (int b = 0; b < 2; ++b)
#pragma unroll
                for (int m = 0; m < 4; ++m)
#pragma unroll
                    for (int n = 0; n < 2; ++n) acc[a][b][m][n] = (f32x4){0.f, 0.f, 0.f, 0.f};
        cur = nxt; cA = nA; cB = nB; ++ui;
        if constexpr (ALIGN_EPI) { if (wr == 1) PG8_BAR; }
    }
    PG8_WAIT_V(0);
    if constexpr (!ALIGN_EPI) { if (wr == 0) PG8_BAR; }
    PG8_BAR;
    if constexpr (Epi::AFTER_DRAIN) { E.fused(acc, cur, wr, wc, fr, fq, lds, wid, lane); S.done(cur); }
#undef PG8_KOFF
#undef PG8_SA
#undef PG8_SB
#undef PG8_STAGE
#undef PG8_LDA
#undef PG8_LDB
#undef PG8_MMA
#undef PG8_WAIT_V
#undef PG8_WAIT_V8E
#undef PG8_WAIT_L
#undef PG8_BAR
#undef PG8_SCHED
}
}
#ifndef DA_MFMA_SUM
#define DA_MFMA_SUM 1
#endif
namespace da {
#if defined(DA_SETPRIO)
#define DA_PRIO(x) __builtin_amdgcn_s_setprio(x)
#else
#define DA_PRIO(x) do {} while (0)
#endif
using bf16x8 = __attribute__((ext_vector_type(8))) short;
using s16x4  = __attribute__((ext_vector_type(4))) short;
using f32x16 = __attribute__((ext_vector_type(16))) float;
using f32x4  = __attribute__((ext_vector_type(4))) float;
using u32x4  = __attribute__((ext_vector_type(4))) unsigned;
typedef unsigned short bf16_t;
constexpr int SEQ = 2048, QROWS = 128, KVBLK = 64, NT = SEQ / KVBLK;
constexpr int SHM_V = 16384, SHM_K = 16384;
constexpr int NSLOT = 3, LDS_K = 0, LDS_V = NSLOT * SHM_K, LDS_OST = 0, OSTRIDE = 132, LDS_TBL = 2 * NSLOT * SHM_K, LDS_WS = LDS_TBL + 2048, LDS_END = LDS_WS + 8 * 128;
constexpr float LOG2E = 1.4426950408889634f;
#define DA_KSWZ(row, colB) ((row) * 256 + ((colB) ^ (((row) & 15) << 4)))
#define DA_SBAR() __builtin_amdgcn_sched_barrier(0)
__device__ __forceinline__ int crow(int r, int hi) { return (r & 3) + 8 * (r >> 2) + 4 * hi; }
__device__ __forceinline__ unsigned cvtpk(float lo, float hi) { unsigned r; asm volatile("v_cvt_pk_bf16_f32 %0, %1, %2" : "=v"(r) : "v"(lo), "v"(hi)); return r; }
__device__ __forceinline__ float bf2f(unsigned short v) { return __uint_as_float(((unsigned)v) << 16); }
__device__ __forceinline__ int t5_bucket(int rel) {
    const int ret = rel > 0 ? 16 : 0; const int n = rel < 0 ? -rel : rel;
    int v;
    if (n < 8) v = n; else { const int l2 = 31 - __builtin_clz((unsigned)(n * n)); v = 8 + (l2 - 6); v = v < 15 ? v : 15; }
    return ret + v;
}
__device__ __forceinline__ void qkt(f32x16& p0, f32x16& p1, const char* Ks, const bf16x8* qr, int r32, int hi, int mapB) {
    p0 = f32x16{}; p1 = f32x16{};
#pragma unroll
    for (int d0 = 0; d0 < 4; ++d0) { const int cb = mapB + (d0 * 16 + hi * 8) * 2;
        const bf16x8 b0 = *reinterpret_cast<const bf16x8*>(Ks + DA_KSWZ(r32, cb));
        const bf16x8 b1 = *reinterpret_cast<const bf16x8*>(Ks + DA_KSWZ(32 + r32, cb));
        p0 = __builtin_amdgcn_mfma_f32_32x32x16_bf16(b0, qr[d0], p0, 0, 0, 0);
        p1 = __builtin_amdgcn_mfma_f32_32x32x16_bf16(b1, qr[d0], p1, 0, 0, 0); }
}
__device__ __forceinline__ void addbias(f32x16& p0, f32x16& p1, const float* tbl, int tb) {
#pragma unroll
    for (int r = 0; r < 16; ++r) { p0[r] += tbl[tb + (r & 3) + 8 * (r >> 2)]; p1[r] += tbl[tb + 32 + (r & 3) + 8 * (r >> 2)]; }
}
__device__ __forceinline__ void exp_half(f32x16& p) {
#pragma unroll
    for (int r = 0; r < 16; ++r) p[r] = __builtin_amdgcn_exp2f(p[r]);
}
__device__ __forceinline__ void finishSM(f32x16& p0, f32x16& p1, float& l_reg, bf16x8& pa0, bf16x8& pa1, bf16x8& pa2, bf16x8& pa3) {
    exp_half(p1);
#if !DA_MFMA_SUM
    { float ps = 0.f;
      _Pragma("unroll") for (int r = 0; r < 16; ++r) ps += p0[r];
      _Pragma("unroll") for (int r = 0; r < 16; ++r) ps += p1[r];
      l_reg += ps; }
#endif
#define DA_PK8(P, BASE, OUT) do { u32x4 w = {cvtpk(P[BASE + 0], P[BASE + 1]), cvtpk(P[BASE + 2], P[BASE + 3]), cvtpk(P[BASE + 4], P[BASE + 5]), cvtpk(P[BASE + 6], P[BASE + 7])}; OUT = *reinterpret_cast<bf16x8*>(&w); } while (0)
    DA_PK8(p0, 0, pa0); DA_PK8(p0, 8, pa1); DA_PK8(p1, 0, pa2); DA_PK8(p1, 8, pa3);
#undef DA_PK8
}
__device__ __forceinline__ int v_st(int k, int c) { const int kk = k; return ((kk >> 3) * 4 + (c >> 5)) * 512 + ((kk & 7) * 32 + (c & 31)) * 2; }
__device__ __forceinline__ int v_rd_base(int lane) { return ((lane & 3) << 3) | (((lane >> 2) & 3) << 6) | (((lane >> 4) & 1) << 5) | (((lane >> 5) & 1) << 8); }
constexpr int v_rd_off(int d0, int ks, int half) { return d0 * 512 + ks * 4096 + half * 2048; }
template <int OFF> __device__ __forceinline__ s16x4 tr_read(int vb) {
    s16x4 r; asm volatile("ds_read_b64_tr_b16 %0, %1 offset:%2" : "=&v"(r) : "v"(vb), "i"(OFF) : "memory"); return r;
}
#define DA_TRD(D0, L0, H0, L1, H1, L2, H2, L3, H3) do { L0 = tr_read<v_rd_off(D0, 0, 0)>(vb); H0 = tr_read<v_rd_off(D0, 0, 1)>(vb); L1 = tr_read<v_rd_off(D0, 1, 0)>(vb); H1 = tr_read<v_rd_off(D0, 1, 1)>(vb); \
    L2 = tr_read<v_rd_off(D0, 2, 0)>(vb); H2 = tr_read<v_rd_off(D0, 2, 1)>(vb); L3 = tr_read<v_rd_off(D0, 3, 0)>(vb); H3 = tr_read<v_rd_off(D0, 3, 1)>(vb); } while (0)
#define DA_PK(L, H) (bf16x8){L[0], L[1], L[2], L[3], H[0], H[1], H[2], H[3]}
#define DA_MM4(OD, L0, H0, L1, H1, L2, H2, L3, H3) do { DA_PRIO(1); OD = __builtin_amdgcn_mfma_f32_32x32x16_bf16(pa0, DA_PK(L0, H0), OD, 0, 0, 0); OD = __builtin_amdgcn_mfma_f32_32x32x16_bf16(pa1, DA_PK(L1, H1), OD, 0, 0, 0); \
    OD = __builtin_amdgcn_mfma_f32_32x32x16_bf16(pa2, DA_PK(L2, H2), OD, 0, 0, 0); OD = __builtin_amdgcn_mfma_f32_32x32x16_bf16(pa3, DA_PK(L3, H3), OD, 0, 0, 0); DA_PRIO(0); } while (0)
#define DA_EX4(B) do { e[B] = __builtin_amdgcn_exp2f(e[B]); e[B + 1] = __builtin_amdgcn_exp2f(e[B + 1]); e[B + 2] = __builtin_amdgcn_exp2f(e[B + 2]); e[B + 3] = __builtin_amdgcn_exp2f(e[B + 3]); } while (0)
template <class H1, class H2>
__device__ __forceinline__ void pv_d0(f32x16* o, int vb, bf16x8 pa0, bf16x8 pa1, bf16x8 pa2, bf16x8 pa3, bf16x8 ones, f32x16& e, const H1& h1, const H2& h2) {
    s16x4 a0, a1, a2, a3, a4, a5, a6, a7, b0, b1, b2, b3, b4, b5, b6, b7;
    DA_TRD(0, a0, a1, a2, a3, a4, a5, a6, a7);
    DA_TRD(1, b0, b1, b2, b3, b4, b5, b6, b7);
#if DA_MFMA_SUM
    o[4] = __builtin_amdgcn_mfma_f32_32x32x16_bf16(pa0, ones, o[4], 0, 0, 0); o[4] = __builtin_amdgcn_mfma_f32_32x32x16_bf16(pa1, ones, o[4], 0, 0, 0);
#endif
    asm volatile("s_waitcnt lgkmcnt(8)" ::: "memory"); DA_SBAR();
    DA_MM4(o[0], a0, a1, a2, a3, a4, a5, a6, a7); DA_EX4(0);
    DA_SBAR(); h1(); DA_TRD(2, a0, a1, a2, a3, a4, a5, a6, a7);
    asm volatile("s_waitcnt lgkmcnt(8)" ::: "memory"); DA_SBAR();
    DA_MM4(o[1], b0, b1, b2, b3, b4, b5, b6, b7); DA_EX4(4);
    DA_SBAR(); h2(); DA_TRD(3, b0, b1, b2, b3, b4, b5, b6, b7);
#if DA_MFMA_SUM
    o[4] = __builtin_amdgcn_mfma_f32_32x32x16_bf16(pa2, ones, o[4], 0, 0, 0); o[4] = __builtin_amdgcn_mfma_f32_32x32x16_bf16(pa3, ones, o[4], 0, 0, 0);
#endif
    asm volatile("s_waitcnt lgkmcnt(8)" ::: "memory"); DA_SBAR();
    DA_MM4(o[2], a0, a1, a2, a3, a4, a5, a6, a7); DA_EX4(8);
    asm volatile("s_waitcnt lgkmcnt(0)" ::: "memory"); DA_SBAR();
    DA_MM4(o[3], b0, b1, b2, b3, b4, b5, b6, b7); DA_EX4(12);
}
#undef DA_EX4
#undef DA_TRD
#undef DA_MM4
#undef DA_PK

__device__ __forceinline__ void glds16(const void* gsrc, unsigned lds_dst) { unsigned keep;
    asm volatile("s_mov_b32 %0, m0\n\ts_mov_b32 m0, %2\n\ts_nop 0\n\tglobal_load_lds_dwordx4 %1, off\n\ts_mov_b32 m0, %0" : "=&s"(keep) : "v"(gsrc), "s"(lds_dst) : "memory"); }

__device__ __forceinline__ void glds16x2(const void* g0, const void* g1, unsigned lds_dst) { unsigned keep;
    asm volatile("s_mov_b32 %0, m0\n\ts_mov_b32 m0, %3\n\ts_nop 0\n\tglobal_load_lds_dwordx4 %1, off\n\ts_addk_i32 m0, 0x400\n\ts_nop 0\n\tglobal_load_lds_dwordx4 %2, off\n\ts_mov_b32 m0, %0" : "=&s"(keep) : "v"(g0), "v"(g1), "s"(lds_dst) : "memory", "scc"); }

__device__ __forceinline__ void glds16x2_s(const void* sbase, unsigned off0, unsigned off1, unsigned lds_dst) { unsigned keep;
    asm volatile("s_mov_b32 %0, m0\n\ts_mov_b32 m0, %4\n\ts_nop 0\n\tglobal_load_lds_dwordx4 %1, %3\n\ts_addk_i32 m0, 0x400\n\ts_nop 0\n\tglobal_load_lds_dwordx4 %2, %3\n\ts_mov_b32 m0, %0" : "=&s"(keep) : "v"(off0), "v"(off1), "s"(sbase), "s"(lds_dst) : "memory", "scc"); }

struct Params {
    const bf16_t* QA; const bf16_t* KA; const bf16_t* VA; const bf16_t* ZA;
    const float* sc;
    const float* tblg;
    const float* subg;
    bf16_t* CAT;
};

__device__ __forceinline__ float wave_sum(float v) {
#pragma unroll
    for (int o = 1; o < 64; o <<= 1) v += __shfl_xor(v, o);
    return v;
}
__device__ __forceinline__ float wave_max(float v) {
#pragma unroll
    for (int o = 1; o < 64; o <<= 1) v = fmaxf(v, __shfl_xor(v, o));
    return v;
}

__device__ __forceinline__ void unit(const Params& P, int b, int h, int qb, char* lds, const int wave_id) {
    int tid_ = wave_id * 64 + mk_lane(); asm volatile("" : "+v"(tid_));
    const int tid = tid_, lane = tid & 63, r32 = lane & 31, hi = lane >> 5;
    const int wid = wave_id, map = wid >> 2, wq = wid & 3;
    char* V_lds = lds + LDS_V; char* K_lds = lds + LDS_K;
    float* tbl = (float*)(lds + LDS_TBL);
    const int Q0 = qb * QROWS;
    const size_t tok0 = (size_t)b * SEQ;
    const float lam = P.sc[0], cL = P.sc[8 + h], cR = P.sc[12 + h];
    tbl[tid] = P.tblg[h * 512 + tid];
    const int mapB = map * 128;
    const char* Kh = (const char*)(P.KA + tok0 * 512 + h * 128); const char* Vh = (const char*)(P.VA + tok0 * 512 + h * 128);
    unsigned koff[2], voff[2];
#pragma unroll
    for (int i = 0; i < 2; ++i) { const int B_ = (2 * wid + i) * 1024 + lane * 16;
        const int row = B_ >> 8, cB = B_ & 255; koff[i] = (unsigned)(row * 1024 + (cB ^ ((row & 15) << 4)));
        const int st = B_ >> 9, rem = B_ & 511, k = (st >> 2) * 8 + (rem >> 6), c = (st & 3) * 32 + ((rem & 63) >> 1);
        voff[i] = (unsigned)(k * 1024 + c * 2); }
    const unsigned lds0 = (unsigned)(uintptr_t)lds;
    const unsigned kdst = lds0 + LDS_K + wid * 2048, vdst = lds0 + LDS_V + wid * 2048;
#define DA_DMA_K(t, slot) do { const char* kt_ = Kh + (size_t)(t) * 65536; glds16(kt_ + koff[0], (unsigned)__builtin_amdgcn_readfirstlane(kdst + (slot))); glds16(kt_ + koff[1], (unsigned)__builtin_amdgcn_readfirstlane(kdst + (slot) + 1024)); } while (0)
#define DA_DMA_V(t, slot) do { const char* vt_ = Vh + (size_t)(t) * 65536; glds16x2(vt_ + voff[0], vt_ + voff[1], (unsigned)__builtin_amdgcn_readfirstlane(vdst + (slot))); } while (0)
#if defined(DA_STAMP)
#define DA_WAITBAR(N) do { const unsigned long long tw0_ = __builtin_amdgcn_s_memtime(); asm volatile("s_waitcnt vmcnt(" #N ") lgkmcnt(0)\n\ts_barrier" ::: "memory"); wacc_ += __builtin_amdgcn_s_memtime() - tw0_; } while (0)
#else
#define DA_WAITBAR(N) asm volatile("s_waitcnt vmcnt(" #N ") lgkmcnt(0)\n\ts_barrier" ::: "memory")
#endif
#if defined(DA_STAMP)
    unsigned long long wacc_ = 0; const unsigned long long tu0_ = __builtin_amdgcn_s_memtime();
#endif
    DA_DMA_K(0, 0); DA_DMA_V(0, 0); DA_DMA_K(1, SHM_K);
    bf16x8 qr[4];
    { const bf16_t* Qw = P.QA + (tok0 + Q0 + wq * 32 + r32) * 512 + h * 128 + map * 64 + hi * 8;
#pragma unroll
      for (int d0 = 0; d0 < 4; ++d0) qr[d0] = *reinterpret_cast<const bf16x8*>(Qw + d0 * 16); }
    const int vb0 = (int)(uintptr_t)V_lds + v_rd_base(lane);
    const int tbase = -Q0 - 32 * wq - r32 + 4 * hi + 255;
#define DA_CVAL(t) ((64 * (t) - Q0 <= -192) ? cL : ((64 * (t) - Q0 >= 256) ? cR : 0.0f))
#define DA_RESC(t) do { const float cn_ = DA_CVAL(t); if (cn_ != ccur) { const float f_ = __builtin_amdgcn_exp2f(ccur - cn_); ccur = cn_; \
        l_reg *= f_; _Pragma("unroll") for (int d_ = 0; d_ < 4 + DA_MFMA_SUM; ++d_) _Pragma("unroll") for (int r_ = 0; r_ < 16; ++r_) o[d_][r_] *= f_; } } while (0)
#define DA_NEAR(t) (64 * (t) - Q0 > -192 && 64 * (t) - Q0 < 256)
#define DA_PART(P0, P1, t) do { if (DA_NEAR(t)) addbias(P0, P1, tbl, tbase + 64 * (t)); exp_half(P0); } while (0)
#define DA_BIAS(P0, P1, t) do { if (DA_NEAR(t)) addbias(P0, P1, tbl, tbase + 64 * (t)); } while (0)
#define DA_ROT() do { const unsigned r_ = s0; s0 = s1; s1 = s2; s2 = r_; } while (0)
    f32x16 o[5]; float ccur = DA_CVAL(0), l_reg = 0.f;
    const bf16x8 ones = (bf16x8){0x3F80, 0x3F80, 0x3F80, 0x3F80, 0x3F80, 0x3F80, 0x3F80, 0x3F80};
#pragma unroll
    for (int d = 0; d < 5; ++d)
#pragma unroll
        for (int r = 0; r < 16; ++r) o[d][r] = 0.f;
    f32x16 pA0, pA1, pB0, pB1; bf16x8 pa0, pa1, pa2, pa3;
    unsigned s0 = 2 * SHM_K, s1 = 0, s2 = SHM_K;
    asm volatile("s_waitcnt vmcnt(0)" ::: "memory");
    DA_WAITBAR(0);
    DA_DMA_K(2, s0); DA_DMA_V(1, s2);
    qkt(pA0, pA1, K_lds + s1, qr, r32, hi, mapB); DA_PART(pA0, pA1, 0);
    DA_ROT();
    for (int t = 1; t + 1 < NT; t += 2) {
        DA_WAITBAR(4);
#if defined(DA_DUPQK)
        qkt(pB0, pB1, K_lds + s1, qr, r32, hi, mapB); asm volatile("" : "+v"(pB0), "+v"(pB1));
#endif
#if defined(DA_XBAR)
        asm volatile("s_waitcnt lgkmcnt(0)\n\ts_barrier" ::: "memory");
#endif
        DA_SBAR(); qkt(pB0, pB1, K_lds + s1, qr, r32, hi, mapB);
        finishSM(pA0, pA1, l_reg, pa0, pa1, pa2, pa3); DA_SBAR();
        DA_BIAS(pB0, pB1, t); DA_RESC(t - 1);
        { const unsigned ks_ = s0, vs_ = s2; pv_d0(o, vb0 + (int)s0, pa0, pa1, pa2, pa3, ones, pB0, [&]() { DA_DMA_K(t + 2, ks_); }, [&]() { DA_DMA_V(t + 1, vs_); }); }
        DA_ROT();
        DA_WAITBAR(4);
#if defined(DA_DUPQK)
        qkt(pA0, pA1, K_lds + s1, qr, r32, hi, mapB); asm volatile("" : "+v"(pA0), "+v"(pA1));
#endif
#if defined(DA_XBAR)
        asm volatile("s_waitcnt lgkmcnt(0)\n\ts_barrier" ::: "memory");
#endif
        DA_SBAR(); qkt(pA0, pA1, K_lds + s1, qr, r32, hi, mapB);
        finishSM(pB0, pB1, l_reg, pa0, pa1, pa2, pa3); DA_SBAR();
        DA_BIAS(pA0, pA1, t + 1); DA_RESC(t);
        { const unsigned ks_ = s0, vs_ = s2; pv_d0(o, vb0 + (int)s0, pa0, pa1, pa2, pa3, ones, pA0, [&]() { if (t + 3 < NT) DA_DMA_K(t + 3, ks_); }, [&]() { DA_DMA_V(t + 2, vs_); }); }
        DA_ROT();
    }
    DA_WAITBAR(2);
    DA_SBAR(); qkt(pB0, pB1, K_lds + s1, qr, r32, hi, mapB);
    finishSM(pA0, pA1, l_reg, pa0, pa1, pa2, pa3); DA_SBAR();
    DA_BIAS(pB0, pB1, NT - 1); DA_RESC(NT - 2); pv_d0(o, vb0 + (int)s0, pa0, pa1, pa2, pa3, ones, pB0, []() {}, []() {});
    DA_ROT();
    DA_WAITBAR(0);
    finishSM(pB0, pB1, l_reg, pa0, pa1, pa2, pa3); DA_SBAR();
    { f32x16 dmy = f32x16{}; DA_RESC(NT - 1); pv_d0(o, vb0 + (int)s0, pa0, pa1, pa2, pa3, ones, dmy, []() {}, []() {}); }
#if defined(DA_STAMP)
    if (blockIdx.x == 17 && wave_id == DA_STAMP && mk_lane() == 0) { const unsigned long long tot_ = __builtin_amdgcn_s_memtime() - tu0_;
        const_cast<float*>(P.sc)[100] = (float)((int)((double)wacc_ / (double)tot_ * 20.0 + 0.5) * 500);
        const_cast<float*>(P.sc)[101] = (float)((int)((double)tot_ / 20000.0 + 0.5) * 1000); }
#endif
#undef DA_RESC
#undef DA_DMA_K
#undef DA_DMA_V
#undef DA_WAITBAR
#undef DA_ROT
#undef DA_CVAL
#undef DA_NEAR
#undef DA_PART
#undef DA_BIAS
#if !DA_MFMA_SUM
    { auto rr = __builtin_amdgcn_permlane32_swap(__float_as_uint(l_reg), __float_as_uint(l_reg), false, false); l_reg = __uint_as_float(rr[0]) + __uint_as_float(rr[1]); }
    float* li_l = (float*)(lds + LDS_WS) + wid * 32;
    if (hi == 0) li_l[r32] = (map ? lam : 1.0f) / l_reg;
#endif
    int te_ = wave_id * 64 + mk_lane(); asm volatile("" : "+v"(te_));
    const int elane = te_ & 63, er32 = elane & 31, ehi = elane >> 5;
    const int erow = wid * 16 + (elane >> 2), eqtr = elane & 3;
    u32x4 zw[4];
    { const bf16_t* zp = P.ZA + (tok0 + Q0 + erow) * 512 + h * 128 + 32 * eqtr;
#pragma unroll
      for (int c8 = 0; c8 < 4; ++c8) zw[c8] = *reinterpret_cast<const u32x4*>(zp + 8 * c8); }
    __syncthreads();
    float* OST = (float*)(lds + LDS_OST);
    const float lsc = map ? lam : 1.0f;
    float* ob = OST + (wq * 32 + 4 * ehi) * OSTRIDE + er32;
    if (map == 1) {
#pragma unroll
        for (int r = 0; r < 16; ++r) {
#if DA_MFMA_SUM
            const float sc_ = lsc * __builtin_amdgcn_rcpf(o[4][r]);
#else
            const float sc_ = ((const float*)(lds + LDS_WS) + wid * 32 + 4 * ehi)[(r & 3) + 8 * (r >> 2)];
#endif
#pragma unroll
            for (int d0 = 0; d0 < 4; ++d0) ob[((r & 3) + 8 * (r >> 2)) * OSTRIDE + d0 * 32] = o[d0][r] * sc_; }
    }
    __syncthreads();
    if (map == 0) {
#pragma unroll
        for (int r = 0; r < 16; ++r) {
#if DA_MFMA_SUM
            const float sc_ = lsc * __builtin_amdgcn_rcpf(o[4][r]);
#else
            const float sc_ = ((const float*)(lds + LDS_WS) + wid * 32 + 4 * ehi)[(r & 3) + 8 * (r >> 2)];
#endif
#pragma unroll
            for (int d0 = 0; d0 < 4; ++d0) { float* pp_ = &ob[((r & 3) + 8 * (r >> 2)) * OSTRIDE + d0 * 32]; *pp_ = o[d0][r] * sc_ - *pp_; } }
    }
    __syncthreads();
    { const int row = erow, qtr = eqtr;
      const float* rp = OST + row * OSTRIDE + 32 * qtr;
      f32x4 v[8]; float ss = 0.f;
#pragma unroll
      for (int i = 0; i < 8; ++i) { v[i] = *reinterpret_cast<const f32x4*>(rp + 4 * i); ss += (v[i][0] * v[i][0] + v[i][1] * v[i][1]) + (v[i][2] * v[i][2] + v[i][3] * v[i][3]); }
      ss += __shfl_xor(ss, 1); ss += __shfl_xor(ss, 2);
      const float rs = rsqrtf(ss * (1.0f / 128.0f) + 1e-6f) * 0.8f;
      const size_t tok = tok0 + Q0 + row;
      bf16_t* cp = P.CAT + tok * 1024 + h * 128 + 32 * qtr;
      const float* gp = P.subg + 32 * qtr;
#pragma unroll
      for (int c8 = 0; c8 < 4; ++c8) {
          const f32x4 g0 = *reinterpret_cast<const f32x4*>(gp + 8 * c8), g1 = *reinterpret_cast<const f32x4*>(gp + 8 * c8 + 4);
          const f32x4 a = v[2 * c8], bq = v[2 * c8 + 1];
          float y[8];
          y[0] = a[0] * rs * g0[0] * __uint_as_float(zw[c8].x << 16); y[1] = a[1] * rs * g0[1] * __uint_as_float(zw[c8].x & 0xffff0000u);
          y[2] = a[2] * rs * g0[2] * __uint_as_float(zw[c8].y << 16); y[3] = a[3] * rs * g0[3] * __uint_as_float(zw[c8].y & 0xffff0000u);
          y[4] = bq[0] * rs * g1[0] * __uint_as_float(zw[c8].z << 16); y[5] = bq[1] * rs * g1[1] * __uint_as_float(zw[c8].z & 0xffff0000u);
          y[6] = bq[2] * rs * g1[2] * __uint_as_float(zw[c8].w << 16); y[7] = bq[3] * rs * g1[3] * __uint_as_float(zw[c8].w & 0xffff0000u);
          u32x4 w; w.x = cvtpk(y[0], y[1]); w.y = cvtpk(y[2], y[3]); w.z = cvtpk(y[4], y[5]); w.w = cvtpk(y[6], y[7]);
          *reinterpret_cast<u32x4*>(cp + 8 * c8) = w; }
    }
    __syncthreads();
}

constexpr int LDS_LI2 = 139264, OST2_BYTES = 8 * 32 * OSTRIDE * 4;
static_assert(OST2_BYTES <= LDS_LI2 && LDS_LI2 + 8 * 64 * 4 <= 147456, "unit2 LDS map");
#define DA_PK8(P, BASE, OUT) do { u32x4 w = {cvtpk(P[BASE + 0], P[BASE + 1]), cvtpk(P[BASE + 2], P[BASE + 3]), cvtpk(P[BASE + 4], P[BASE + 5]), cvtpk(P[BASE + 6], P[BASE + 7])}; OUT = *reinterpret_cast<bf16x8*>(&w); } while (0)
__device__ __forceinline__ float softmax_pack(f32x16& p0, f32x16& p1, bf16x8& a0, bf16x8& a1, bf16x8& a2, bf16x8& a3) {
    exp_half(p0); exp_half(p1);
    float ps = 0.f;
#pragma unroll
    for (int r = 0; r < 16; ++r) ps += p0[r];
#pragma unroll
    for (int r = 0; r < 16; ++r) ps += p1[r];
    DA_PK8(p0, 0, a0); DA_PK8(p0, 8, a1); DA_PK8(p1, 0, a2); DA_PK8(p1, 8, a3);
    return ps;
}
#undef DA_PK8
#define DA_TRD(D0, L0, H0, L1, H1, L2, H2, L3, H3) do { L0 = tr_read<v_rd_off(D0, 0, 0)>(vb); H0 = tr_read<v_rd_off(D0, 0, 1)>(vb); L1 = tr_read<v_rd_off(D0, 1, 0)>(vb); H1 = tr_read<v_rd_off(D0, 1, 1)>(vb); \
    L2 = tr_read<v_rd_off(D0, 2, 0)>(vb); H2 = tr_read<v_rd_off(D0, 2, 1)>(vb); L3 = tr_read<v_rd_off(D0, 3, 0)>(vb); H3 = tr_read<v_rd_off(D0, 3, 1)>(vb); } while (0)
#define DA_PK(L, H) (bf16x8){L[0], L[1], L[2], L[3], H[0], H[1], H[2], H[3]}
#define DA_MM8(D0, L0, H0, L1, H1, L2, H2, L3, H3) do { \
    o1[D0] = __builtin_amdgcn_mfma_f32_32x32x16_bf16(a0, DA_PK(L0, H0), o1[D0], 0, 0, 0); o2[D0] = __builtin_amdgcn_mfma_f32_32x32x16_bf16(b0, DA_PK(L0, H0), o2[D0], 0, 0, 0); \
    o1[D0] = __builtin_amdgcn_mfma_f32_32x32x16_bf16(a1, DA_PK(L1, H1), o1[D0], 0, 0, 0); o2[D0] = __builtin_amdgcn_mfma_f32_32x32x16_bf16(b1, DA_PK(L1, H1), o2[D0], 0, 0, 0); \
    o1[D0] = __builtin_amdgcn_mfma_f32_32x32x16_bf16(a2, DA_PK(L2, H2), o1[D0], 0, 0, 0); o2[D0] = __builtin_amdgcn_mfma_f32_32x32x16_bf16(b2, DA_PK(L2, H2), o2[D0], 0, 0, 0); \
    o1[D0] = __builtin_amdgcn_mfma_f32_32x32x16_bf16(a3, DA_PK(L3, H3), o1[D0], 0, 0, 0); o2[D0] = __builtin_amdgcn_mfma_f32_32x32x16_bf16(b3, DA_PK(L3, H3), o2[D0], 0, 0, 0); } while (0)
__device__ __forceinline__ void pv2(f32x16* o1, f32x16* o2, int vb, bf16x8 a0, bf16x8 a1, bf16x8 a2, bf16x8 a3, bf16x8 b0, bf16x8 b1, bf16x8 b2, bf16x8 b3) {
    s16x4 x0, x1, x2, x3, x4, x5, x6, x7;
    DA_TRD(0, x0, x1, x2, x3, x4, x5, x6, x7); asm volatile("s_waitcnt lgkmcnt(0)" ::: "memory"); DA_SBAR(); DA_MM8(0, x0, x1, x2, x3, x4, x5, x6, x7); DA_SBAR();
    DA_TRD(1, x0, x1, x2, x3, x4, x5, x6, x7); asm volatile("s_waitcnt lgkmcnt(0)" ::: "memory"); DA_SBAR(); DA_MM8(1, x0, x1, x2, x3, x4, x5, x6, x7); DA_SBAR();
    DA_TRD(2, x0, x1, x2, x3, x4, x5, x6, x7); asm volatile("s_waitcnt lgkmcnt(0)" ::: "memory"); DA_SBAR(); DA_MM8(2, x0, x1, x2, x3, x4, x5, x6, x7); DA_SBAR();
    DA_TRD(3, x0, x1, x2, x3, x4, x5, x6, x7); asm volatile("s_waitcnt lgkmcnt(0)" ::: "memory"); DA_SBAR(); DA_MM8(3, x0, x1, x2, x3, x4, x5, x6, x7);
}
#undef DA_TRD
#undef DA_MM8
#undef DA_PK

__device__ __forceinline__ void addbias2(f32x16& p0, f32x16& p1, const float* tbl, int tb) {
#pragma unroll
    for (int r = 0; r < 16; ++r) { p0[r] += tbl[tb + (r & 3) + 8 * (r >> 2)]; p1[r] += tbl[tb + 32 + (r & 3) + 8 * (r >> 2)]; if ((r & 3) == 3) DA_SBAR(); }
}
__device__ __forceinline__ void qkt2(f32x16& p0, f32x16& p1, const char* Ks, const char* Qp, int r32, int hi, int mapB) {
    p0 = f32x16{}; p1 = f32x16{};
    const int sw = (r32 & 7) << 4;
#pragma unroll
    for (int d0 = 0; d0 < 4; ++d0) { const char* kp = Ks + r32 * 256 + (((d0 * 16 + hi * 8) * 2) ^ sw) + mapB;
        const bf16x8 b0 = *reinterpret_cast<const bf16x8*>(kp);
        const bf16x8 b1 = *reinterpret_cast<const bf16x8*>(kp + 32 * 256);
        const bf16x8 q = *reinterpret_cast<const bf16x8*>(Qp + d0 * 1024);
        p0 = __builtin_amdgcn_mfma_f32_32x32x16_bf16(b0, q, p0, 0, 0, 0);
        p1 = __builtin_amdgcn_mfma_f32_32x32x16_bf16(b1, q, p1, 0, 0, 0);
        if (d0 == 1) DA_SBAR(); }
}
constexpr int U2_K = 0, U2_V = 2 * SHM_K, U2_Q = 4 * SHM_K, U2_TBL = U2_Q + 8 * 8192;
struct Params2 { const char* bufb; const float* scal; const float* subg; };
constexpr size_t U2_BSB = (size_t)16384 * 512 * 2, U2_CAT = 8 * U2_BSB;
__device__ __forceinline__ void unit2(const Params2& P, int b, int h, int qb, char* lds, const int wave_id) {
    int tid_ = wave_id * 64 + mk_lane(); asm volatile("" : "+v"(tid_));
    const int tid = tid_, lane = tid & 63, r32 = lane & 31, hi = lane >> 5;
    const int wid = wave_id;
    char* V_lds = lds + U2_V; char* K_lds = lds + U2_K;
    float* tbl = (float*)(lds + U2_TBL);
    char* Qf = lds + U2_Q + wid * 8192 + lane * 16;
    const int Q0 = qb * 256, Qw0 = Q0 + 32 * wid;
    const size_t tok0 = (size_t)b * SEQ;
    const float cL = P.scal[8 + h], cR = P.scal[12 + h];
    tbl[tid] = P.scal[768 + h * 512 + tid];
    const char* Kh = P.bufb + U2_BSB + (tok0 * 512 + h * 128) * 2;
    const unsigned lds0 = (unsigned)(uintptr_t)lds;
    const unsigned kdst = lds0 + U2_K + wid * 2048, vdst = lds0 + U2_V + wid * 2048;
#define DA_DMA_KV(t, slot) do { const char* kt_ = Kh + (size_t)(t) * 65536; const char* vt_ = kt_ + U2_BSB; int ln_ = mk_lane(); asm volatile("" : "+v"(ln_)); \
    unsigned ko_[2], vo_[2]; \
    _Pragma("unroll") for (int i_ = 0; i_ < 2; ++i_) { const int B_ = (2 * wid + i_) * 1024 + ln_ * 16; \
        const int row_ = B_ >> 8, cB_ = B_ & 255; ko_[i_] = (unsigned)(row_ * 1024 + (cB_ ^ ((row_ & 7) << 4))); \
        const int st_ = B_ >> 9, rem_ = B_ & 511, k_ = (st_ >> 2) * 8 + (rem_ >> 6), c_ = (st_ & 3) * 32 + ((rem_ & 63) >> 1); vo_[i_] = (unsigned)(k_ * 1024 + c_ * 2); } \
    glds16x2_s(kt_, ko_[0], ko_[1], (unsigned)__builtin_amdgcn_readfirstlane(kdst + (slot))); glds16x2_s(vt_, vo_[0], vo_[1], (unsigned)__builtin_amdgcn_readfirstlane(vdst + (slot))); } while (0)
#define DA_WAITBAR(N) asm volatile("s_waitcnt vmcnt(" #N ") lgkmcnt(0)\n\ts_barrier" ::: "memory")
    DA_DMA_KV(0, 0);
    { const bf16_t* Qw = (const bf16_t*)P.bufb + (tok0 + Qw0 + r32) * 512 + h * 128 + hi * 8;
#pragma unroll
      for (int f = 0; f < 8; ++f) { const bf16x8 qv = *reinterpret_cast<const bf16x8*>(Qw + (f >> 2) * 64 + (f & 3) * 16); *reinterpret_cast<bf16x8*>(Qf + f * 1024) = qv; } }
#define DA_CVAL(t) ((64 * (t) - Qw0 <= -192) ? cL : ((64 * (t) - Qw0 >= 160) ? cR : 0.0f))
#define DA_NEAR(t) (64 * (t) - Qw0 > -192 && 64 * (t) - Qw0 < 160)
    f32x16 o1[4], o2[4]; float l1 = 0.f, l2 = 0.f, ccur = DA_CVAL(0);
#pragma unroll
    for (int d = 0; d < 4; ++d)
#pragma unroll
        for (int r = 0; r < 16; ++r) { o1[d][r] = 0.f; o2[d][r] = 0.f; }
    for (int t = 0; t < NT; ++t) {
        const unsigned sc_ = (unsigned)(t & 1) * SHM_K;
        DA_WAITBAR(0);
        if (t + 1 < NT) DA_DMA_KV(t + 1, sc_ ^ SHM_K);
        { const float cn_ = DA_CVAL(t);
          if (cn_ != ccur) { const float f_ = __builtin_amdgcn_exp2f(ccur - cn_); ccur = cn_; l1 *= f_; l2 *= f_;
#pragma unroll
              for (int d_ = 0; d_ < 4; ++d_)
#pragma unroll
                  for (int r_ = 0; r_ < 16; ++r_) { o1[d_][r_] *= f_; o2[d_][r_] *= f_; } } }
        f32x16 p0, p1; bf16x8 a0, a1, a2, a3, b0, b1, b2, b3;
        { int ln_ = mk_lane(); const int r32_ = ln_ & 31, hi_ = ln_ >> 5; const char* qf_ = lds + U2_Q + wid * 8192 + ln_ * 16; const int tb_ = -Qw0 - r32_ + 4 * hi_ + 255 + 64 * t;
          DA_SBAR(); qkt2(p0, p1, K_lds + sc_, qf_, r32_, hi_, 0);
          if (DA_NEAR(t)) addbias2(p0, p1, tbl, tb_);
          l1 += softmax_pack(p0, p1, a0, a1, a2, a3);
          asm volatile("" ::: "memory");
          DA_SBAR(); qkt2(p0, p1, K_lds + sc_, qf_ + 4096, r32_, hi_, 128);
          if (DA_NEAR(t)) addbias2(p0, p1, tbl, tb_);
          l2 += softmax_pack(p0, p1, b0, b1, b2, b3); }
        { const int vb_ = (int)(uintptr_t)V_lds + v_rd_base(mk_lane()) + (int)sc_;
          DA_SBAR(); pv2(o1, o2, vb_, a0, a1, a2, a3, b0, b1, b2, b3); }
    }
#undef DA_DMA_KV
#undef DA_WAITBAR
#undef DA_CVAL
#undef DA_NEAR
    { auto rr = __builtin_amdgcn_permlane32_swap(__float_as_uint(l1), __float_as_uint(l1), false, false); l1 = __uint_as_float(rr[0]) + __uint_as_float(rr[1]); }
    { auto rr = __builtin_amdgcn_permlane32_swap(__float_as_uint(l2), __float_as_uint(l2), false, false); l2 = __uint_as_float(rr[0]) + __uint_as_float(rr[1]); }
    int te_ = wave_id * 64 + mk_lane(); asm volatile("" : "+v"(te_));
    const int elane = te_ & 63, er32 = elane & 31, ehi = elane >> 5;
    float* li = (float*)(lds + LDS_LI2) + wid * 64;
    { const float lam = P.scal[0]; if (ehi == 0) { li[er32] = 1.0f / l1; li[32 + er32] = lam / l2; } }
    const int prow = elane >> 1, phalf = elane & 1;
    const size_t ptok = tok0 + Qw0 + prow;
    u32x4 zw[8];
    { const bf16_t* zp = (const bf16_t*)(P.bufb + 3 * U2_BSB) + ptok * 512 + h * 128 + 64 * phalf;
#pragma unroll
      for (int c8 = 0; c8 < 8; ++c8) zw[c8] = *reinterpret_cast<const u32x4*>(zp + 8 * c8); }
    __syncthreads();
    float* OSTw = (float*)(lds) + wid * (32 * OSTRIDE);
    { const float* lib = li + 4 * ehi; float* ob = OSTw + (4 * ehi) * OSTRIDE + er32;
#pragma unroll
      for (int r = 0; r < 16; ++r) { const float s1 = lib[(r & 3) + 8 * (r >> 2)], s2 = lib[32 + (r & 3) + 8 * (r >> 2)];
#pragma unroll
          for (int d0 = 0; d0 < 4; ++d0) ob[((r & 3) + 8 * (r >> 2)) * OSTRIDE + d0 * 32] = o1[d0][r] * s1 - o2[d0][r] * s2; } }
    asm volatile("s_waitcnt lgkmcnt(0)" ::: "memory");
    __builtin_amdgcn_wave_barrier();
    { const float* rp = OSTw + prow * OSTRIDE + 64 * phalf;
      f32x4 v[16]; float ss = 0.f;
#pragma unroll
      for (int i = 0; i < 16; ++i) { v[i] = *reinterpret_cast<const f32x4*>(rp + 4 * i); ss += (v[i][0] * v[i][0] + v[i][1] * v[i][1]) + (v[i][2] * v[i][2] + v[i][3] * v[i][3]); }
      ss += __shfl_xor(ss, 1);
      const float rs = rsqrtf(ss * (1.0f / 128.0f) + 1e-6f) * 0.8f;
      bf16_t* cp = (bf16_t*)(const_cast<char*>(P.bufb) + U2_CAT) + ptok * 1024 + h * 128 + 64 * phalf;
      const float* gp = P.subg + 64 * phalf;
#pragma unroll
      for (int c8 = 0; c8 < 8; ++c8) {
          const f32x4 g0 = *reinterpret_cast<const f32x4*>(gp + 8 * c8), g1 = *reinterpret_cast<const f32x4*>(gp + 8 * c8 + 4);
          const f32x4 a = v[2 * c8], bq = v[2 * c8 + 1];
          float y[8];
          y[0] = a[0] * rs * g0[0] * __uint_as_float(zw[c8].x << 16); y[1] = a[1] * rs * g0[1] * __uint_as_float(zw[c8].x & 0xffff0000u);
          y[2] = a[2] * rs * g0[2] * __uint_as_float(zw[c8].y << 16); y[3] = a[3] * rs * g0[3] * __uint_as_float(zw[c8].y & 0xffff0000u);
          y[4] = bq[0] * rs * g1[0] * __uint_as_float(zw[c8].z << 16); y[5] = bq[1] * rs * g1[1] * __uint_as_float(zw[c8].z & 0xffff0000u);
          y[6] = bq[2] * rs * g1[2] * __uint_as_float(zw[c8].w << 16); y[7] = bq[3] * rs * g1[3] * __uint_as_float(zw[c8].w & 0xffff0000u);
          u32x4 w; w.x = cvtpk(y[0], y[1]); w.y = cvtpk(y[2], y[3]); w.z = cvtpk(y[4], y[5]); w.w = cvtpk(y[6], y[7]);
          *reinterpret_cast<u32x4*>(cp + 8 * c8) = w; }
    }
    __syncthreads();
}
#undef DA_KSWZ
#undef DA_SBAR
}

namespace na {
using bf16x8 = __attribute__((ext_vector_type(8))) short;
using s16x4  = __attribute__((ext_vector_type(4))) short;
using f32x4  = __attribute__((ext_vector_type(4))) float;
using u32x4  = __attribute__((ext_vector_type(4))) unsigned;
using u32x2  = __attribute__((ext_vector_type(2))) unsigned;
typedef unsigned short bf16_t;
constexpr int SEQ = 2048, NSLOT = 9, SLOTB = 16384, LDS_RPB = NSLOT * SLOTB  , LDS_END = LDS_RPB + 15 * 32 * 4;
constexpr float LOG2E = 1.4426950408889634f;
typedef float f32x2_t __attribute__((ext_vector_type(2))); typedef __bf16 bf16x2_t __attribute__((ext_vector_type(2)));
__device__ __forceinline__ unsigned cvtpk(float lo, float hi) { f32x2_t v = {lo, hi}; bf16x2_t b = __builtin_convertvector(v, bf16x2_t); return __builtin_bit_cast(unsigned, b); }
__device__ __forceinline__ int clampi(int v, int lo, int hi) { return v < lo ? lo : (v > hi ? hi : v); }
__device__ __forceinline__ int rs_of(int r) { return clampi(r - 4, 0, 24); }
typedef short v4i16_t __attribute__((ext_vector_type(4)));
__device__ __forceinline__ s16x4 tr_read0(int addr) { return __builtin_bit_cast(s16x4, __builtin_amdgcn_ds_read_tr16_b64_v4i16((__attribute__((address_space(3))) v4i16_t*)(unsigned)addr)); }
__device__ __forceinline__ float wave_max(float v) {
#pragma unroll
    for (int o = 1; o < 64; o <<= 1) v = fmaxf(v, __shfl_xor(v, o));
    return v;
}
struct Params {
    const bf16_t* QB; const bf16_t* KB; const bf16_t* VB; const bf16_t* ZB;
    const float* rpbg;
    bf16_t* CAT;
};

__device__ __forceinline__ void glds16(const void* gsrc, unsigned lds_dst) { unsigned keep;
    asm volatile("s_mov_b32 %0, m0\n\ts_mov_b32 m0, %2\n\ts_nop 0\n\tglobal_load_lds_dwordx4 %1, off\n\ts_mov_b32 m0, %0" : "=&s"(keep) : "v"(gsrc), "s"(lds_dst) : "memory"); }

__device__ __forceinline__ void unit(const Params& P, int b, int h, int seg, char* lds, const int wave_id) {
    int tid_ = wave_id * 64 + mk_lane(); asm volatile("" : "+v"(tid_));
    const int tid = tid_, lane = tid & 63, l15 = lane & 15, g = lane >> 4;
    const int wid = wave_id, rr = wid >> 2, qt = wid & 3;
    float* RPB = (float*)(lds + LDS_RPB);
    const size_t tok0 = (size_t)b * SEQ;
    if (tid < 480) RPB[tid] = ((tid & 31) < 31) ? P.rpbg[h * 480 + tid] : -1.0e30f;
    const int r0 = seg * 8;
    const int c0 = 16 * qt, kc0 = clampi(c0 - 8, 0, 32);
    const int qc = c0 + l15, cs = clampi(qc - 8, 0, 48);
    int dci[2][4];
#pragma unroll
    for (int blk = 0; blk < 2; ++blk)
#pragma unroll
        for (int e = 0; e < 4; ++e) { const int kc = kc0 + 16 * blk + 4 * g + e; dci[blk][e] = ((kc >= cs) && (kc < cs + 16)) ? (kc - qc + 15) : 31; }
    const int skc = 8 * wid + (lane >> 3), sch = lane & 7;
    const unsigned koff = (unsigned)((skc * 512 + h * 64 + ((sch ^ (skc & 7)) << 3)) * 2);
    const unsigned voff = (unsigned)((skc * 512 + h * 64 + ((((sch >> 1) ^ ((skc >> 1) & 3)) << 1 | (sch & 1)) << 3)) * 2);
    const char* Kb = (const char*)(P.KB + tok0 * 512); const char* Vb = (const char*)(P.VB + tok0 * 512);
    const unsigned lds0 = (unsigned)(uintptr_t)lds;
    const unsigned kdst = lds0 + wid * 1024, vdst = lds0 + 8192 + wid * 1024;
#define NA_DMA_ROW(kr) do { const unsigned so_ = (unsigned)(((kr) % NSLOT) * SLOTB); const size_t ro_ = (size_t)(kr) * 65536; \
    glds16(Kb + ro_ + koff, (unsigned)__builtin_amdgcn_readfirstlane(kdst + so_)); glds16(Vb + ro_ + voff, (unsigned)__builtin_amdgcn_readfirstlane(vdst + so_)); } while (0)
    int kad[2][2];
#pragma unroll
    for (int blk = 0; blk < 2; ++blk)
#pragma unroll
        for (int ks = 0; ks < 2; ++ks) { const int row = kc0 + 16 * blk + l15; kad[blk][ks] = row * 128 + (((4 * ks + g) ^ (row & 7)) << 4); }
    int vad[2][4];
#pragma unroll
    for (int blk = 0; blk < 2; ++blk)
#pragma unroll
        for (int d = 0; d < 4; ++d) { const int row = kc0 + 16 * blk + 4 * g + (l15 >> 2); vad[blk][d] = (int)lds0 + 8192 + row * 128 + 8 * (l15 & 3) + ((d ^ ((row >> 1) & 3)) << 5); }
    const bf16x8 ones = (bf16x8){0x3F80, 0x3F80, 0x3F80, 0x3F80, 0x3F80, 0x3F80, 0x3F80, 0x3F80};
    for (int kr = rs_of(r0); kr <= rs_of(r0 + 1) + 7; ++kr) NA_DMA_ROW(kr);
    int loaded_hi = rs_of(r0 + 1) + 7;
    bf16x8 qf[2]; u32x2 zw[4];
    { const size_t qtok = tok0 + (size_t)(r0 + rr) * 64 + c0 + l15;
#pragma unroll
      for (int ks = 0; ks < 2; ++ks) qf[ks] = *reinterpret_cast<const bf16x8*>(P.QB + qtok * 512 + h * 64 + 32 * ks + 8 * g);
#pragma unroll
      for (int d = 0; d < 4; ++d) zw[d] = *reinterpret_cast<const u32x2*>(P.ZB + qtok * 512 + h * 64 + 16 * d + 4 * g); }
    u32x2 pend[4]; size_t pend_tok = 0;
#pragma unroll
    for (int d = 0; d < 4; ++d) pend[d] = (u32x2){0u, 0u};
    for (int t = 0; t < 4; ++t) {
        const int ra = r0 + 2 * t, r = ra + rr, rs = rs_of(r);
        asm volatile("s_waitcnt vmcnt(0) lgkmcnt(0)\n\ts_barrier" ::: "memory");
        const size_t qtok = tok0 + (size_t)r * 64 + c0 + l15;
        if (t > 0) { bf16_t* cp = P.CAT + pend_tok * 1024 + 512 + h * 64 + 4 * g;
#pragma unroll
            for (int d = 0; d < 4; ++d) *reinterpret_cast<u32x2*>(cp + 16 * d) = pend[d]; }
        bf16x8 qn[2]; u32x2 zn[4];
        { const size_t ntok = tok0 + (size_t)(t < 3 ? r + 2 : r) * 64 + c0 + l15;
#pragma unroll
          for (int ks = 0; ks < 2; ++ks) qn[ks] = *reinterpret_cast<const bf16x8*>(P.QB + ntok * 512 + h * 64 + 32 * ks + 8 * g);
#pragma unroll
          for (int d = 0; d < 4; ++d) zn[d] = *reinterpret_cast<const u32x2*>(P.ZB + ntok * 512 + h * 64 + 16 * d + 4 * g); }
        f32x4 o[4], osum = (f32x4){0.f, 0.f, 0.f, 0.f};
#pragma unroll
        for (int d = 0; d < 4; ++d) o[d] = (f32x4){0.f, 0.f, 0.f, 0.f};
        bf16x8 kA[4], kB[4]; s16x4 vA[8], vB[8]; f32x4 bA[2], bB[2];
#define NA_LOADF(KF, VF, BF, i) do { const int so_ = ((rs + (i)) % NSLOT) * SLOTB; const char* sp_ = lds + so_; const float* bp_ = RPB + (rs - r + (i) + 7) * 32; \
    _Pragma("unroll") for (int e_ = 0; e_ < 4; ++e_) { BF[0][e_] = bp_[dci[0][e_]]; BF[1][e_] = bp_[dci[1][e_]]; } \
    KF[0] = *reinterpret_cast<const bf16x8*>(sp_ + kad[0][0]); KF[1] = *reinterpret_cast<const bf16x8*>(sp_ + kad[0][1]); KF[2] = *reinterpret_cast<const bf16x8*>(sp_ + kad[1][0]); KF[3] = *reinterpret_cast<const bf16x8*>(sp_ + kad[1][1]); \
    _Pragma("unroll") for (int d_ = 0; d_ < 4; ++d_) { const int va_ = so_ + vad[0][d_]; VF[2 * d_] = tr_read0(va_); VF[2 * d_ + 1] = tr_read0(va_ + 2048); } } while (0)
#define NA_ITEM(KF, VF, BF, i) do { f32x4 s0 = BF[0], s1 = BF[1]; \
    s0 = __builtin_amdgcn_mfma_f32_16x16x32_bf16(KF[0], qf[0], s0, 0, 0, 0); s1 = __builtin_amdgcn_mfma_f32_16x16x32_bf16(KF[2], qf[0], s1, 0, 0, 0); \
    s0 = __builtin_amdgcn_mfma_f32_16x16x32_bf16(KF[1], qf[1], s0, 0, 0, 0); s1 = __builtin_amdgcn_mfma_f32_16x16x32_bf16(KF[3], qf[1], s1, 0, 0, 0); \
    _Pragma("unroll") for (int e = 0; e < 4; ++e) { s0[e] = __builtin_amdgcn_exp2f(s0[e]); s1[e] = __builtin_amdgcn_exp2f(s1[e]); } \
    u32x4 pw; pw.x = cvtpk(s0[0], s0[1]); pw.y = cvtpk(s0[2], s0[3]); pw.z = cvtpk(s1[0], s1[1]); pw.w = cvtpk(s1[2], s1[3]); \
    const bf16x8 pb = *reinterpret_cast<const bf16x8*>(&pw); \
    osum = __builtin_amdgcn_mfma_f32_16x16x32_bf16(ones, pb, osum, 0, 0, 0); \
    _Pragma("unroll") for (int d_ = 0; d_ < 4; ++d_) { const s16x4 lo = VF[2 * d_], hi_ = VF[2 * d_ + 1]; \
        const bf16x8 va = (bf16x8){lo[0], lo[1], lo[2], lo[3], hi_[0], hi_[1], hi_[2], hi_[3]}; \
        o[d_] = __builtin_amdgcn_mfma_f32_16x16x32_bf16(va, pb, o[d_], 0, 0, 0); } } while (0)
#define NA_MID() do { asm volatile("s_waitcnt lgkmcnt(0)\n\ts_barrier" ::: "memory"); \
    if (t < 3) { const int nh = rs_of(ra + 3) + 7; for (int kr = loaded_hi + 1; kr <= nh; ++kr) NA_DMA_ROW(kr); loaded_hi = nh; } } while (0)
        NA_LOADF(kA, vA, bA, 0);
        NA_LOADF(kB, vB, bB, 1); __builtin_amdgcn_sched_barrier(0); NA_ITEM(kA, vA, bA, 0);
        NA_ITEM(kB, vB, bB, 1);
        NA_MID();
        NA_LOADF(kA, vA, bA, 2);
        NA_LOADF(kB, vB, bB, 3); __builtin_amdgcn_sched_barrier(0); NA_ITEM(kA, vA, bA, 2);
        NA_LOADF(kA, vA, bA, 4); __builtin_amdgcn_sched_barrier(0); NA_ITEM(kB, vB, bB, 3);
        NA_LOADF(kB, vB, bB, 5); __builtin_amdgcn_sched_barrier(0); NA_ITEM(kA, vA, bA, 4);
        NA_LOADF(kA, vA, bA, 6); __builtin_amdgcn_sched_barrier(0); NA_ITEM(kB, vB, bB, 5);
        NA_LOADF(kB, vB, bB, 7); __builtin_amdgcn_sched_barrier(0); NA_ITEM(kA, vA, bA, 6);
        NA_ITEM(kB, vB, bB, 7);
#undef NA_LOADF
#undef NA_ITEM
#undef NA_MID
        const float inv = __builtin_amdgcn_rcpf(osum[0]);
#pragma unroll
        for (int d = 0; d < 4; ++d) {
            pend[d].x = cvtpk(o[d][0] * inv * __uint_as_float(zw[d].x << 16), o[d][1] * inv * __uint_as_float(zw[d].x & 0xffff0000u));
            pend[d].y = cvtpk(o[d][2] * inv * __uint_as_float(zw[d].y << 16), o[d][3] * inv * __uint_as_float(zw[d].y & 0xffff0000u)); }
        pend_tok = qtok;
        qf[0] = qn[0]; qf[1] = qn[1];
#pragma unroll
        for (int d = 0; d < 4; ++d) zw[d] = zn[d];
    }
    { bf16_t* cp = P.CAT + pend_tok * 1024 + 512 + h * 64 + 4 * g;
#pragma unroll
      for (int d = 0; d < 4; ++d) *reinterpret_cast<u32x2*>(cp + 16 * d) = pend[d]; }
    asm volatile("s_waitcnt vmcnt(0) lgkmcnt(0)\n\ts_barrier" ::: "memory");
#undef NA_DMA_ROW
}
}

constexpr int NWAVES = 8;
#ifndef MK_N_LAUNCHES
#define MK_N_LAUNCHES 1
#endif
constexpr int N_LAUNCHES = MK_N_LAUNCHES;
constexpr int PER_PHASE = 5;
constexpr int BATCH = 8, SEQ = 2048, D = 1024, M = BATCH * SEQ, DIN = 4096, PLE = 256;
constexpr size_t MiB = 1u << 20;
constexpr size_t WS_CTL = 0, CTL_ZERO_BYTES = 64 * 1024;
constexpr size_t WS_WIN = 1 * MiB, WS_WOUT = 9 * MiB, WS_WG = 11 * MiB, WS_WP = 13 * MiB;
constexpr size_t WS_PB = 14 * MiB;
constexpr size_t WS_XN = 22 * MiB;
constexpr size_t WS_BUF = 54 * MiB;
constexpr size_t WS_CAT = 182 * MiB;
constexpr size_t WS_PP = 214 * MiB;
constexpr size_t WS_END = 246 * MiB;
constexpr size_t WS_GAINS = 128 * 1024;
constexpr size_t WS_SCAL = WS_GAINS + 1024, WS_TBLA = WS_GAINS + 4096, WS_RPBG = WS_GAINS + 16384;
constexpr size_t WS_INVRS = 256 * 1024;
constexpr int CW_BAR = 1024;
constexpr int RING_BYTES = 147456;
constexpr int NA_EXTRA = 2048;
constexpr int MISC_OFF = RING_BYTES + NA_EXTRA;
constexpr int LDS_BYTES = MISC_OFF + 256;
static_assert(pg8::STAGE_BYTES <= RING_BYTES && da::LDS_END <= RING_BYTES && na::LDS_END <= MISC_OFF && LDS_BYTES <= 163840, "LDS map");

#define GAS __attribute__((address_space(1)))
#define LAS __attribute__((address_space(3)))
typedef unsigned short bf16;
typedef unsigned v4u __attribute__((ext_vector_type(4)));
typedef float f32x4 __attribute__((ext_vector_type(4)));
#define LDS_WAIT() asm volatile("s_waitcnt lgkmcnt(0)" ::: "memory")
__device__ __forceinline__ unsigned f2bf(float f) { unsigned u = __builtin_bit_cast(unsigned, f); return (u + 0x7fffu + ((u >> 16) & 1u)) >> 16; }
__device__ __forceinline__ unsigned pk2(float lo, float hi) { return f2bf(lo) | (f2bf(hi) << 16); }

#define XB_TMO      128
#define XB_XCNT(j)  (256  + 64 * (j))
#define XB_XSUB(j)  (1280 + 64 * (j))
#define XB_XGEN(j)  (2304 + 64 * (j))
#define XB_TOP      3328
#define XB_TOPGEN   3392
#define XCD_BAR_WORDS 3456
#define XB_SPIN_CAP (1u << 18)
__device__ __forceinline__ unsigned xb_ld(unsigned* p)              { return __hip_atomic_load(p, __ATOMIC_RELAXED, __HIP_MEMORY_SCOPE_AGENT); }
__device__ __forceinline__ unsigned xb_add(unsigned* p, unsigned v) { return __hip_atomic_fetch_add(p, v, __ATOMIC_RELAXED, __HIP_MEMORY_SCOPE_AGENT); }
__device__ __forceinline__ unsigned xb_xcc_id() { return (unsigned)__builtin_amdgcn_s_getreg((3 << 11) | 20) & 0xFu; }
#define XB_SPIN(cond, bar) do { unsigned _sp = 0; while (cond) { __builtin_amdgcn_s_sleep(1); \
    if ((++_sp & 255u) == 0u) { if (xb_ld(&(bar)[XB_TMO])) break; if (_sp > XB_SPIN_CAP) { atomicAdd(&(bar)[XB_TMO], 1u); break; } } } } while (0)
struct XcdBarrier { unsigned* bar; unsigned x; volatile LAS unsigned* st; };
__device__ __forceinline__ XcdBarrier xcd_barrier_post(unsigned* bar, volatile LAS unsigned* st, const bool leader) {
    XcdBarrier b; b.bar = bar; b.x = xb_xcc_id(); b.st = st;
    if (leader) (void)xb_add(&bar[XB_XCNT(b.x)], 1u);
    return b;
}
__device__ __forceinline__ void xcd_barrier_complete(unsigned* bar, unsigned x, unsigned& nloc, unsigned& nx) {
    const unsigned G = gridDim.x * gridDim.y * gridDim.z;
    unsigned sum, cnt, mine, sp = 0u;
    for (;;) {
        sum = 0u; cnt = 0u; mine = 0u;
#pragma unroll
        for (unsigned j = 0; j < 16; ++j) { const unsigned c = xb_ld(&bar[XB_XCNT(j)]); sum += c; cnt += (c > 0u) ? 1u : 0u; mine = (j == x) ? c : mine; }
        if (sum == G) break;
        __builtin_amdgcn_s_sleep(1);
        if ((++sp & 255u) == 0u) { if (xb_ld(&bar[XB_TMO])) break; if (sp > XB_SPIN_CAP) { atomicAdd(&bar[XB_TMO], 1u); break; } }
    }
    nloc = mine > 0u ? mine : 1u; nx = cnt > 0u ? cnt : 1u;
}
__device__ __forceinline__ void xcd_barrier(const XcdBarrier& b, const bool leader) {
    asm volatile("s_waitcnt vmcnt(0)" ::: "memory");
    __syncthreads();
    if (leader) {
        unsigned* bar = b.bar;
        __builtin_amdgcn_s_waitcnt(0);
        unsigned nloc = b.st[0], nx = b.st[1];
        if (nloc == 0u) { xcd_barrier_complete(bar, b.x, nloc, nx); b.st[0] = nloc; b.st[1] = nx; }
        const unsigned old = xb_add(&bar[XB_XSUB(b.x)], 1u);
        const unsigned gen = old / nloc;
        if (old + 1u == (gen + 1u) * nloc) {
            __builtin_amdgcn_fence(__ATOMIC_RELEASE, "agent");
            asm volatile("s_waitcnt vmcnt(0)" ::: "memory");
            const unsigned og = xb_add(&bar[XB_TOP], 1u);
            const unsigned tg = og / nx;
            if (og + 1u == (tg + 1u) * nx) xb_add(&bar[XB_TOPGEN], 1u);
            else XB_SPIN(xb_ld(&bar[XB_TOPGEN]) == tg, bar);
            __builtin_amdgcn_fence(__ATOMIC_ACQUIRE, "agent");
            xb_add(&bar[XB_XGEN(b.x)], 1u);
            asm volatile("s_waitcnt vmcnt(0)" ::: "memory");
        } else {
            XB_SPIN(xb_ld(&bar[XB_XGEN(b.x)]) == gen, bar);
            __builtin_amdgcn_fence(__ATOMIC_ACQUIRE, "agent");
            asm volatile("s_waitcnt vmcnt(0)" ::: "memory");
        }
    }
    __syncthreads();
}

#define FB_DONE(j) (4096 + 64 * (j))
__device__ __forceinline__ void flat2_barrier(unsigned* bar, volatile LAS unsigned* st, unsigned& gen, const int wave_id, const unsigned x) {
    asm volatile("s_waitcnt vmcnt(0)" ::: "memory");
    __syncthreads();
    ++gen;
    if (wave_id == 0) {
        const int l = mk_lane();
        if (st[0] == 0u) {
            const unsigned G = gridDim.x; unsigned sp = 0, c = 0;
            for (;;) { c = (l < 16) ? xb_ld(&bar[XB_XCNT(l)]) : 0u; unsigned s = c;
#pragma unroll
                for (int o = 8; o; o >>= 1) s += __shfl_xor(s, o);
                if (__builtin_amdgcn_readfirstlane(s) == G) break;
                __builtin_amdgcn_s_sleep(1);
                if ((++sp & 255u) == 0u) { if (xb_ld(&bar[XB_TMO])) break; if (sp > XB_SPIN_CAP) { if (l == 0) atomicAdd(&bar[XB_TMO], 1u); break; } } }
            if (l < 16) st[16 + l] = c;
            if (l == 0) st[0] = 1u;
            asm volatile("s_waitcnt lgkmcnt(0)" ::: "memory");
        }
        const unsigned cl = (l < 16) ? st[16 + l] : 0u; const unsigned nloc = st[16 + x];
        if (l == 0) { const unsigned old = xb_add(&bar[XB_XSUB(x)], 1u);
            if (old + 1u == gen * nloc) { __builtin_amdgcn_fence(__ATOMIC_RELEASE, "agent"); asm volatile("s_waitcnt vmcnt(0)" ::: "memory"); (void)xb_add(&bar[FB_DONE(x)], 1u); } }
        unsigned sp = 0;
        for (;;) {
            const unsigned v = (cl > 0u) ? xb_ld(&bar[FB_DONE(l)]) : gen;
            if (__builtin_amdgcn_ballot_w64(v < gen) == 0ull) break;
            __builtin_amdgcn_s_sleep(1);
            if ((++sp & 255u) == 0u) { if (xb_ld(&bar[XB_TMO])) break; if (sp > XB_SPIN_CAP) { if (l == 0) atomicAdd(&bar[XB_TMO], 1u); break; } }
        }
        __builtin_amdgcn_fence(__ATOMIC_ACQUIRE, "agent");
    }
    __syncthreads();
}

#define FB_LOC(j) (8192 + 64 * (j))
__device__ __forceinline__ void local_barrier(unsigned* bar, unsigned& lgen, const int wave_id, const unsigned x, const unsigned nloc, const bool inv_l1 = true) {
    asm volatile("s_waitcnt vmcnt(0)" ::: "memory");
    __syncthreads();
    ++lgen;
    if (wave_id == 0) {
        if (mk_lane() == 0) {
            (void)xb_add(&bar[FB_LOC(x)], 1u);
            const unsigned target = lgen * nloc;
            XB_SPIN(xb_ld(&bar[FB_LOC(x)]) < target, bar);
        }
        if (inv_l1) { __builtin_amdgcn_fence(__ATOMIC_ACQUIRE, "agent"); asm volatile("s_waitcnt vmcnt(0)" ::: "memory"); }
    }
    __syncthreads();
}

#define FB_CNT(j) (4096 + 64 * (j))
__device__ __forceinline__ void flat_barrier(unsigned* bar, unsigned& gen, const int wave_id, const int bx, const unsigned per) {
    asm volatile("s_waitcnt vmcnt(0)" ::: "memory");
    __syncthreads();
    ++gen;
    if (wave_id == 0) {
        const int l = mk_lane();
        const unsigned target = gen * per;
        if (l == 0) { __builtin_amdgcn_fence(__ATOMIC_RELEASE, "agent"); (void)xb_add(&bar[FB_CNT(bx & 7)], 1u); }
        unsigned sp = 0;
        for (;;) {
            const unsigned v = (l < 8) ? xb_ld(&bar[FB_CNT(l)]) : target;
            if (__builtin_amdgcn_ballot_w64(v < target) == 0ull) break;
            __builtin_amdgcn_s_sleep(1);
            if ((++sp & 255u) == 0u) { if (xb_ld(&bar[XB_TMO])) break; if (sp > XB_SPIN_CAP) { if (l == 0) atomicAdd(&bar[XB_TMO], 1u); break; } }
        }
        __builtin_amdgcn_fence(__ATOMIC_ACQUIRE, "agent");
    }
    __syncthreads();
}

__device__ __forceinline__ float wave_sum_f(float v) {
#pragma unroll
    for (int o = 1; o < 64; o <<= 1) v += __shfl_xor(v, o);
    return v;
}
__device__ __forceinline__ float wave_max_f(float v) {
#pragma unroll
    for (int o = 1; o < 64; o <<= 1) v = fmaxf(v, __shfl_xor(v, o));
    return v;
}
template <bool PERMW>
__device__ __forceinline__ void p0_transpose_item64(const float* W, int K, int N, bf16* WT, LAS float* scr, int item, int lane, const float* rowscale = nullptr) {
    const int nblk = N / 64, kb = item / nblk, nb = item % nblk, k0 = 64 * kb, n0 = 64 * nb;
    const int kr = lane >> 4, col = (lane & 15) * 4;
    f32x4 wv[16];
#pragma unroll
    for (int i = 0; i < 16; ++i) wv[i] = __builtin_nontemporal_load((const GAS f32x4*)&W[(size_t)(k0 + 4 * i + kr) * N + n0 + col]);
#pragma unroll
    for (int i = 0; i < 16; ++i) { f32x4 v = wv[i]; if (rowscale) v *= rowscale[k0 + 4 * i + kr];
        LAS float* d = scr + (4 * i + kr) * 66 + col;
        typedef float f32x2_ __attribute__((ext_vector_type(2)));
        *(LAS f32x2_*)d = (f32x2_){v.x, v.y}; *(LAS f32x2_*)(d + 2) = (f32x2_){v.z, v.w}; }
    LDS_WAIT(); asm volatile("" ::: "memory");
    const int c = lane & 7;
#pragma unroll
    for (int j = 0; j < 8; ++j) { const int n = (lane >> 3) + 8 * j; const LAS float* s = scr + (8 * c) * 66 + n;
        v4u o; o.x = pk2(s[0 * 66], s[1 * 66]); o.y = pk2(s[2 * 66], s[3 * 66]); o.z = pk2(s[4 * 66], s[5 * 66]); o.w = pk2(s[6 * 66], s[7 * 66]);
        int row = n0 + n;
        if (PERMW) { const int l = row & 255; row = (row & ~255) + 128 * ((l >> 5) & 1) + 32 * (l >> 6) + (l & 31); }
        *(GAS v4u*)(WT + (size_t)row * K + k0 + 8 * c) = o; }
    LDS_WAIT(); asm volatile("" ::: "memory");
}
template <bool PERMW>
__device__ __forceinline__ void p0_transpose_item(const float* W, int K, int N, bf16* WT, LAS float* scr, int item, int lane, const float* rowscale = nullptr) {
    const int nblk = N / 32, kb = item / nblk, nb = item % nblk, k0 = 64 * kb, n0 = 32 * nb;
    int r0 = n0;
    if (PERMW) { const int l = n0 & 255, wc = l >> 6, bj = (l >> 5) & 1; int tb = n0 & ~255;
#if defined(MK_TBAL)
        if (tb >= 12 * 256) tb ^= 2 * 256;
#endif
        r0 = tb + 128 * bj + 32 * wc; }
    float wv[32];
#pragma unroll
    for (int i = 0; i < 32; ++i) { const int kk = 2 * i + (lane >> 5); wv[i] = __builtin_nontemporal_load(&W[(size_t)(k0 + kk) * N + n0 + (lane & 31)]); }
#pragma unroll
    for (int i = 0; i < 32; ++i) { const int kk = 2 * i + (lane >> 5); scr[kk * 33 + (lane & 31)] = rowscale ? wv[i] * rowscale[k0 + kk] : wv[i]; }
    LDS_WAIT(); asm volatile("" ::: "memory");
    const int c = lane & 7;
#pragma unroll
    for (int j = 0; j < 4; ++j) { const int n = (lane >> 3) + 8 * j; const LAS float* s = scr + (8 * c) * 33 + n;
        v4u o; o.x = pk2(s[0 * 33], s[1 * 33]); o.y = pk2(s[2 * 33], s[3 * 33]); o.z = pk2(s[4 * 33], s[5 * 33]); o.w = pk2(s[6 * 33], s[7 * 33]);
        *(GAS v4u*)(WT + (size_t)(r0 + n) * K + k0 + 8 * c) = o; }
    LDS_WAIT(); asm volatile("" ::: "memory");
}
template <int NR>
__device__ __forceinline__ void rms_rows_to_bf16(const float* x, const float* g, bf16* xn, int m0, int stride, int lane, float* inv = nullptr) {
    const GAS f32x4* gr = (const GAS f32x4*)g + lane;
    f32x4 v[NR][4];
#pragma unroll
    for (int r = 0; r < NR; ++r) { const GAS f32x4* xr = (const GAS f32x4*)(x + (size_t)(m0 + r * stride) * D) + lane;
#pragma unroll
        for (int j = 0; j < 4; ++j) v[r][j] = __builtin_nontemporal_load(&xr[64 * j]); }
    f32x4 gg[4];
#pragma unroll
    for (int j = 0; j < 4; ++j) gg[j] = gr[64 * j];
#pragma unroll
    for (int r = 0; r < NR; ++r) { float s = 0.f;
#pragma unroll
        for (int j = 0; j < 4; ++j) s += (v[r][j].x * v[r][j].x + v[r][j].y * v[r][j].y) + (v[r][j].z * v[r][j].z + v[r][j].w * v[r][j].w);
        const float ms_ = wave_sum_f(s) * (1.f / D) + 1e-6f;
        const float rstd = rsqrtf(ms_);
#if defined(MK_XNP)
        if (lane == 0) inv[m0 + r * stride] = sqrtf(ms_);
#endif
        GAS unsigned long long* o8 = (GAS unsigned long long*)(xn + (size_t)(m0 + r * stride) * D) + lane;
#pragma unroll
        for (int j = 0; j < 4; ++j)
#if defined(MK_XNP) && defined(MK_XN_NT)
            __builtin_nontemporal_store((unsigned long long)pk2(v[r][j].x * rstd, v[r][j].y * rstd) | ((unsigned long long)pk2(v[r][j].z * rstd, v[r][j].w * rstd) << 32), &o8[64 * j]); }
#elif defined(MK_XNP)
            o8[64 * j] = (unsigned long long)pk2(v[r][j].x * rstd, v[r][j].y * rstd) | ((unsigned long long)pk2(v[r][j].z * rstd, v[r][j].w * rstd) << 32); }
#else
            o8[64 * j] = (unsigned long long)pk2(v[r][j].x * rstd * gg[j].x, v[r][j].y * rstd * gg[j].y) | ((unsigned long long)pk2(v[r][j].z * rstd * gg[j].z, v[r][j].w * rstd * gg[j].w) << 32); }
#endif
}

template <int NR>
__device__ __forceinline__ void rms_load(const float* x, int m0, int stride, int lane, f32x4 (&v)[NR][4]) {
#pragma unroll
    for (int r = 0; r < NR; ++r) { const GAS f32x4* xr = (const GAS f32x4*)(x + (size_t)(m0 + r * stride) * D) + lane;
#pragma unroll
        for (int j = 0; j < 4; ++j) v[r][j] = __builtin_nontemporal_load(&xr[64 * j]); }
}
template <int NR>
__device__ __forceinline__ void rms_finish(const f32x4 (&v)[NR][4], const float* g, bf16* xn, int m0, int stride, int lane, float* inv) {
#if !defined(MK_XNP)
    const GAS f32x4* gr = (const GAS f32x4*)g + lane;
    f32x4 gg[4];
#pragma unroll
    for (int j = 0; j < 4; ++j) gg[j] = gr[64 * j];
#endif
#pragma unroll
    for (int r = 0; r < NR; ++r) { float s = 0.f;
#pragma unroll
        for (int j = 0; j < 4; ++j) s += (v[r][j].x * v[r][j].x + v[r][j].y * v[r][j].y) + (v[r][j].z * v[r][j].z + v[r][j].w * v[r][j].w);
        const float ms_ = wave_sum_f(s) * (1.f / D) + 1e-6f;
        const float rstd = rsqrtf(ms_);
#if defined(MK_XNP)
        if (lane == 0) inv[m0 + r * stride] = sqrtf(ms_);
#endif
        GAS unsigned long long* o8 = (GAS unsigned long long*)(xn + (size_t)(m0 + r * stride) * D) + lane;
#pragma unroll
        for (int j = 0; j < 4; ++j)
#if defined(MK_XNP)
            o8[64 * j] = (unsigned long long)pk2(v[r][j].x * rstd, v[r][j].y * rstd) | ((unsigned long long)pk2(v[r][j].z * rstd, v[r][j].w * rstd) << 32);
#else
            o8[64 * j] = (unsigned long long)pk2(v[r][j].x * rstd * gg[j].x, v[r][j].y * rstd * gg[j].y) | ((unsigned long long)pk2(v[r][j].z * rstd * gg[j].z, v[r][j].w * rstd * gg[j].w) << 32);
#endif
    }
}

__device__ __forceinline__ void l2_prefetch_tile(const void* base, size_t pitch, int row_bytes, int tid, unsigned dump_lds) {
    const int lines_per_row = row_bytes / 128, nlines = 256 * lines_per_row;
    const unsigned dst = (unsigned)__builtin_amdgcn_readfirstlane(dump_lds + (unsigned)(tid >> 6) * 1024u);
    for (int i = tid; i < nlines; i += NWAVES * 64) { const int r = i / lines_per_row, c = i % lines_per_row;
        na::glds16((const char*)base + (size_t)r * pitch + (size_t)c * 128, dst); }
}

struct Args { const float* in[18]; float* out; unsigned char* ws; int ph_lo, ph_hi, li, pad; };

__global__ void __launch_bounds__(NWAVES * 64, 2) mk_fwd(Args args) {
    extern __shared__ __attribute__((aligned(16))) unsigned char lds[];
    const int wave = __builtin_amdgcn_readfirstlane((int)threadIdx.x >> 6);
#define tid (wave * 64 + mk_lane())
#define lane (mk_lane())
#define leader_ (wave == 0 && mk_lane() == 0)
    const int G = gridDim.x; const int bx = blockIdx.x; const int vcu = (G % 8 == 0) ? (bx % 8) * (G / 8) + bx / 8 : bx;
    unsigned char* ws = args.ws;
    volatile LAS unsigned* MISC = (volatile LAS unsigned*)((LAS unsigned char*)lds + MISC_OFF);
    for (int u = tid; u < (LDS_BYTES - MISC_OFF) / 4; u += NWAVES * 64) MISC[u] = 0u;
#if !defined(MK_LATEREG)
    __syncthreads();
#endif
    XcdBarrier bar; bar.bar = (unsigned*)(ws + WS_CTL) + CW_BAR; bar.x = 0; bar.st = nullptr;
#if defined(MK_FLATBAR) && MK_FLATBAR == 2
    unsigned fb_gen = 0;
#if defined(MK_XLOCAL)
    unsigned xl_gen = 0; int xl_rank = 0; unsigned xl_rankv = 0;
    if (N_LAUNCHES != PER_PHASE) { bar.x = xb_xcc_id(); bar.st = MISC + 8;
#if defined(MK_LATEREG)
        if (leader_) xl_rankv = xb_add(&bar.bar[XB_XCNT(bar.x)], 1u); }
#else
        if (leader_) MISC[4] = xb_add(&bar.bar[XB_XCNT(bar.x)], 1u);
        __syncthreads(); xl_rank = __builtin_amdgcn_readfirstlane((int)MISC[4]); }
#endif
#else
    if (N_LAUNCHES != PER_PHASE) bar = xcd_barrier_post((unsigned*)(ws + WS_CTL) + CW_BAR, MISC + 8, leader_);
#endif
#define GRID_BARRIER() flat2_barrier((unsigned*)(ws + WS_CTL) + CW_BAR, MISC + 16, fb_gen, wave, bar.x)
#elif defined(MK_FLATBAR)
    unsigned fb_gen = 0; const unsigned fb_per = (unsigned)G / 8u;
#define GRID_BARRIER() flat_barrier((unsigned*)(ws + WS_CTL) + CW_BAR, fb_gen, wave, bx, fb_per)
#else
    if (N_LAUNCHES != PER_PHASE) bar = xcd_barrier_post((unsigned*)(ws + WS_CTL) + CW_BAR, MISC + 8, leader_);
#define GRID_BARRIER() xcd_barrier(bar, leader_)
#endif
    const int lo = args.ph_lo, hi = args.ph_hi;
#ifdef MK_ONLY_PHASE
#define IN(k) ((k) == MK_ONLY_PHASE && lo <= (k) && (k) < hi)
#else
#define IN(k) (lo <= (k) && (k) < hi)
#endif
#define BOTH(k) (IN(k) && IN((k) + 1))
    const float* x = args.in[0]; const float* p = args.in[1]; const float* norm_g = args.in[2]; const float* w_in = args.in[3]; const float* w_out = args.in[4];
    const float* w_gate = args.in[16]; const float* w_proj = args.in[17];
    bf16* Win_t = (bf16*)(ws + WS_WIN); bf16* Wout_t = (bf16*)(ws + WS_WOUT); bf16* Wg_t = (bf16*)(ws + WS_WG); bf16* Wp_t = (bf16*)(ws + WS_WP);
    bf16* PB = (bf16*)(ws + WS_PB); bf16* XN = (bf16*)(ws + WS_XN); bf16* BUF = (bf16*)(ws + WS_BUF); bf16* CAT = (bf16*)(ws + WS_CAT); bf16* PP = (bf16*)(ws + WS_PP);
    constexpr size_t BS = (size_t)M * 512;

#ifndef MK_REP0
#define MK_REP0 1
#endif
#ifndef MK_REP1
#define MK_REP1 1
#endif
#ifndef MK_REPDA
#define MK_REPDA 1
#endif
#ifndef MK_REPNA
#define MK_REPNA 1
#endif
#ifndef MK_REP3
#define MK_REP3 1
#endif
    if (IN(0)) {
      for (int rep_ = 0; rep_ < MK_REP0; ++rep_) {
        LAS float* scr = (LAS float*)((LAS unsigned char*)lds + wave * 16384);
        const int gw = vcu * NWAVES + wave, NGW = G * NWAVES;
        constexpr int I_IN = (D / 64) * (DIN / 32), I_SQ = (D / 64) * (D / 32), I_P = (PLE / 64) * (D / 32);
        constexpr int NITEMS = I_IN + 2 * I_SQ + I_P;
#ifndef MK_REP0W
#define MK_REP0W 1
#endif
#ifndef MK_REP0R
#define MK_REP0R 1
#endif
#if defined(MK_P0OVL)
        f32x4 xv0_[4][4], pv0_[4];
#pragma unroll
        for (int r = 0; r < 4; ++r) pv0_[r] = __builtin_nontemporal_load((const GAS f32x4*)(p + (size_t)(gw + r * NGW) * PLE) + lane);
        rms_load<4>(x, gw, NGW, lane, xv0_);
#endif
#if defined(MK_P0T64) && defined(MK_P0SPREAD)
#define P0_TASKW(k) (NGW - 1 - 8 * (k))
#else
#define P0_TASKW(k) (k)
#endif
#if defined(MK_P0T64)
        { LAS float* scr64 = (LAS float*)((LAS unsigned char*)lds + wave * 16896);
          constexpr int J_IN = (D / 64) * (DIN / 64), J_SQ = (D / 64) * (D / 64), J_P = (PLE / 64) * (D / 64), NJ = J_IN + 2 * J_SQ + J_P;
          for (int it = gw; it < NJ; it += NGW) { int r = it;
#if defined(MK_XNP)
              if (r < J_IN) { p0_transpose_item64<true>(w_in, D, DIN, Win_t, scr64, r, lane, norm_g); continue; }
#else
              if (r < J_IN) { p0_transpose_item64<true>(w_in, D, DIN, Win_t, scr64, r, lane); continue; }
#endif
              r -= J_IN;
              if (r < J_SQ) { p0_transpose_item64<false>(w_out, D, D, Wout_t, scr64, r, lane); continue; } r -= J_SQ;
              if (r < J_SQ) { p0_transpose_item64<false>(w_gate, D, D, Wg_t, scr64, r, lane); continue; } r -= J_SQ;
              p0_transpose_item64<false>(w_proj, PLE, D, Wp_t, scr64, r, lane); } }
#else
        for (int rw_ = 0; rw_ < MK_REP0W; ++rw_)
        for (int it = gw; it < NITEMS; it += NGW) {
            int r = it;
            #if defined(MK_XNP)
            if (r < I_IN) { p0_transpose_item<true>(w_in, D, DIN, Win_t, scr, r, lane, norm_g); continue; }
#else
            if (r < I_IN) { p0_transpose_item<true>(w_in, D, DIN, Win_t, scr, r, lane); continue; }
#endif
            r -= I_IN;
            if (r < I_SQ) { p0_transpose_item<false>(w_out, D, D, Wout_t, scr, r, lane); continue; } r -= I_SQ;
            if (r < I_SQ) { p0_transpose_item<false>(w_gate, D, D, Wg_t, scr, r, lane); continue; } r -= I_SQ;
            p0_transpose_item<false>(w_proj, PLE, D, Wp_t, scr, r, lane);
        }
#endif
#if defined(MK_P0T64) && defined(MK_P0SPREAD) && MK_P0SPREAD == 2
        { constexpr int NJ_ = (D / 64) * (DIN / 64) + 2 * (D / 64) * (D / 64) + (PLE / 64) * (D / 64); const int iw = gw - NJ_; const float L2E = 1.4426950408889634f;
          static_assert(NJ_ + 106 <= 256 * NWAVES, "idle waves for the table tasks");
          if (iw >= 0 && iw < 32) { float* TB = (float*)(ws + WS_TBLA); const int i = iw * 64 + lane, h = i >> 9, idx = i & 511; TB[i] = args.in[12][da::t5_bucket(idx - 255) * 4 + h] * L2E; }
          else if (iw >= 32 && iw < 92) { float* RB = (float*)(ws + WS_RPBG); const int i = (iw - 32) * 64 + lane, h = i / 480, r = i % 480, dr = r >> 5, dc = r & 31; RB[i] = dc < 31 ? args.in[15][(h * 15 + dr) * 31 + dc] * L2E : 0.f; }
          else if (iw == 92) { float* GN = (float*)(ws + WS_GAINS); const float qs = 0.125f * L2E;
              GN[lane] = args.in[5][lane] * qs; GN[64 + lane] = args.in[6][lane]; GN[128 + lane] = args.in[13][lane] * qs; GN[192 + lane] = args.in[14][lane]; }
          else if (iw == 93) { float* SC = (float*)(ws + WS_SCAL);
              const float lam = __expf(wave_sum_f(args.in[7][lane] * args.in[8][lane])) - __expf(wave_sum_f(args.in[9][lane] * args.in[10][lane])) + 0.2f;
              if (lane == 0) SC[0] = lam; }
          else if (iw >= 94 && iw < 98) { float* SC = (float*)(ws + WS_SCAL); const int h = iw - 94;
              const float ga = wave_max_f(fabsf(args.in[5][lane])) * wave_max_f(fabsf(args.in[6][lane]));
              const float tm = wave_max_f(fabsf(args.in[12][(lane & 31) * 4 + h]));
              const float MB = fminf(8.0f * L2E * ga * 1.01f + tm * L2E + 0.1f, 64.0f);
              if (lane == 0) { SC[4 + h] = MB; SC[8 + h] = args.in[12][15 * 4 + h] * L2E; SC[12 + h] = args.in[12][31 * 4 + h] * L2E; } }
          else if (iw >= 98 && iw < 106) { float* SC = (float*)(ws + WS_SCAL); const int h = iw - 98;
              const float gb = wave_max_f(fabsf(args.in[13][lane])) * wave_max_f(fabsf(args.in[14][lane]));
              float bm = 0.f; for (int i = lane; i < 465; i += 64) bm = fmaxf(bm, fabsf(args.in[15][h * 465 + i])); bm = wave_max_f(bm);
              if (lane == 0) SC[16 + h] = fminf(8.0f * L2E * gb * 1.01f + bm * L2E + 0.1f, 64.0f); } }
#else
        if (gw == P0_TASKW(0)) { float* GN = (float*)(ws + WS_GAINS); const float qs = 0.125f * 1.4426950408889634f;
            GN[lane] = args.in[5][lane] * qs; GN[64 + lane] = args.in[6][lane]; GN[128 + lane] = args.in[13][lane] * qs; GN[192 + lane] = args.in[14][lane]; }
        if (gw == P0_TASKW(1)) {
            const float L2E = 1.4426950408889634f; float* SC = (float*)(ws + WS_SCAL);
            const float lam = __expf(wave_sum_f(args.in[7][lane] * args.in[8][lane])) - __expf(wave_sum_f(args.in[9][lane] * args.in[10][lane])) + 0.2f;
            const float ga = wave_max_f(fabsf(args.in[5][lane])) * wave_max_f(fabsf(args.in[6][lane])), gb = wave_max_f(fabsf(args.in[13][lane])) * wave_max_f(fabsf(args.in[14][lane]));
            if (lane == 0) SC[0] = lam;
            for (int h = 0; h < 4; ++h) { const float tm = wave_max_f(fabsf(args.in[12][(lane & 31) * 4 + h]));
                const float MB = fminf(8.0f * L2E * ga * 1.01f + tm * L2E + 0.1f, 64.0f);
                if (lane == 0) { SC[4 + h] = MB; SC[8 + h] = args.in[12][15 * 4 + h] * L2E; SC[12 + h] = args.in[12][31 * 4 + h] * L2E; } }
            for (int h = 0; h < 8; ++h) { float bm = 0.f; for (int i = lane; i < 465; i += 64) bm = fmaxf(bm, fabsf(args.in[15][h * 465 + i])); bm = wave_max_f(bm);
                if (lane == 0) SC[16 + h] = fminf(8.0f * L2E * gb * 1.01f + bm * L2E + 0.1f, 64.0f); }
        }
        if (gw == P0_TASKW(2)) { float* TB = (float*)(ws + WS_TBLA);
            for (int i = lane; i < 2048; i += 64) { const int h = i >> 9, idx = i & 511; TB[i] = args.in[12][da::t5_bucket(idx - 255) * 4 + h] * 1.4426950408889634f; } }
        if (gw == P0_TASKW(3)) { float* RB = (float*)(ws + WS_RPBG);
            for (int i = lane; i < 8 * 480; i += 64) { const int h = i / 480, r = i % 480, dr = r >> 5, dc = r & 31; RB[i] = dc < 31 ? args.in[15][(h * 15 + dr) * 31 + dc] * 1.4426950408889634f : 0.f; } }
#endif
#if defined(MK_P0LOCAL)
        for (int it_ = 0; it_ < 2; ++it_) { const int m = (M / NGW) * gw + 4 * it_; constexpr int RS = 1;
#else
#ifndef MK_P0ROWS
#define MK_P0ROWS 4
#endif
#if defined(MK_P0OVL)
        rms_finish<4>(xv0_, norm_g, XN, gw, NGW, lane, (float*)(ws + WS_INVRS));
#pragma unroll
        for (int r = 0; r < 4; ++r) *((GAS unsigned long long*)(PB + (size_t)(gw + r * NGW) * PLE) + lane) = (unsigned long long)pk2(pv0_[r].x, pv0_[r].y) | ((unsigned long long)pk2(pv0_[r].z, pv0_[r].w) << 32);
        for (int m = gw + 4 * NGW; m < M; m += MK_P0ROWS * NGW) { constexpr int RS = 0;
#else
        for (int rr_ = 0; rr_ < MK_REP0R; ++rr_)
        for (int m = gw; m < M; m += MK_P0ROWS * NGW) { constexpr int RS = 0;
#endif
#endif
            const int rs_ = RS ? 1 : NGW;
            f32x4 pv[MK_P0ROWS];
#pragma unroll
            for (int r = 0; r < MK_P0ROWS; ++r) pv[r] = __builtin_nontemporal_load((const GAS f32x4*)(p + (size_t)(m + r * rs_) * PLE) + lane);
            rms_rows_to_bf16<MK_P0ROWS>(x, norm_g, XN, m, rs_, lane, (float*)(ws + WS_INVRS));
#pragma unroll
            for (int r = 0; r < MK_P0ROWS; ++r) *((GAS unsigned long long*)(PB + (size_t)(m + r * rs_) * PLE) + lane) = (unsigned long long)pk2(pv[r].x, pv[r].y) | ((unsigned long long)pk2(pv[r].z, pv[r].w) << 32);
        }
      }
#if defined(MK_LATEREG) && defined(MK_XLOCAL)
        if (BOTH(0)) { if (leader_) MISC[4] = xl_rankv; GRID_BARRIER(); xl_rank = __builtin_amdgcn_readfirstlane((int)MISC[4]); }
#else
        if (BOTH(0)) GRID_BARRIER();
#endif
    }
    int vbx = bx; bool xl = false;
#if defined(MK_XLOCAL)
    if (fb_gen > 0u) { const int l_ = mk_lane(); const unsigned c_ = (l_ < 16) ? MISC[16 + 16 + l_] : 0u;
        const bool ok_ = (l_ >= 16) || (l_ < 8 ? c_ == (unsigned)G / 8u : c_ == 0u);
#if defined(MK_FORCE_FALLBACK)
        xl = false;
#else
        xl = (G % 8 == 0) && (__builtin_amdgcn_ballot_w64(!ok_) == 0ull) && bar.x < 8u;
#endif
        if (xl) vbx = xl_rank * 8 + (int)bar.x; }
#define PHASE_BARRIER() do { if (xl) local_barrier((unsigned*)(ws + WS_CTL) + CW_BAR, xl_gen, wave, bar.x, (unsigned)G / 8u); else GRID_BARRIER(); } while (0)
#if defined(MK_NOINV23)
#define PHASE_BARRIER_FT() do { if (xl) local_barrier((unsigned*)(ws + WS_CTL) + CW_BAR, xl_gen, wave, bar.x, (unsigned)G / 8u, false); else GRID_BARRIER(); } while (0)
#else
#define PHASE_BARRIER_FT() PHASE_BARRIER()
#endif
#else
#define PHASE_BARRIER() GRID_BARRIER()
#define PHASE_BARRIER_FT() GRID_BARRIER()
#endif
    const int vcu2 = (G % 8 == 0) ? (vbx % 8) * (G / 8) + vbx / 8 : vbx;
#if defined(MK_KROT)
#define KROT(K_) ((2 * (vbx % 8) * MK_KROT) % ((K_) / 64))
#else
#define KROT(K_) 0
#endif
#if defined(MK_CLKPROBE)
    unsigned long long pc0_ = 0, pr0_ = 0, pc1_ = 0, pr1_ = 0;
#define CLK_BEGIN(k) do { if (MK_CLKPROBE == (k)) { pc0_ = __builtin_amdgcn_s_memtime(); pr0_ = __builtin_amdgcn_s_memrealtime(); } } while (0)
#define CLK_END(k) do { if (MK_CLKPROBE == (k)) { pc1_ = __builtin_amdgcn_s_memtime(); pr1_ = __builtin_amdgcn_s_memrealtime(); } } while (0)
#else
#define CLK_BEGIN(k) do {} while (0)
#define CLK_END(k) do {} while (0)
#endif
#if defined(MK_PP_STAGGER) && MK_PP_STAGGER == 5
    const bool pp_late_ = ((vbx % 8) & 1) != 0;
#else
    const bool pp_late_ = false;
#endif
    if (IN(1)) {
#if defined(MK_PP_FIRST)
        { pg8::Gemm g{PB, Wp_t, M, D, PLE, KROT(PLE)}; pg8::StaticOrder S; S.init(M, D, G, vbx);
          pg8::EpiBf16Plain E{PP, D};
          pg8::gemm_phase<pg8::EpiBf16Plain, pg8::StaticOrder, true, true>((LAS unsigned char*)lds, g, S, E, wave); }
#elif defined(MK_PP_STAGGER)
#if MK_PP_STAGGER == 2
        const bool pp_first_ = ((vbx / 8) & 1) == 0;
#elif MK_PP_STAGGER == 3
        const bool pp_first_ = ((vbx / 8) & 16) == 0;
#elif MK_PP_STAGGER == 4
        const bool pp_first_ = ((((vbx / 8) >> 3) ^ (vbx % 8)) & 1) == 0;
#elif MK_PP_STAGGER == 8
        const bool pp_first_ = (((vbx / 8) ^ (vbx % 8)) & 1) == 0;
#elif MK_PP_STAGGER == 6
        const bool pp_first_ = ((vbx % 8) & 4) == 0;
#elif MK_PP_STAGGER == 7
        const bool pp_first_ = ((vbx % 8) & 2) == 0;
#else
        const bool pp_first_ = ((vbx % 8) & 1) == 0;
#endif
        if (pp_first_)
        { pg8::Gemm g{PB, Wp_t, M, D, PLE, KROT(PLE)}; pg8::StaticOrder S; S.init(M, D, G, vbx);
          pg8::EpiBf16Plain E{PP, D};
          pg8::gemm_phase<pg8::EpiBf16Plain, pg8::StaticOrder, true, true>((LAS unsigned char*)lds, g, S, E, wave); }
#endif
        CLK_BEGIN(1);
#if defined(MK_PNROT)
        { pg8::Gemm g{XN, Win_t, M, DIN, D, KROT(D)}; pg8::StaticOrder S; S.init(M, DIN, G, vbx, ((vbx % 8) * MK_PNROT) % (DIN / 256));
#define P1ORDER pg8::StaticOrder
#else
#if defined(MK_DUPMAIN) && MK_DUPMAIN == 1
        { pg8::Gemm g{XN, Win_t, M, DIN, D, KROT(D)}; pg8::DupOrder S; S.init(M, DIN, G, vbx);
#define P1ORDER pg8::DupOrder
#else
        { pg8::Gemm g{XN, Win_t, M, DIN, D, KROT(D)}; pg8::StaticOrder S; S.init(M, DIN, G, vbx);
#define P1ORDER pg8::StaticOrder
#endif
#endif
          pg8::EpiProj E{BUF, (const float*)(ws + WS_GAINS)};
          pg8::gemm_phase<pg8::EpiProj, P1ORDER, true, true>((LAS unsigned char*)lds, g, S, E, wave); }
        CLK_END(1);
#if MK_REP1 == 2
        { pg8::Gemm g{XN, Win_t, M, DIN, D, KROT(D)}; pg8::StaticOrder S; S.init(M, DIN, G, vbx);
          pg8::EpiProj E{BUF, (const float*)(ws + WS_GAINS)};
          pg8::gemm_phase<pg8::EpiProj, pg8::StaticOrder, true, true>((LAS unsigned char*)lds, g, S, E, wave); }
#endif
#if defined(MK_PP_STAGGER)
        if (!pp_first_ && !pp_late_)
        { pg8::Gemm g{PB, Wp_t, M, D, PLE, KROT(PLE)}; pg8::StaticOrder S; S.init(M, D, G, vbx);
          pg8::EpiBf16Plain E{PP, D};
          pg8::gemm_phase<pg8::EpiBf16Plain, pg8::StaticOrder, true, true>((LAS unsigned char*)lds, g, S, E, wave); }
#elif !defined(MK_PP_FIRST)
        { pg8::Gemm g{PB, Wp_t, M, D, PLE, KROT(PLE)}; pg8::StaticOrder S; S.init(M, D, G, vbx);
          pg8::EpiBf16Plain E{PP, D};
          pg8::gemm_phase<pg8::EpiBf16Plain, pg8::StaticOrder, true, true>((LAS unsigned char*)lds, g, S, E, wave); }
#endif
#if MK_REP1 == 3
        { pg8::Gemm g{PB, Wp_t, M, D, PLE, KROT(PLE)}; pg8::StaticOrder S; S.init(M, D, G, vbx);
          pg8::EpiBf16Plain E{PP, D};
          pg8::gemm_phase<pg8::EpiBf16Plain, pg8::StaticOrder, true, true>((LAS unsigned char*)lds, g, S, E, wave); }
#endif
        if (BOTH(1)) PHASE_BARRIER_FT();
    }
    if (IN(2)) {
#if defined(MK_P2MIX)
        { da::Params PD{BUF, BUF + BS, BUF + 2 * BS, BUF + 3 * BS, (const float*)(ws + WS_SCAL), (const float*)(ws + WS_TBLA), args.in[11], CAT};
          na::Params PN{BUF + 4 * BS, BUF + 5 * BS, BUF + 6 * BS, BUF + 7 * BS, (const float*)(ws + WS_RPBG), CAT};
          const int slot_na = (G == 256) ? (MK_P2MIX == 7 ? 2 : MK_P2MIX == 8 ? (((vbx % 8) & 1) ? 0 : 2) : MK_P2MIX == 9 ? (((vbx % 8) & 2) ? 0 : 2) : MK_P2MIX == 2 ? (vcu2 & 1) * 2 : (vcu2 % MK_P2MIX) % 3) : 2;
          for (int s = 0; s < 3; ++s) {
              if (s == slot_na) { const int uidx = vcu2; if (uidx < 256) { const int bh = uidx >> 2, seg = uidx & 3; na::unit(PN, bh >> 3, bh & 7, seg, (char*)lds, wave); } }
              else { const int i = s < slot_na ? s : s - 1; const int uidx = (G == 256) ? (vcu2 >> 5) * 64 + i * 32 + (vcu2 & 31) : i * G + vcu2;
                  if (uidx < 512) { const int bh = uidx >> 4, qb = uidx & 15; da::unit(PD, bh >> 2, bh & 3, qb, (char*)lds, wave); } } } }
#elif defined(MK_NA_FIRST)
#ifndef MK_SKIP_NA
        { na::Params P{BUF + 4 * BS, BUF + 5 * BS, BUF + 6 * BS, BUF + 7 * BS, (const float*)(ws + WS_RPBG), CAT};
          for (int rep_ = 0; rep_ < MK_REPNA; ++rep_) for (int uidx = vcu2; uidx < 256; uidx += G) { const int bh = uidx >> 2, seg = uidx & 3; na::unit(P, bh >> 3, bh & 7, seg, (char*)lds, wave); } }
#endif
#ifndef MK_SKIP_DA
        CLK_BEGIN(2);
        { da::Params P{BUF, BUF + BS, BUF + 2 * BS, BUF + 3 * BS, (const float*)(ws + WS_SCAL), (const float*)(ws + WS_TBLA), args.in[11], CAT};
#if !defined(MK_DA_UNIT2)
          for (int rep_ = 0; rep_ < MK_REPDA; ++rep_) for (int i = 0; i < 2; ++i) { const int uidx = (G == 256) ? (vcu2 >> 5) * 64 + i * 32 + (vcu2 & 31) : i * G + vcu2; if (uidx >= 512) break; const int bh = uidx >> 4, qb = uidx & 15;     da::unit(P, bh >> 2, bh & 3, qb, (char*)lds, wave); } }
#else
          static_assert(WS_CAT - WS_BUF == da::U2_CAT && WS_TBLA - WS_SCAL == 768 * 4, "unit2 derives every tensor from one base");
          const da::Params2 P2{(const char*)(ws + WS_BUF), (const float*)(ws + WS_SCAL), args.in[11]};
          for (int rep_ = 0; rep_ < MK_REPDA; ++rep_) for (int uidx = vcu2; uidx < 256; uidx += G) { const int bh = uidx >> 3, qb = uidx & 7; da::unit2(P2, bh >> 2, bh & 3, qb, (char*)lds, wave); } }
#endif
        CLK_END(2);
#endif
#else
#if defined(MK_NASTAG)
        const bool na_first_ = (((vbx % 8) >> MK_NASTAG) & 1) != 0;
        if (na_first_)
        { na::Params P{BUF + 4 * BS, BUF + 5 * BS, BUF + 6 * BS, BUF + 7 * BS, (const float*)(ws + WS_RPBG), CAT};
          for (int rep_ = 0; rep_ < MK_REPNA; ++rep_) for (int uidx = vcu2; uidx < 256; uidx += G) { const int bh = uidx >> 2, seg = uidx & 3; na::unit(P, bh >> 3, bh & 7, seg, (char*)lds, wave); } }
#endif
#ifndef MK_SKIP_DA
        CLK_BEGIN(2);
        { da::Params P{BUF, BUF + BS, BUF + 2 * BS, BUF + 3 * BS, (const float*)(ws + WS_SCAL), (const float*)(ws + WS_TBLA), args.in[11], CAT};
#if !defined(MK_DA_UNIT2)
          for (int rep_ = 0; rep_ < MK_REPDA; ++rep_) for (int i = 0; i < 2; ++i) { const int uidx = (G == 256) ? (vcu2 >> 5) * 64 + i * 32 + (vcu2 & 31) : i * G + vcu2; if (uidx >= 512) break; const int bh = uidx >> 4, qb = uidx & 15;     da::unit(P, bh >> 2, bh & 3, qb, (char*)lds, wave); } }
#else
          static_assert(WS_CAT - WS_BUF == da::U2_CAT && WS_TBLA - WS_SCAL == 768 * 4, "unit2 derives every tensor from one base");
          const da::Params2 P2{(const char*)(ws + WS_BUF), (const float*)(ws + WS_SCAL), args.in[11]};
          for (int rep_ = 0; rep_ < MK_REPDA; ++rep_) for (int uidx = vcu2; uidx < 256; uidx += G) { const int bh = uidx >> 3, qb = uidx & 7; da::unit2(P2, bh >> 2, bh & 3, qb, (char*)lds, wave); } }
#endif
        CLK_END(2);
#endif
#if defined(MK_NASTAG)
        if (!na_first_)
#endif
#ifndef MK_SKIP_NA
        { na::Params P{BUF + 4 * BS, BUF + 5 * BS, BUF + 6 * BS, BUF + 7 * BS, (const float*)(ws + WS_RPBG), CAT};
          for (int rep_ = 0; rep_ < MK_REPNA; ++rep_) for (int uidx = vcu2; uidx < 256; uidx += G) { const int bh = uidx >> 2, seg = uidx & 3; na::unit(P, bh >> 3, bh & 7, seg, (char*)lds, wave); } }
#endif
#endif
        if (BOTH(2)) PHASE_BARRIER_FT();
    }
    if (IN(3)) {
      for (int rep_ = 0; rep_ < MK_REP3; ++rep_) {
#if defined(MK_DUPMAIN) && MK_DUPMAIN == 3
        pg8::Gemm g{CAT, Wout_t, M, D, D, KROT(D)}; pg8::DupOrder S; S.init(M, D, G, vbx);
#define P3ORDER pg8::DupOrder
#else
        pg8::Gemm g{CAT, Wout_t, M, D, D, KROT(D)}; pg8::StaticOrder S; S.init(M, D, G, vbx);
#define P3ORDER pg8::StaticOrder
#endif
#if defined(MK_L2PF)
        { pg8::Unit u0; if (S.next(0, u0)) l2_prefetch_tile(x + (size_t)u0.pm * 256 * D + u0.pn * 256, (size_t)D * 4, 1024, tid, (unsigned)(uintptr_t)lds + 131072u); }
#endif
        pg8::EpiX1 E{x, args.out, XN, (const float*)(ws + WS_INVRS)};
        pg8::gemm_phase<pg8::EpiX1, P3ORDER, true, true>((LAS unsigned char*)lds, g, S, E, wave);
      }
        if (BOTH(3)) PHASE_BARRIER();
    }
#ifndef MK_REP4
#define MK_REP4 1
#endif
#ifndef MK_XBAR
#define MK_XBAR 0
#endif
    if (IN(4)) {
      for (int xb_ = 0; xb_ < MK_XBAR; ++xb_) GRID_BARRIER();
#if defined(MK_PP_STAGGER) && MK_PP_STAGGER == 5
        if (pp_late_)
        { pg8::Gemm g{PB, Wp_t, M, D, PLE, KROT(PLE)}; pg8::StaticOrder S; S.init(M, D, G, vbx);
          pg8::EpiBf16Plain E{PP, D};
          pg8::gemm_phase<pg8::EpiBf16Plain, pg8::StaticOrder, true, true>((LAS unsigned char*)lds, g, S, E, wave); }
#endif
      for (int rep_ = 0; rep_ < MK_REP4; ++rep_) {
#if defined(MK_DUPMAIN) && MK_DUPMAIN == 4
        pg8::Gemm g{XN, Wg_t, M, D, D, KROT(D)}; pg8::DupOrder S; S.init(M, D, G, vbx);
#define P4ORDER pg8::DupOrder
#else
        pg8::Gemm g{XN, Wg_t, M, D, D, KROT(D)}; pg8::StaticOrder S; S.init(M, D, G, vbx);
#define P4ORDER pg8::StaticOrder
#endif
#if defined(MK_L2PF)
        { pg8::Unit u0; if (S.next(0, u0)) l2_prefetch_tile(PP + (size_t)u0.pm * 256 * D + u0.pn * 256, (size_t)D * 2, 512, tid, (unsigned)(uintptr_t)lds + 131072u); }
#endif
        pg8::EpiFinal E{args.out, PP, XN};
        pg8::gemm_phase<pg8::EpiFinal, P4ORDER, true, true>((LAS unsigned char*)lds, g, S, E, wave);
      }
    }
#if defined(DA_STAMP)
    if (bx == 17 && tid == 0) { __builtin_amdgcn_s_sleep(127); __builtin_amdgcn_s_sleep(127); asm volatile("s_waitcnt vmcnt(0)" ::: "memory"); args.out[0] = ((const float*)(ws + WS_SCAL))[100 + DA_STAMPSEL]; }
#endif
#if defined(MK_CLKPROBE)
    if (bx == 17 && tid == 0) { const double ghz = (double)(pc1_ - pc0_) / (double)(pr1_ - pr0_) * 0.1;
        __builtin_amdgcn_s_sleep(127); asm volatile("s_waitcnt vmcnt(0)" ::: "memory");
#if MK_CLKVAL == 0
        args.out[0] = (float)((double)(int)(ghz * 5.0 + 0.5) * 2000.0);
#else
        args.out[0] = (float)((double)(pr1_ - pr0_) * 10.0);
#endif
    }
#endif
#undef GRID_BARRIER
#undef PHASE_BARRIER
#undef PHASE_BARRIER_FT
#undef IN
#undef BOTH
#undef tid
#undef lane
#undef leader_
}

#if defined(MK_NAIVE_ATTN)
namespace dbg {
typedef __hip_bfloat16 hb;
__device__ __forceinline__ float tof(hb v) { return __bfloat162float(v); }
__device__ __forceinline__ float wsum(float v) {
#pragma unroll
  for (int o = 32; o; o >>= 1) v += __shfl_xor(v, o);
  return v;
}
__device__ __forceinline__ float wmax(float v) {
#pragma unroll
  for (int o = 32; o; o >>= 1) v = fmaxf(v, __shfl_xor(v, o));
  return v;
}
__device__ __forceinline__ int t5b(int rel) {
  int ret = rel > 0 ? 16 : 0; int n = rel < 0 ? -rel : rel; int v;
  if (n < 8) v = n; else { float nf = (float)n; int large = 8 + (int)(logf(nf / 8.f) / 2.772588722239781f * 8.f); v = large < 15 ? large : 15; }
  return ret + v;
}
constexpr int S = 2048;
constexpr float QKS = 0.6931471805599453f;
__global__ __launch_bounds__(128) void k_diffattn(const hb* __restrict__ QA, const hb* __restrict__ KA, const hb* __restrict__ VA, const hb* __restrict__ ZA,
                                                  const float* __restrict__ t5, const float* __restrict__ lq1, const float* __restrict__ lk1, const float* __restrict__ lq2,
                                                  const float* __restrict__ lk2, const float* __restrict__ subg, hb* __restrict__ CAT) {
  __shared__ float a_s[2][2048];
  __shared__ float b_s[2][2048];
  __shared__ float q_s[2][128];
  const int w = threadIdx.x >> 6, lane = threadIdx.x & 63;
  const int task = blockIdx.x * 2 + w;
  const int q = task % S, h = (task / S) % 4, b = task / (S * 4);
  const float lam = __expf(wsum(lq1[lane] * lk1[lane])) - __expf(wsum(lq2[lane] * lk2[lane])) + 0.2f;
  const size_t tok = (size_t)b * S + q;
  q_s[w][lane] = tof(QA[tok * 512 + h * 128 + lane]);
  q_s[w][64 + lane] = tof(QA[tok * 512 + h * 128 + 64 + lane]);
  __syncthreads();
  float m1 = -1e30f, m2 = -1e30f;
  for (int i = 0; i < 32; ++i) {
    const int k = lane + 64 * i;
    const hb* kr = KA + ((size_t)b * S + k) * 512 + h * 128;
    float d1 = 0.f, d2 = 0.f;
    for (int d = 0; d < 64; ++d) { d1 += q_s[w][d] * tof(kr[d]); d2 += q_s[w][64 + d] * tof(kr[64 + d]); }
    const float bias = t5[t5b(k - q) * 4 + h];
    d1 = d1 * QKS + bias; d2 = d2 * QKS + bias;
    a_s[w][k] = d1; b_s[w][k] = d2;
    m1 = fmaxf(m1, d1); m2 = fmaxf(m2, d2);
  }
  m1 = wmax(m1); m2 = wmax(m2);
  float l1 = 0.f, l2 = 0.f;
  for (int i = 0; i < 32; ++i) {
    const int k = lane + 64 * i;
    const float e1 = __expf(a_s[w][k] - m1); a_s[w][k] = e1; l1 += e1;
    const float e2 = __expf(b_s[w][k] - m2); b_s[w][k] = e2; l2 += e2;
  }
  l1 = wsum(l1); l2 = wsum(l2);
  const float i1 = 1.f / l1, i2 = lam / l2;
  for (int i = 0; i < 32; ++i) { const int k = lane + 64 * i; a_s[w][k] = a_s[w][k] * i1 - b_s[w][k] * i2; }
  __syncthreads();
  float o0 = 0.f, o1 = 0.f;
  const hb* vb = VA + (size_t)b * S * 512 + h * 128;
  for (int k = 0; k < S; ++k) { const float a = a_s[w][k]; o0 += a * tof(vb[(size_t)k * 512 + lane]); o1 += a * tof(vb[(size_t)k * 512 + 64 + lane]); }
  const float ss = wsum(o0 * o0 + o1 * o1);
  const float r = rsqrtf(ss / 128.f + 1e-6f) * 0.8f;
  const float y0 = o0 * r * subg[lane] * tof(ZA[tok * 512 + h * 128 + lane]);
  const float y1 = o1 * r * subg[64 + lane] * tof(ZA[tok * 512 + h * 128 + 64 + lane]);
  CAT[tok * 1024 + h * 128 + lane] = __float2bfloat16(y0);
  CAT[tok * 1024 + h * 128 + 64 + lane] = __float2bfloat16(y1);
}
__global__ __launch_bounds__(256) void k_na(const hb* __restrict__ QB, const hb* __restrict__ KB, const hb* __restrict__ VB, const hb* __restrict__ ZB,
                                            const float* __restrict__ rpb, hb* __restrict__ CAT) {
  __shared__ float q_s[4][64];
  const int w = threadIdx.x >> 6, lane = threadIdx.x & 63;
  const int task = blockIdx.x * 4 + w;
  const int h = task & 7, tokl = task >> 3;
  const int b = tokl / S, s = tokl % S, r = s >> 6, c = s & 63;
  const int rs = min(max(r - 4, 0), 24), cs = min(max(c - 8, 0), 48);
  q_s[w][lane] = tof(QB[(size_t)tokl * 512 + h * 64 + lane]);
  __syncthreads();
  float sc[2]; int ktok[2];
#pragma unroll
  for (int t = 0; t < 2; ++t) {
    const int idx = lane + 64 * t, i = idx >> 4, j = idx & 15;
    const int krow = rs + i, kcol = cs + j;
    ktok[t] = b * S + krow * 64 + kcol;
    const hb* kr = KB + (size_t)ktok[t] * 512 + h * 64;
    float d = 0.f;
    for (int e = 0; e < 64; ++e) d += q_s[w][e] * tof(kr[e]);
    int dc = kcol - c; dc = min(max(dc, -15), 15) + 15;
    sc[t] = d * QKS + rpb[(h * 15 + (krow - r + 7)) * 31 + dc];
  }
  const float mx = wmax(fmaxf(sc[0], sc[1]));
  const float p0 = __expf(sc[0] - mx), p1 = __expf(sc[1] - mx);
  const float l = wsum(p0 + p1);
  float o = 0.f;
  for (int idx = 0; idx < 128; ++idx) {
    const float pp_ = __shfl(idx < 64 ? p0 : p1, idx & 63);
    const int kt = __shfl(idx < 64 ? ktok[0] : ktok[1], idx & 63);
    o += pp_ * tof(VB[(size_t)kt * 512 + h * 64 + lane]);
  }
  const float y = o / l * tof(ZB[(size_t)tokl * 512 + h * 64 + lane]);
  CAT[(size_t)tokl * 1024 + 512 + h * 64 + lane] = __float2bfloat16(y);
}
}
#endif

extern "C" void kernel_launch(void* const* d_in, const int* in_sizes, int n_in, void* d_out, int out_size, void* d_ws, size_t ws_size, hipStream_t stream) {
    static int grid = 0;
    if (grid == 0) {
        if (n_in != 18 || in_sizes[0] != M * D || out_size != M * D || ws_size < WS_END) { fprintf(stderr, "kernel_launch: unexpected shapes (n_in %d, in0 %d, out %d, ws %zu); nothing launched\n", n_in, n_in > 0 ? in_sizes[0] : -1, out_size, ws_size); grid = -1; return; }
        int dev = 0, cus = 0, per_cu = 0;
        if (hipGetDevice(&dev) != hipSuccess || hipDeviceGetAttribute(&cus, hipDeviceAttributeMultiprocessorCount, dev) != hipSuccess) { fprintf(stderr, "kernel_launch: device query failed\n"); grid = -1; return; }
        if (hipFuncSetAttribute((const void*)mk_fwd, hipFuncAttributeMaxDynamicSharedMemorySize, LDS_BYTES) != hipSuccess) { fprintf(stderr, "kernel_launch: hipFuncSetAttribute failed\n"); grid = -1; return; }
        if (hipOccupancyMaxActiveBlocksPerMultiprocessor(&per_cu, (const void*)mk_fwd, NWAVES * 64, LDS_BYTES) != hipSuccess || per_cu < 1) fprintf(stderr, "kernel_launch: note: occupancy query reports %d blocks per CU\n", per_cu);
        (void)hipGetLastError();
        if (cus != 256) { fprintf(stderr, "kernel_launch: built for a 256-CU device (the phase programs deal 256-row tiles to 256 workgroups); found %d; nothing launched\n", cus); grid = -1; return; }
        grid = cus;
    }
    if (grid < 0) return;
    if (hipMemsetAsync((char*)d_ws + WS_CTL, 0, CTL_ZERO_BYTES, stream) != hipSuccess) { fprintf(stderr, "kernel_launch: memset failed\n"); return; }
    Args a{};
    for (int i = 0; i < 18; ++i) a.in[i] = (const float*)d_in[i];
    a.out = (float*)d_out; a.ws = (unsigned char*)d_ws;
#if MK_N_LAUNCHES == 1
    a.ph_lo = 0; a.ph_hi = PER_PHASE; a.li = 0;
    hipLaunchKernelGGL(mk_fwd, dim3(grid), dim3(NWAVES * 64), LDS_BYTES, stream, a);
#if defined(MK_TWICE)
    (void)hipMemsetAsync((char*)d_ws + WS_CTL, 0, CTL_ZERO_BYTES, stream);
    hipLaunchKernelGGL(mk_fwd, dim3(grid), dim3(NWAVES * 64), LDS_BYTES, stream, a);
#endif
#else
    for (int ph = 0; ph < PER_PHASE; ++ph) {
        a.ph_lo = ph; a.ph_hi = ph + 1; a.li = ph;
        hipLaunchKernelGGL(mk_fwd, dim3(grid), dim3(NWAVES * 64), LDS_BYTES, stream, a);
#if defined(MK_NAIVE_ATTN)
        if (ph == 2) {
            typedef dbg::hb hb; hb* BUFh = (hb*)((char*)d_ws + WS_BUF); hb* CATh = (hb*)((char*)d_ws + WS_CAT); const size_t BS = (size_t)M * 512;
            if (MK_NAIVE_ATTN & 1) dbg::k_diffattn<<<BATCH * 4 * SEQ / 2, 128, 0, stream>>>(BUFh, BUFh + BS, BUFh + 2 * BS, BUFh + 3 * BS, (const float*)d_in[12], (const float*)d_in[7], (const float*)d_in[8], (const float*)d_in[9], (const float*)d_in[10], (const float*)d_in[11], CATh);
            if (MK_NAIVE_ATTN & 2) dbg::k_na<<<M * 8 / 4, 256, 0, stream>>>(BUFh + 4 * BS, BUFh + 5 * BS, BUFh + 6 * BS, BUFh + 7 * BS, (const float*)d_in[15], CATh);
        }
#endif
    }
#endif
    const hipError_t le = hipPeekAtLastError();
    if (le != hipSuccess) fprintf(stderr, "kernel_launch: launch failed: %s (grid %d)\n", hipGetErrorName(le), grid);
}
```

```cpp
#include <hip/hip_runtime.h>
#include <hip/hip_bf16.h>
#include <cstdio>
#include <cstdint>
__device__ __forceinline__ int mk_lane() { int l; asm volatile("v_mbcnt_lo_u32_b32 %0, -1, 0\n\tv_mbcnt_hi_u32_b32 %0, -1, %0" : "=v"(l)); return l; }
#define MK_N_LAUNCHES 1
#define MK_FLATBAR 2
#define MK_XLOCAL
#define MK_XNP
#define MK_TAILPF
#define MK_PP_STAGGER 1
#define MK_P0T64
#define MK_P0SPREAD 2
#define MK_LATEREG
#define MK_EPIBATCH
#define MK_EPIFAST
#define MK_P0EVEN
#define MK_LATETBL
#define MK_NA_NOLOOP
#define MK_EARLYINV
#define MK_DA_OX2
#define MK_DA_GPRE
#define MK_GAINS_LDS
#define MK_DA_PAIR
#define MK_DA_SADDR
#define MK_PG8_SADDR
#define MK_NA_LATEWAIT 2
#define MK_NA_FILLSPLIT
#define MK_NA_XSTEP
#define MK_NA_SPLIT
#define MK_NA_SADDR
#define MK_DA_QF2
#if defined(MK_NAIVE_ATTN)
#if (MK_NAIVE_ATTN & 1)
#define MK_SKIP_DA
#endif
#if (MK_NAIVE_ATTN & 2)
#define MK_SKIP_NA
#endif
#endif
namespace pg8 {
#define PG8_LAS __attribute__((address_space(3)))
typedef unsigned short bf16_t;
typedef short bf16x8 __attribute__((ext_vector_type(8)));
typedef float f32x4 __attribute__((ext_vector_type(4)));
typedef unsigned u32x4 __attribute__((ext_vector_type(4)));
constexpr int BM = 256, BK = 64, HALF = 128, HTB = HALF * BK * 2  , STAGE_BYTES = 8 * HTB, NXCD = 8,
#if defined(MK_WGM)
    WGM = MK_WGM;
#else
    WGM = 8;
#endif

__host__ __device__ __forceinline__ int lds_byte(int r, int c) { const int st = (r >> 4) * 2 + (c >> 5), rr = r & 15, cc = c & 31, ob = rr * 64 + cc * 2; return st * 1024 + (ob ^ (((ob >> 9) & 1) << 5)); }
__host__ __device__ __forceinline__ void stage_rc(int b, int& R, int& C) { const int st = b / 1024, sb = b % 1024, swz = sb ^ (((sb >> 9) & 1) << 5); R = (st >> 1) * 16 + swz / 64; C = (st & 1) * 32 + (swz % 64) / 2; }
__host__ __device__ __forceinline__ int perm32(int rho) { const int n = rho >> 4, i = rho & 15; return 8 * (i >> 2) + 4 * n + (i & 3); }

struct Unit { int pm, pn; int skip; int alt; };
struct Gemm { const bf16_t* A; const bf16_t* Bt; int M, N, K; int k0 = 0; };

struct StaticOrder {
    int nM, nN, nwg, G, c, rot;
    __host__ __device__ void init(int M, int N, int G_, int c_, int rot_ = 0) { nM = M / BM; nN = N / BM; nwg = nM * nN; G = G_; c = c_; rot = rot_; }
    __host__ __device__ bool next(int i, Unit& u) const {
        const long L = (long)i * G + c; if (L >= nwg) return false;
        int wgid = (int)L; { const int q = nwg / NXCD, r = nwg % NXCD, xcd = wgid % NXCD, off = wgid / NXCD; wgid = (xcd < r ? xcd * (q + 1) : r * (q + 1) + (xcd - r) * q) + off; }
        const int nig = WGM * nN, gid = wgid / nig, fm = gid * WGM, gsz = (nM - fm) < WGM ? (nM - fm) : WGM;
        u.pm = fm + ((wgid % nig) % gsz); u.pn = ((wgid % nig) / gsz + rot) % nN; u.skip = 0; u.alt = 0; return true;
    }
    __device__ __forceinline__ void a_ready(const Unit&) const {}
    __device__ __forceinline__ void done(const Unit&) const {}
};
struct DupOrder : StaticOrder {
    __host__ __device__ bool next(int i, Unit& u) const { const bool r = StaticOrder::next(i >> 1, u); u.skip = (i & 1) ? 0 : 1; return r; }
};
struct P1Order {
    StaticOrder in, pp; int n_in; bool pp_first;
    __host__ __device__ void init(int M, int Nin, int Npp, int G_, int c_, bool pp_first_) { in.init(M, Nin, G_, c_); pp.init(M, Npp, G_, c_); n_in = (in.nwg - c_ + G_ - 1) / G_; pp_first = pp_first_; }
    __host__ __device__ bool next(int i, Unit& u) const {
        if (pp_first) { if (i == 0) { const bool r = pp.next(0, u); u.alt = 1; return r; } return in.next(i - 1, u); }
        if (i < n_in) return in.next(i, u);
        if (i == n_in) { const bool r = pp.next(0, u); u.alt = 1; return r; }
        return false;
    }
};
__device__ __forceinline__ unsigned cvt_pk_bf16(float lo, float hi) { unsigned r; asm volatile("v_cvt_pk_bf16_f32 %0, %1, %2" : "=v"(r) : "v"(lo), "v"(hi)); return r; }
__device__ __forceinline__ float sigmoidf_fast(float v) { return __builtin_amdgcn_rcpf(1.0f + __builtin_amdgcn_exp2f(-1.4426950408889634f * v)); }
constexpr int M_ROWS = 16384;
__device__ __forceinline__ void store16_sc1(void* p, u32x4 v) { asm volatile("global_store_dwordx4 %0, %1, off sc1\n\ts_nop 1" :: "v"(p), "v"(v) : "memory"); }

struct EpiBf16Plain {
    static constexpr bool PERM = true, AFTER_DRAIN = false; static constexpr int NSTORES = 16;
    bf16_t* O; int ldc;
    __device__ __forceinline__ const char* tail_a(const Unit&, const char* d) const { return d; }
    __device__ __forceinline__ const char* tail_b(const Unit&, const char* d) const { return d; }
    __device__ __forceinline__ void operator()(const f32x4 (&acc)[2][2][4][2], const Unit& u, int wr, int wc, int fr, int fq) const {
        const int row0 = u.pm * BM + wr * 64 + fr, col0 = u.pn * BM + wc * 32 + 8 * fq;
#pragma unroll
        for (int ai = 0; ai < 2; ++ai)
#pragma unroll
            for (int m = 0; m < 4; ++m) { bf16_t* rowp = O + (size_t)(row0 + ai * HALF + m * 16) * ldc + col0;
#pragma unroll
                for (int bj = 0; bj < 2; ++bj) { const f32x4 v0 = acc[ai][bj][m][0], v1 = acc[ai][bj][m][1];
                    u32x4 w; w.x = cvt_pk_bf16(v0[0], v0[1]); w.y = cvt_pk_bf16(v0[2], v0[3]); w.z = cvt_pk_bf16(v1[0], v1[1]); w.w = cvt_pk_bf16(v1[2], v1[3]);
                    *(u32x4*)(rowp + bj * HALF) = w; } }
    }
};

#if defined(MK_BUF_NT)
#define BUF_STORE(p, w) __builtin_nontemporal_store((w), (u32x4*)(p))
#else
#define BUF_STORE(p, w) (*(u32x4*)(p) = (w))
#endif
__device__ __forceinline__ void buf_store_pair_s(const void* sbase, unsigned off, const u32x4 w0, const u32x4 w1) {
    asm volatile("global_store_dwordx4 %0, %1, %3\n\tglobal_store_dwordx4 %0, %2, %3 offset:64\n\ts_nop 1" :: "v"(off), "v"(w0), "v"(w1), "s"(sbase) : "memory");
}
__device__ __forceinline__ void buf_store_pair(bf16_t* rowp, int fr, const u32x4 w0, const u32x4 w1) {
#if defined(MK_FULLLINE)
    const bool lo = fr < 8;
    u32x4 snd, rcv;
    snd.x = lo ? w1.x : w0.x; snd.y = lo ? w1.y : w0.y; snd.z = lo ? w1.z : w0.z; snd.w = lo ? w1.w : w0.w;
    rcv.x = (unsigned)__builtin_amdgcn_update_dpp(0, (int)snd.x, 0x128, 0xf, 0xf, false); rcv.y = (unsigned)__builtin_amdgcn_update_dpp(0, (int)snd.y, 0x128, 0xf, 0xf, false);
    rcv.z = (unsigned)__builtin_amdgcn_update_dpp(0, (int)snd.z, 0x128, 0xf, 0xf, false); rcv.w = (unsigned)__builtin_amdgcn_update_dpp(0, (int)snd.w, 0x128, 0xf, 0xf, false);
    u32x4 a, b;
    a.x = lo ? w0.x : rcv.x; a.y = lo ? w0.y : rcv.y; a.z = lo ? w0.z : rcv.z; a.w = lo ? w0.w : rcv.w;
    b.x = lo ? rcv.x : w1.x; b.y = lo ? rcv.y : w1.y; b.z = lo ? rcv.z : w1.z; b.w = lo ? rcv.w : w1.w;
    bf16_t* pa = lo ? rowp : rowp - 8 * 512 + 32;
    BUF_STORE(pa, a); BUF_STORE(pa + 8 * 512, b);
#else
    BUF_STORE(rowp, w0); BUF_STORE(rowp + 32, w1);
#if defined(MK_DUPSTORE)
    asm volatile("" ::: "memory"); BUF_STORE(rowp, w0); BUF_STORE(rowp + 32, w1);
#endif
#endif
}
struct EpiProj {
    static constexpr bool PERM = true, AFTER_DRAIN = false; static constexpr int NSTORES =
#if defined(MK_DUPEPI1)
        17;
#else
        16;
#endif
    static constexpr int NSTORES_DOC = 16;
    bf16_t* buf;
#if defined(MK_GAINS_LDS)
    const float* gains; const PG8_LAS float* gl;
#else
    const float* gains;
#endif
    __device__ __forceinline__ const char* tail_a(const Unit&, const char* d) const { return d; }
    __device__ __forceinline__ const char* tail_b(const Unit&, const char* d) const { return d; }
    __device__ __forceinline__ void operator()(const f32x4 (&acc)[2][2][4][2], const Unit& u, int wr, int wc, int fr, int fq) const {
#if defined(MK_TBAL)
        const int t0_ = u.pn >> 1, type = t0_ >= 6 ? (t0_ ^ 1) : t0_, half = u.pn & 1;
#else
        const int type = u.pn >> 1, half = u.pn & 1;
#endif
        if (u.skip) return;
        bf16_t* base = buf + (size_t)type * ((size_t)M_ROWS * 512);
        const int row0 = u.pm * BM + wr * 64 + fr;
        const int lc0 = half * 256 + 64 * wc + 8 * fq;
        if (type == 0 || type == 1 || type == 4 || type == 5) {
            const float* g = gains + ((type & 1) + (type >> 2) * 2) * 64;
#if defined(MK_EPIBATCH)
            f32x4 gq_[2][2];
#pragma unroll
#if defined(MK_GAINS_LDS)
            for (int bj = 0; bj < 2; ++bj) { const PG8_LAS float* gs = gl + ((type & 1) + (type >> 2) * 2) * 64 + 32 * bj + 8 * fq; gq_[bj][0] = *(const PG8_LAS f32x4*)gs; gq_[bj][1] = *(const PG8_LAS f32x4*)(gs + 4); }
#else
            for (int bj = 0; bj < 2; ++bj) { gq_[bj][0] = *(const f32x4*)(g + 32 * bj + 8 * fq); gq_[bj][1] = *(const f32x4*)(g + 32 * bj + 8 * fq + 4); }
#endif
#endif
#if defined(MK_EPIFAST)
            float rs_[2][4];
#pragma unroll
            for (int ai = 0; ai < 2; ++ai)
#pragma unroll
                for (int m = 0; m < 4; ++m) { float ss = 0.f;
#pragma unroll
                    for (int bj = 0; bj < 2; ++bj)
#pragma unroll
                        for (int n = 0; n < 2; ++n) { const f32x4 x = acc[ai][bj][m][n]; ss += (x[0] * x[0] + x[1] * x[1]) + (x[2] * x[2] + x[3] * x[3]); }
                    typedef unsigned u32x2_ __attribute__((ext_vector_type(2)));
                    const u32x2_ r1 = __builtin_amdgcn_permlane16_swap(__float_as_uint(ss), __float_as_uint(ss), false, false);
                    const float t1 = __uint_as_float(r1.x) + __uint_as_float(r1.y);
                    const u32x2_ r2 = __builtin_amdgcn_permlane32_swap(__float_as_uint(t1), __float_as_uint(t1), false, false);
                    rs_[ai][m] = rsqrtf((__uint_as_float(r2.x) + __uint_as_float(r2.y)) * (1.0f / 64.0f) + 1e-6f); }
#pragma unroll
            for (int ai = 0; ai < 2; ++ai)
#pragma unroll
                for (int m = 0; m < 4; ++m) { const float rs = rs_[ai][m];
                    bf16_t* rowp = base + (size_t)(row0 + ai * HALF + m * 16) * 512 + lc0;
                    u32x4 wq_[2];
#pragma unroll
                    for (int bj = 0; bj < 2; ++bj) {
                        const f32x4 g0 = gq_[bj][0], g1 = gq_[bj][1];
                        const f32x4 v0 = acc[ai][bj][m][0] * rs * g0, v1 = acc[ai][bj][m][1] * rs * g1;
                        u32x4 w; w.x = cvt_pk_bf16(v0[0], v0[1]); w.y = cvt_pk_bf16(v0[2], v0[3]); w.z = cvt_pk_bf16(v1[0], v1[1]); w.w = cvt_pk_bf16(v1[2], v1[3]);
                        wq_[bj] = w; }
#if defined(MK_ST_SADDR)
                    buf_store_pair_s((const void*)base, (unsigned)(((row0 + ai * HALF + m * 16) * 512 + lc0) * 2), wq_[0], wq_[1]); }
#else
                    buf_store_pair(rowp, fr, wq_[0], wq_[1]); }
#endif
#else
#pragma unroll
            for (int ai = 0; ai < 2; ++ai)
#pragma unroll
                for (int m = 0; m < 4; ++m) {
                    float ss = 0.f;
#pragma unroll
                    for (int bj = 0; bj < 2; ++bj)
#pragma unroll
                        for (int n = 0; n < 2; ++n) { const f32x4 x = acc[ai][bj][m][n]; ss += (x[0] * x[0] + x[1] * x[1]) + (x[2] * x[2] + x[3] * x[3]); }
                    ss += __shfl_xor(ss, 16); ss += __shfl_xor(ss, 32);
                    const float rs = rsqrtf(ss * (1.0f / 64.0f) + 1e-6f);
                    bf16_t* rowp = base + (size_t)(row0 + ai * HALF + m * 16) * 512 + lc0;
#pragma unroll
                    for (int bj = 0; bj < 2; ++bj) {
#if defined(MK_EPIBATCH)
                        const f32x4 g0 = gq_[bj][0], g1 = gq_[bj][1];
#else
                        const f32x4 g0 = *(const f32x4*)(g + 32 * bj + 8 * fq), g1 = *(const f32x4*)(g + 32 * bj + 8 * fq + 4);
#endif
                        const f32x4 v0 = acc[ai][bj][m][0] * rs * g0, v1 = acc[ai][bj][m][1] * rs * g1;
                        u32x4 w; w.x = cvt_pk_bf16(v0[0], v0[1]); w.y = cvt_pk_bf16(v0[2], v0[3]); w.z = cvt_pk_bf16(v1[0], v1[1]); w.w = cvt_pk_bf16(v1[2], v1[3]);
                        BUF_STORE(rowp + 32 * bj, w); }
                    asm volatile("" ::: "memory");
                }
#endif
        } else {
#if defined(MK_SILU_LATE)
            const bool act = false;
#else
            const bool act = (type == 3 || type == 7);
#endif
#pragma unroll
            for (int ai = 0; ai < 2; ++ai)
#pragma unroll
                for (int m = 0; m < 4; ++m) { bf16_t* rowp = base + (size_t)(row0 + ai * HALF + m * 16) * 512 + lc0;
                    u32x4 wq_[2];
#pragma unroll
                    for (int bj = 0; bj < 2; ++bj) { f32x4 v0 = acc[ai][bj][m][0], v1 = acc[ai][bj][m][1];
                        if (act) {
#pragma unroll
                            for (int e = 0; e < 4; ++e) { v0[e] = v0[e] * sigmoidf_fast(v0[e]); v1[e] = v1[e] * sigmoidf_fast(v1[e]); } }
                        u32x4 w; w.x = cvt_pk_bf16(v0[0], v0[1]); w.y = cvt_pk_bf16(v0[2], v0[3]); w.z = cvt_pk_bf16(v1[0], v1[1]); w.w = cvt_pk_bf16(v1[2], v1[3]);
                        wq_[bj] = w; }
#if defined(MK_ST_SADDR)
                    buf_store_pair_s((const void*)base, (unsigned)(((row0 + ai * HALF + m * 16) * 512 + lc0) * 2), wq_[0], wq_[1]); }
#else
                    buf_store_pair(rowp, fr, wq_[0], wq_[1]); }
#endif
        }
    }
};

struct EpiP1 {
    static constexpr bool PERM = true, AFTER_DRAIN = false; static constexpr int NSTORES = 16;
    EpiProj a; EpiBf16Plain b;
    __device__ __forceinline__ void operator()(const f32x4 (&acc)[2][2][4][2], const Unit& u, int wr, int wc, int fr, int fq) const { if (u.alt) b(acc, u, wr, wc, fr, fq); else a(acc, u, wr, wc, fr, fq); }
};

struct EpiX1 {
    static constexpr bool PERM = true, AFTER_DRAIN = false; static constexpr int NSTORES = 16;
    const float* x; float* x1; bf16_t* x1b; const float* inv;
#if defined(MK_TAILPF) && defined(MK_XNP) && !defined(MK_XNP_NOEPI)
    __device__ __forceinline__ const char* tail_b(const Unit& u, const char*) const { return (const char*)(x1b + (size_t)u.pm * BM * 1024 + (size_t)u.pn * BM); }
    __device__ __forceinline__ const char* tail_a(const Unit& u, const char*) const { return (const char*)(x1b + (size_t)u.pm * BM * 1024 + (size_t)u.pn * BM) + 256; }
#else
    __device__ __forceinline__ const char* tail_a(const Unit&, const char* d) const { return d; }
    __device__ __forceinline__ const char* tail_b(const Unit&, const char* d) const { return d; }
#endif
    __device__ __forceinline__ void operator()(const f32x4 (&acc)[2][2][4][2], const Unit& u, int wr, int wc, int fr, int fq) const {
        if (u.skip) return;
        const int row0 = u.pm * BM + wr * 64 + fr, col0 = u.pn * BM + wc * 32 + 8 * fq;
#if defined(MK_EPIBATCH) && defined(MK_XNP) && !defined(MK_XNP_NOEPI)
        u32x4 xw_[2][4][2]; float sc_[2][4];
#pragma unroll
        for (int ai = 0; ai < 2; ++ai)
#pragma unroll
            for (int m = 0; m < 4; ++m) { const size_t off = (size_t)(row0 + ai * HALF + m * 16) * 1024 + col0; sc_[ai][m] = inv[row0 + ai * HALF + m * 16];
#pragma unroll
                for (int bj = 0; bj < 2; ++bj) xw_[ai][m][bj] = __builtin_nontemporal_load((const u32x4*)(x1b + off + bj * HALF)); }
        asm volatile("" ::: "memory");
#pragma unroll
        for (int ai = 0; ai < 2; ++ai)
#pragma unroll
            for (int m = 0; m < 4; ++m) { const size_t off = (size_t)(row0 + ai * HALF + m * 16) * 1024 + col0; const float sc = sc_[ai][m];
#pragma unroll
                for (int bj = 0; bj < 2; ++bj) { const size_t o = off + bj * HALF; const u32x4 xw = xw_[ai][m][bj];
                    f32x4 v0 = acc[ai][bj][m][0], v1 = acc[ai][bj][m][1];
                    v0[0] += __uint_as_float(xw.x << 16) * sc; v0[1] += __uint_as_float(xw.x & 0xffff0000u) * sc; v0[2] += __uint_as_float(xw.y << 16) * sc; v0[3] += __uint_as_float(xw.y & 0xffff0000u) * sc;
                    v1[0] += __uint_as_float(xw.z << 16) * sc; v1[1] += __uint_as_float(xw.z & 0xffff0000u) * sc; v1[2] += __uint_as_float(xw.w << 16) * sc; v1[3] += __uint_as_float(xw.w & 0xffff0000u) * sc;
                    u32x4 w; w.x = cvt_pk_bf16(v0[0], v0[1]); w.y = cvt_pk_bf16(v0[2], v0[3]); w.z = cvt_pk_bf16(v1[0], v1[1]); w.w = cvt_pk_bf16(v1[2], v1[3]);
#if defined(MK_X1B_SC1)
                    store16_sc1((void*)(x1b + o), w); } }
#elif defined(MK_X1B_NT)
                    __builtin_nontemporal_store(w, (u32x4*)(x1b + o)); } }
#else
                    *(u32x4*)(x1b + o) = w; } }
#endif
        return;
#endif
#pragma unroll
        for (int ai = 0; ai < 2; ++ai)
#pragma unroll
            for (int m = 0; m < 4; ++m) { const size_t off = (size_t)(row0 + ai * HALF + m * 16) * 1024 + col0;
#if defined(MK_XNP) && !defined(MK_XNP_NOEPI)
                const float sc = inv[row0 + ai * HALF + m * 16];
#endif
#pragma unroll
                for (int bj = 0; bj < 2; ++bj) { const size_t o = off + bj * HALF;
#if defined(MK_XNP) && !defined(MK_XNP_NOEPI)
                    const u32x4 xw = __builtin_nontemporal_load((const u32x4*)(x1b + o));
                    f32x4 v0 = acc[ai][bj][m][0], v1 = acc[ai][bj][m][1];
                    v0[0] += __uint_as_float(xw.x << 16) * sc; v0[1] += __uint_as_float(xw.x & 0xffff0000u) * sc; v0[2] += __uint_as_float(xw.y << 16) * sc; v0[3] += __uint_as_float(xw.y & 0xffff0000u) * sc;
                    v1[0] += __uint_as_float(xw.z << 16) * sc; v1[1] += __uint_as_float(xw.z & 0xffff0000u) * sc; v1[2] += __uint_as_float(xw.w << 16) * sc; v1[3] += __uint_as_float(xw.w & 0xffff0000u) * sc;
#else
                    const f32x4 v0 = acc[ai][bj][m][0] + __builtin_nontemporal_load((const f32x4*)(x + o)), v1 = acc[ai][bj][m][1] + __builtin_nontemporal_load((const f32x4*)(x + o + 4));
#endif
#if defined(MK_X1_F32)
                    *(f32x4*)(x1 + o) = v0; *(f32x4*)(x1 + o + 4) = v1;
#endif
                    u32x4 w; w.x = cvt_pk_bf16(v0[0], v0[1]); w.y = cvt_pk_bf16(v0[2], v0[3]); w.z = cvt_pk_bf16(v1[0], v1[1]); w.w = cvt_pk_bf16(v1[2], v1[3]);
                    *(u32x4*)(x1b + o) = w; } }
    }
};

struct EpiFinal {
    static constexpr bool PERM = true, AFTER_DRAIN = false; static constexpr int NSTORES = 16;
    float* out; const bf16_t* pp; const bf16_t* x1b;
#if defined(MK_TAILPF)
    __device__ __forceinline__ const char* tail_b(const Unit& u, const char*) const { return (const char*)(pp + (size_t)u.pm * BM * 1024 + (size_t)u.pn * BM); }
    __device__ __forceinline__ const char* tail_a(const Unit& u, const char*) const { return (const char*)(pp + (size_t)u.pm * BM * 1024 + (size_t)u.pn * BM) + 256; }
#else
    __device__ __forceinline__ const char* tail_a(const Unit&, const char* d) const { return d; }
    __device__ __forceinline__ const char* tail_b(const Unit&, const char* d) const { return d; }
#endif
    __device__ __forceinline__ void operator()(const f32x4 (&acc)[2][2][4][2], const Unit& u, int wr, int wc, int fr, int fq) const {
        if (u.skip) return;
        const int row0 = u.pm * BM + wr * 64 + fr, col0 = u.pn * BM + wc * 32 + 8 * fq;
#if defined(MK_EPIPIPE) && !defined(MK_X1_F32)
#define EF_LOAD(G, PW, XQ) do { _Pragma("unroll") for (int q_ = 0; q_ < 4; ++q_) { const int m_ = 2 * ((G) & 1) + (q_ >> 1), bj_ = q_ & 1; \
            const size_t o_ = (size_t)(row0 + ((G) >> 1) * HALF + m_ * 16) * 1024 + col0 + bj_ * HALF; \
            PW[q_] = __builtin_nontemporal_load((const u32x4*)(pp + o_)); XQ[q_] = *(const u32x4*)(x1b + o_); } } while (0)
#define EF_COMP(G, PW, XQ) do { _Pragma("unroll") for (int q_ = 0; q_ < 4; ++q_) { const int m_ = 2 * ((G) & 1) + (q_ >> 1), bj_ = q_ & 1; \
            const size_t o_ = (size_t)(row0 + ((G) >> 1) * HALF + m_ * 16) * 1024 + col0 + bj_ * HALF; const u32x4 pw = PW[q_], xw = XQ[q_]; \
            f32x4 p0, p1, v0, v1; \
            p0[0] = __uint_as_float(pw.x << 16); p0[1] = __uint_as_float(pw.x & 0xffff0000u); p0[2] = __uint_as_float(pw.y << 16); p0[3] = __uint_as_float(pw.y & 0xffff0000u); \
            p1[0] = __uint_as_float(pw.z << 16); p1[1] = __uint_as_float(pw.z & 0xffff0000u); p1[2] = __uint_as_float(pw.w << 16); p1[3] = __uint_as_float(pw.w & 0xffff0000u); \
            v0[0] = __uint_as_float(xw.x << 16); v0[1] = __uint_as_float(xw.x & 0xffff0000u); v0[2] = __uint_as_float(xw.y << 16); v0[3] = __uint_as_float(xw.y & 0xffff0000u); \
            v1[0] = __uint_as_float(xw.z << 16); v1[1] = __uint_as_float(xw.z & 0xffff0000u); v1[2] = __uint_as_float(xw.w << 16); v1[3] = __uint_as_float(xw.w & 0xffff0000u); \
            const f32x4 a0 = acc[(G) >> 1][bj_][m_][0], a1 = acc[(G) >> 1][bj_][m_][1]; \
            _Pragma("unroll") for (int e_ = 0; e_ < 4; ++e_) { v0[e_] += sigmoidf_fast(a0[e_]) * p0[e_]; v1[e_] += sigmoidf_fast(a1[e_]) * p1[e_]; } \
            __builtin_nontemporal_store(v0, (f32x4*)(out + o_)); __builtin_nontemporal_store(v1, (f32x4*)(out + o_ + 4)); } } while (0)
        { u32x4 pA_[4], xA_[4], pB_[4], xB_[4];
          EF_LOAD(0, pA_, xA_); EF_LOAD(1, pB_, xB_); asm volatile("" ::: "memory");
          EF_COMP(0, pA_, xA_); asm volatile("" ::: "memory"); EF_LOAD(2, pA_, xA_); asm volatile("" ::: "memory");
          EF_COMP(1, pB_, xB_); asm volatile("" ::: "memory"); EF_LOAD(3, pB_, xB_); asm volatile("" ::: "memory");
          EF_COMP(2, pA_, xA_); EF_COMP(3, pB_, xB_); }
#undef EF_LOAD
#undef EF_COMP
        return;
#endif
#if defined(MK_EPIBATCH) && !defined(MK_X1_F32)
#ifndef MK_DUPEPI4
#define MK_DUPEPI4 1
#endif
#pragma unroll
        for (int de_ = 0; de_ < MK_DUPEPI4; ++de_)
#pragma unroll
        for (int ai = 0; ai < 2; ++ai) {
            u32x4 pw_[4][2], xq_[4][2];
#pragma unroll
            for (int m = 0; m < 4; ++m) { const size_t off = (size_t)(row0 + ai * HALF + m * 16) * 1024 + col0;
#pragma unroll
                for (int bj = 0; bj < 2; ++bj) { pw_[m][bj] = __builtin_nontemporal_load((const u32x4*)(pp + off + bj * HALF)); xq_[m][bj] = *(const u32x4*)(x1b + off + bj * HALF); } }
            asm volatile("" ::: "memory");
#pragma unroll
            for (int m = 0; m < 4; ++m) { const size_t off = (size_t)(row0 + ai * HALF + m * 16) * 1024 + col0;
#pragma unroll
                for (int bj = 0; bj < 2; ++bj) { const size_t o = off + bj * HALF; const u32x4 pw = pw_[m][bj], xw = xq_[m][bj];
                    f32x4 p0, p1, v0, v1;
                    p0[0] = __uint_as_float(pw.x << 16); p0[1] = __uint_as_float(pw.x & 0xffff0000u); p0[2] = __uint_as_float(pw.y << 16); p0[3] = __uint_as_float(pw.y & 0xffff0000u);
                    p1[0] = __uint_as_float(pw.z << 16); p1[1] = __uint_as_float(pw.z & 0xffff0000u); p1[2] = __uint_as_float(pw.w << 16); p1[3] = __uint_as_float(pw.w & 0xffff0000u);
                    v0[0] = __uint_as_float(xw.x << 16); v0[1] = __uint_as_float(xw.x & 0xffff0000u); v0[2] = __uint_as_float(xw.y << 16); v0[3] = __uint_as_float(xw.y & 0xffff0000u);
                    v1[0] = __uint_as_float(xw.z << 16); v1[1] = __uint_as_float(xw.z & 0xffff0000u); v1[2] = __uint_as_float(xw.w << 16); v1[3] = __uint_as_float(xw.w & 0xffff0000u);
                    const f32x4 a0 = acc[ai][bj][m][0], a1 = acc[ai][bj][m][1];
#pragma unroll
                    for (int e_ = 0; e_ < 4; ++e_) { v0[e_] += sigmoidf_fast(a0[e_]) * p0[e_]; v1[e_] += sigmoidf_fast(a1[e_]) * p1[e_]; }
#if defined(MK_OUT_PLAIN)
                    *(f32x4*)(out + o) = v0; *(f32x4*)(out + o + 4) = v1; } }
#elif defined(MK_OUTSWZ)
                    { typedef unsigned u32x2_ __attribute__((ext_vector_type(2)));
                      f32x4 w0, w1;
#pragma unroll
                      for (int e_ = 0; e_ < 4; ++e_) { const u32x2_ s1 = __builtin_amdgcn_permlane16_swap(__float_as_uint(v0[e_]), __float_as_uint(v1[e_]), false, false);
                          const u32x2_ s2 = __builtin_amdgcn_permlane32_swap(s1.x, s1.y, false, false); w0[e_] = __uint_as_float(s2.x); w1[e_] = __uint_as_float(s2.y); }
                      float* ob = out + (o - 8 * fq) + 4 * fq;
                      __builtin_nontemporal_store(w0, (f32x4*)ob); __builtin_nontemporal_store(w1, (f32x4*)(ob + 16)); } } }
#else
                    __builtin_nontemporal_store(v0, (f32x4*)(out + o)); __builtin_nontemporal_store(v1, (f32x4*)(out + o + 4));
#if defined(MK_DUPSTORE4)
                    asm volatile("" ::: "memory"); __builtin_nontemporal_store(v0, (f32x4*)(out + o)); __builtin_nontemporal_store(v1, (f32x4*)(out + o + 4));
#endif
                    } }
#endif
        }
        return;
#endif
#pragma unroll
        for (int ai = 0; ai < 2; ++ai)
#pragma unroll
            for (int m = 0; m < 4; ++m) { const size_t off = (size_t)(row0 + ai * HALF + m * 16) * 1024 + col0;
#pragma unroll
                for (int bj = 0; bj < 2; ++bj) { const size_t o = off + bj * HALF;
                    const u32x4 pw = __builtin_nontemporal_load((const u32x4*)(pp + o));
                    f32x4 p0, p1;
                    p0[0] = __uint_as_float(pw.x << 16); p0[1] = __uint_as_float(pw.x & 0xffff0000u); p0[2] = __uint_as_float(pw.y << 16); p0[3] = __uint_as_float(pw.y & 0xffff0000u);
                    p1[0] = __uint_as_float(pw.z << 16); p1[1] = __uint_as_float(pw.z & 0xffff0000u); p1[2] = __uint_as_float(pw.w << 16); p1[3] = __uint_as_float(pw.w & 0xffff0000u);
#if defined(MK_X1_F32)
                    f32x4 v0 = *(const f32x4*)(out + o), v1 = *(const f32x4*)(out + o + 4);
#else
                    const u32x4 xw = *(const u32x4*)(x1b + o);
                    f32x4 v0, v1;
                    v0[0] = __uint_as_float(xw.x << 16); v0[1] = __uint_as_float(xw.x & 0xffff0000u); v0[2] = __uint_as_float(xw.y << 16); v0[3] = __uint_as_float(xw.y & 0xffff0000u);
                    v1[0] = __uint_as_float(xw.z << 16); v1[1] = __uint_as_float(xw.z & 0xffff0000u); v1[2] = __uint_as_float(xw.w << 16); v1[3] = __uint_as_float(xw.w & 0xffff0000u);
#endif
                    const f32x4 a0 = acc[ai][bj][m][0], a1 = acc[ai][bj][m][1];
#pragma unroll
                    for (int e = 0; e < 4; ++e) { v0[e] += sigmoidf_fast(a0[e]) * p0[e]; v1[e] += sigmoidf_fast(a1[e]) * p1[e]; }
                    __builtin_nontemporal_store(v0, (f32x4*)(out + o)); __builtin_nontemporal_store(v1, (f32x4*)(out + o + 4)); } }
    }
};

#if defined(MK_M0CLOB)
__device__ __forceinline__ void pg8_stage2_s(const void* sbase, unsigned off0, unsigned off1, unsigned lds_dst) {
    asm volatile("s_mov_b32 m0, %3\n\ts_nop 0\n\tglobal_load_lds_dwordx4 %0, %2\n\ts_addk_i32 m0, 0x2000\n\ts_nop 0\n\tglobal_load_lds_dwordx4 %1, %2"
                 :: "v"(off0), "v"(off1), "s"(sbase), "s"(lds_dst) : "memory", "scc", "m0"); }
#else
__device__ __forceinline__ void pg8_stage2_s(const void* sbase, unsigned off0, unsigned off1, unsigned lds_dst) { unsigned keep;
    asm volatile("s_mov_b32 %0, m0\n\ts_mov_b32 m0, %4\n\ts_nop 0\n\tglobal_load_lds_dwordx4 %1, %3\n\ts_addk_i32 m0, 0x2000\n\ts_nop 0\n\tglobal_load_lds_dwordx4 %2, %3\n\ts_mov_b32 m0, %0"
                 : "=&s"(keep) : "v"(off0), "v"(off1), "s"(sbase), "s"(lds_dst) : "memory", "scc"); }
#endif
__device__ __forceinline__ void pg8_stage6_s(const void* b0, const void* b1, const void* a0, unsigned ob0, unsigned ob1, unsigned oa0, unsigned oa1, unsigned lds_b, unsigned lds_a) { unsigned keep;
    asm volatile("s_mov_b32 %0, m0\n\ts_mov_b32 m0, %8\n\ts_nop 0\n\tglobal_load_lds_dwordx4 %1, %5\n\ts_addk_i32 m0, 0x2000\n\ts_nop 0\n\tglobal_load_lds_dwordx4 %2, %5\n\t"
                 "s_addk_i32 m0, 0x2000\n\ts_nop 0\n\tglobal_load_lds_dwordx4 %1, %6\n\ts_addk_i32 m0, 0x2000\n\ts_nop 0\n\tglobal_load_lds_dwordx4 %2, %6\n\t"
                 "s_mov_b32 m0, %9\n\ts_nop 0\n\tglobal_load_lds_dwordx4 %3, %7\n\ts_addk_i32 m0, 0x2000\n\ts_nop 0\n\tglobal_load_lds_dwordx4 %4, %7\n\ts_mov_b32 m0, %0"
                 : "=&s"(keep) : "v"(ob0), "v"(ob1), "v"(oa0), "v"(oa1), "s"(b0), "s"(b1), "s"(a0), "s"(lds_b), "s"(lds_a) : "memory", "scc"); }
template <class Epi, class Sched, bool ALIGN_EPI = false, bool SP2 = false>
__device__ __forceinline__ void gemm_phase(PG8_LAS unsigned char* lds, const Gemm g, const Sched& S, const Epi& E, const int wave_id, const bool preb = false) {
    const int wid = wave_id, lane = mk_lane(), tid = wid * 64 + lane, wr = wid >> 2, wc = wid & 3, fr = lane & 15, fq = lane >> 4;
    const int K = g.K, nt = K / BK;
    unsigned voffA[2], voffB[2];
#pragma unroll
    for (int i = 0; i < 2; ++i) { int R, C; stage_rc(tid * 16 + i * 8192, R, C); const int Rb = Epi::PERM ? ((R & ~31) + perm32(R & 31)) : R;
        voffA[i] = (unsigned)(R * K + C) * 2u; voffB[i] = (unsigned)(Rb * K + C) * 2u; }
    const size_t kstep = (size_t)(BK * 2);
    const int k0r = g.k0; const ptrdiff_t krot = (ptrdiff_t)k0r * (ptrdiff_t)kstep;
#define PG8_KOFF(j) ((ptrdiff_t)((((j) + k0r) & (nt - 1))) * (ptrdiff_t)kstep - krot)
    const size_t hstep = (size_t)HALF * K * 2;
    const size_t tstep = 2 * hstep;
    const unsigned ldsw = (unsigned)wid * 1024u;
    const unsigned lds_u32 = (unsigned)(__UINTPTR_TYPE__)lds;
    const int aoff = lds_byte(wr * 64 + fr, fq * 8), boff = lds_byte(wc * 32 + fr, fq * 8);
#define PG8_SA(b, h) (((b) * 2 + (h)) * HTB)
#define PG8_SB(b, h) ((4 + (b) * 2 + (h)) * HTB)
#if defined(MK_PG8_SADDR)
#define PG8_STAGE(bufoff, gbase, voff) pg8_stage2_s((const void*)(gbase), (voff)[0], (voff)[1], lds_u32 + (unsigned)(bufoff) + ldsw)
#else
#define PG8_STAGE(bufoff, gbase, voff) do { _Pragma("unroll") for (int _i = 0; _i < 2; ++_i) \
        __builtin_amdgcn_global_load_lds((const unsigned*)((const char*)(gbase) + (voff)[_i]), (PG8_LAS unsigned*)(lds + (bufoff) + ldsw + _i * 8192), 16, 0, 0); } while (0)
#endif
#define PG8_LDA(dst, b, h) do { _Pragma("unroll") for (int m = 0; m < 4; ++m) _Pragma("unroll") for (int k = 0; k < 2; ++k) dst[m][k] = *(const PG8_LAS bf16x8*)(lds + PG8_SA(b, h) + aoff + m * 2048 + k * 1024); } while (0)
#define PG8_LDB(dst, b, h) do { _Pragma("unroll") for (int n = 0; n < 2; ++n) _Pragma("unroll") for (int k = 0; k < 2; ++k) dst[n][k] = *(const PG8_LAS bf16x8*)(lds + PG8_SB(b, h) + boff + n * 2048 + k * 1024); } while (0)
#if defined(MK_NOPRIO)
#define PG8_PRIO(x) do {} while (0)
#else
#define PG8_PRIO(x) __builtin_amdgcn_s_setprio(x)
#endif
#define PG8_MMA(ai, bj, At, Bt) do { PG8_PRIO(1); _Pragma("unroll") for (int m = 0; m < 4; ++m) _Pragma("unroll") for (int n = 0; n < 2; ++n) _Pragma("unroll") for (int k = 0; k < 2; ++k) \
        acc[ai][bj][m][n] = __builtin_amdgcn_mfma_f32_16x16x32_bf16(Bt[n][k], At[m][k], acc[ai][bj][m][n], 0, 0, 0); PG8_PRIO(0); } while (0)
#define PG8_MMAQ(ai, bj, At, Bt) do { _Pragma("unroll") for (int m = 0; m < 4; ++m) _Pragma("unroll") for (int n = 0; n < 2; ++n) _Pragma("unroll") for (int k = 0; k < 2; ++k) \
        acc[ai][bj][m][n] = __builtin_amdgcn_mfma_f32_16x16x32_bf16(Bt[n][k], At[m][k], acc[ai][bj][m][n], 0, 0, 0); } while (0)
#if defined(MK_PRIO2)
#define PG8_MMA2(ai) do { PG8_PRIO(1); PG8_MMAQ(ai, 0, At, B0); PG8_MMAQ(ai, 1, At, B1); PG8_PRIO(0); } while (0)
#else
#define PG8_MMA2(ai) do { PG8_MMA(ai, 0, At, B0); PG8_MMA(ai, 1, At, B1); } while (0)
#endif
#define PG8_WAIT_V(n) asm volatile("s_waitcnt vmcnt(" #n ")" ::: "memory")
#if defined(MK_VMRELAX2)
#define PG8_RELAXN "26"
#else
#define PG8_RELAXN "24"
#endif
#if defined(MK_PLAINWAIT)
#define PG8_WAIT_V8E(f) asm volatile("s_waitcnt vmcnt(8)" ::: "memory")
#elif defined(MK_NOPWAIT)
#define PG8_NOPS_1 "s_nop 7\n\t"
#define PG8_NOPS_2 PG8_NOPS_1 PG8_NOPS_1
#define PG8_NOPS_4 PG8_NOPS_2 PG8_NOPS_2
#define PG8_NOPS_8 PG8_NOPS_4 PG8_NOPS_4
#define PG8_CAT_(a, b) a##b
#define PG8_CAT(a, b) PG8_CAT_(a, b)
#define PG8_WAIT_V8E(f) asm volatile(PG8_CAT(PG8_NOPS_, MK_NOPWAIT) "s_waitcnt vmcnt(8)" ::: "memory")
#else
#define PG8_WAIT_V8E(f) do { static_assert(Epi::NSTORES == 16 || Epi::NSTORES == 17, "epilogue stores per lane"); asm volatile("s_cmp_eq_u32 %0, 0\n\ts_cbranch_scc1 1f\n\ts_waitcnt vmcnt(" PG8_RELAXN ")\n\ts_branch 2f\n1:\n\ts_waitcnt vmcnt(8)\n2:" :: "s"(f) : "scc", "memory"); } while (0)
#endif
#define PG8_WAIT_L(n) asm volatile("s_waitcnt lgkmcnt(" #n ")" ::: "memory")
#define PG8_BAR __builtin_amdgcn_s_barrier()
#define PG8_SCHED __builtin_amdgcn_sched_barrier(0)
    Unit cur, nxt; int ui = 0;
    if (!S.next(0, cur)) return;
    f32x4 acc[2][2][4][2];
#pragma unroll
    for (int a = 0; a < 2; ++a)
#pragma unroll
        for (int b = 0; b < 2; ++b)
#pragma unroll
            for (int m = 0; m < 4; ++m)
#pragma unroll
                for (int n = 0; n < 2; ++n) acc[a][b][m][n] = (f32x4){0.f, 0.f, 0.f, 0.f};
    bf16x8 At[4][2], B0[2][2], B1[2][2];
    const char* cA = (const char*)g.A + (size_t)cur.pm * tstep + krot; const char* cB = (const char*)g.Bt + (size_t)cur.pn * tstep + krot;
    S.a_ready(cur);
    if constexpr (SP2) {
#if defined(MK_PROLOG14)
        PG8_STAGE(PG8_SB(0, 0), cB, voffB); PG8_STAGE(PG8_SB(0, 1), cB + hstep, voffB); PG8_STAGE(PG8_SA(0, 0), cA, voffA); PG8_STAGE(PG8_SA(0, 1), cA + hstep, voffA);
        PG8_STAGE(PG8_SB(1, 0), cB + kstep, voffB); PG8_STAGE(PG8_SA(1, 0), cA + kstep, voffA); PG8_STAGE(PG8_SB(1, 1), cB + hstep + kstep, voffB);
        if (wr == 1) PG8_BAR;
        PG8_WAIT_V(8); PG8_BAR;
        PG8_WAIT_V(6); PG8_BAR;
#else
        if (!preb) { PG8_STAGE(PG8_SB(0, 0), cB, voffB); PG8_STAGE(PG8_SB(0, 1), cB + hstep, voffB); }
        PG8_STAGE(PG8_SA(0, 0), cA, voffA); PG8_STAGE(PG8_SA(0, 1), cA + hstep, voffA);
        if (wr == 1) PG8_BAR;
        PG8_WAIT_V(2); PG8_BAR;
        PG8_STAGE(PG8_SB(1, 0), cB + kstep, voffB); PG8_STAGE(PG8_SA(1, 0), cA + kstep, voffA); PG8_STAGE(PG8_SB(1, 1), cB + hstep + kstep, voffB);
        PG8_WAIT_V(6); PG8_BAR;
#endif
    } else {
        PG8_STAGE(PG8_SB(0, 0), cB, voffB); PG8_STAGE(PG8_SA(0, 0), cA, voffA); PG8_STAGE(PG8_SB(0, 1), cB + hstep, voffB); PG8_STAGE(PG8_SA(0, 1), cA + hstep, voffA);
        if (wr == 1) PG8_BAR;
        PG8_WAIT_V(4); PG8_BAR;
        PG8_STAGE(PG8_SB(1, 0), cB + kstep, voffB); PG8_STAGE(PG8_SA(1, 0), cA + kstep, voffA); PG8_STAGE(PG8_SB(1, 1), cB + hstep + kstep, voffB);
        PG8_WAIT_V(6); PG8_BAR;
    }
    for (;;) {
        const bool has_next = S.next(ui + 1, nxt);
        const char* nA = has_next ? (const char*)g.A + (size_t)nxt.pm * tstep + krot : E.tail_a(cur, cA); const char* nB = has_next ? (const char*)g.Bt + (size_t)nxt.pn * tstep + krot : E.tail_b(cur, cB);
        for (int t = 0; t < nt; t += 2) {
            const bool last = (t == nt - 2);
            const char* a1 = cA + PG8_KOFF(t + 1);
            const char* a2 = last ? nA : cA + PG8_KOFF(t + 2); const char* b2 = last ? nB : cB + PG8_KOFF(t + 2);
            const char* a3 = a2 + kstep; const char* b3 = b2 + kstep;
            if (last && has_next) S.a_ready(nxt);
#if defined(MK_VMRELAX) || defined(MK_VMRELAX2)
            const int fae_ = __builtin_amdgcn_readfirstlane((t == 0 && ui > 0) ? 1 : 0);
#else
            const int fae_ = 0;
#endif
            if constexpr (SP2) {
#if defined(MK_STAGEFIRST)
            PG8_STAGE(PG8_SA(1, 1), a1 + hstep, voffA); PG8_LDB(B0, 0, 0); PG8_LDB(B1, 0, 1); PG8_SCHED; PG8_LDA(At, 0, 0);
#else
            PG8_LDB(B0, 0, 0); PG8_LDB(B1, 0, 1); PG8_SCHED; PG8_LDA(At, 0, 0); PG8_STAGE(PG8_SA(1, 1), a1 + hstep, voffA);
#endif
            PG8_WAIT_V8E(fae_); PG8_WAIT_L(0); PG8_BAR; PG8_MMA2(0); PG8_BAR; PG8_SCHED;
#if defined(MK_PG8_ST6) && defined(MK_PG8_SADDR)
            PG8_LDA(At, 0, 1); pg8_stage6_s(b2, b2 + hstep, a2, voffB[0], voffB[1], voffA[0], voffA[1], lds_u32 + (unsigned)PG8_SB(0, 0) + ldsw, lds_u32 + (unsigned)PG8_SA(0, 0) + ldsw);
#else
#if defined(MK_STAGEFIRST)
            PG8_STAGE(PG8_SB(0, 0), b2, voffB); PG8_STAGE(PG8_SB(0, 1), b2 + hstep, voffB); PG8_STAGE(PG8_SA(0, 0), a2, voffA); PG8_LDA(At, 0, 1);
#else
            PG8_LDA(At, 0, 1); PG8_STAGE(PG8_SB(0, 0), b2, voffB); PG8_STAGE(PG8_SB(0, 1), b2 + hstep, voffB); PG8_STAGE(PG8_SA(0, 0), a2, voffA);
#endif
#endif
            PG8_WAIT_V8E(fae_); PG8_WAIT_L(0); PG8_BAR; PG8_MMA2(1); PG8_BAR; PG8_SCHED;
#if defined(MK_STAGEFIRST)
            PG8_STAGE(PG8_SA(0, 1), a2 + hstep, voffA); PG8_LDB(B0, 1, 0); PG8_LDB(B1, 1, 1); PG8_SCHED; PG8_LDA(At, 1, 0);
#else
            PG8_LDB(B0, 1, 0); PG8_LDB(B1, 1, 1); PG8_SCHED; PG8_LDA(At, 1, 0); PG8_STAGE(PG8_SA(0, 1), a2 + hstep, voffA);
#endif
#if defined(MK_VMRELAX2)
            PG8_WAIT_V8E(fae_); PG8_WAIT_L(0); PG8_BAR; PG8_MMA2(0); PG8_BAR; PG8_SCHED;
#else
            PG8_WAIT_V(8); PG8_WAIT_L(0); PG8_BAR; PG8_MMA2(0); PG8_BAR; PG8_SCHED;
#endif
#if defined(MK_PG8_ST6) && defined(MK_PG8_SADDR)
            PG8_LDA(At, 1, 1); pg8_stage6_s(b3, b3 + hstep, a3, voffB[0], voffB[1], voffA[0], voffA[1], lds_u32 + (unsigned)PG8_SB(1, 0) + ldsw, lds_u32 + (unsigned)PG8_SA(1, 0) + ldsw);
#else
#if defined(MK_STAGEFIRST)
            PG8_STAGE(PG8_SB(1, 0), b3, voffB); PG8_STAGE(PG8_SB(1, 1), b3 + hstep, voffB); PG8_STAGE(PG8_SA(1, 0), a3, voffA); PG8_LDA(At, 1, 1);
#else
            PG8_LDA(At, 1, 1); PG8_STAGE(PG8_SB(1, 0), b3, voffB); PG8_STAGE(PG8_SB(1, 1), b3 + hstep, voffB); PG8_STAGE(PG8_SA(1, 0), a3, voffA);
#endif
#endif
            PG8_WAIT_V(8); PG8_WAIT_L(0); PG8_BAR; PG8_MMA2(1); PG8_BAR; PG8_SCHED;
            } else {
            PG8_LDB(B0, 0, 0); PG8_SCHED; PG8_LDA(At, 0, 0); PG8_STAGE(PG8_SA(1, 1), a1 + hstep, voffA);
            PG8_WAIT_L(8); PG8_BAR; PG8_WAIT_L(0); PG8_MMA(0, 0, At, B0); PG8_BAR; PG8_SCHED;
            PG8_LDB(B1, 0, 1); PG8_STAGE(PG8_SB(0, 0), b2, voffB);
            PG8_BAR; PG8_WAIT_L(0); PG8_MMA(0, 1, At, B1); PG8_BAR;
            PG8_LDA(At, 0, 1); PG8_STAGE(PG8_SA(0, 0), a2, voffA);
            PG8_BAR; PG8_WAIT_L(0); PG8_MMA(1, 0, At, B0); PG8_BAR; PG8_SCHED;
            PG8_STAGE(PG8_SB(0, 1), b2 + hstep, voffB);
            PG8_WAIT_V(6); PG8_BAR; PG8_MMA(1, 1, At, B1); PG8_BAR;
            PG8_LDB(B0, 1, 0); PG8_SCHED; PG8_LDA(At, 1, 0); PG8_STAGE(PG8_SA(0, 1), a2 + hstep, voffA);
            PG8_WAIT_L(8); PG8_BAR; PG8_WAIT_L(0); PG8_MMA(0, 0, At, B0); PG8_BAR; PG8_SCHED;
            PG8_LDB(B1, 1, 1); PG8_STAGE(PG8_SB(1, 0), b3, voffB);
            PG8_BAR; PG8_WAIT_L(0); PG8_MMA(0, 1, At, B1); PG8_BAR;
            PG8_LDA(At, 1, 1); PG8_STAGE(PG8_SA(1, 0), a3, voffA);
            PG8_BAR; PG8_WAIT_L(0); PG8_MMA(1, 0, At, B0); PG8_BAR; PG8_SCHED;
            PG8_STAGE(PG8_SB(1, 1), b3 + hstep, voffB);
            PG8_WAIT_V(6); PG8_BAR; PG8_MMA(1, 1, At, B1); PG8_BAR;
            }
        }
        if constexpr (ALIGN_EPI) { if (wr == 0) PG8_BAR; }
#if defined(MK_VMRELAX2)
        if (has_next) PG8_STAGE(PG8_SA(1, 1), nA + kstep + hstep, voffA);
#endif
        if constexpr (!Epi::AFTER_DRAIN) { E(acc, cur, wr, wc, fr, fq);
#if defined(MK_DUPEPI1)
            if constexpr (Epi::NSTORES == 17) { asm volatile("" ::: "memory"); E(acc, cur, wr, wc, fr, fq); }
#endif
            S.done(cur); }
        if (!has_next) break;
#pragma unroll
        for (int a = 0; a < 2; ++a)
#pragma unroll
            for (int b = 0; b < 2; ++b)
#pragma unroll
                for (int m = 0; m < 4; ++m)
#pragma unroll
                    for (int n = 0; n < 2; ++n) acc[a][b][m][n] = (f32x4){0.f, 0.f, 0.f, 0.f};
        cur = nxt; cA = nA; cB = nB; ++ui;
        if constexpr (ALIGN_EPI) { if (wr == 1) PG8_BAR; }
    }
    PG8_WAIT_V(0);
    if constexpr (!ALIGN_EPI) { if (wr == 0) PG8_BAR; }
    PG8_BAR;
    if constexpr (Epi::AFTER_DRAIN) { E.fused(acc, cur, wr, wc, fr, fq, lds, wid, lane); S.done(cur); }
#undef PG8_KOFF
#undef PG8_SA
#undef PG8_SB
#undef PG8_STAGE
#undef PG8_LDA
#undef PG8_LDB
#undef PG8_MMA
#undef PG8_WAIT_V
#undef PG8_WAIT_V8E
#undef PG8_WAIT_L
#undef PG8_BAR
#undef PG8_SCHED
}

template <class Epi, class Sched>
__device__ __forceinline__ void gemm_preissue_b(PG8_LAS unsigned char* lds, const Gemm g, const Sched& S, const int wave_id) {
    const int wid = wave_id, lane = mk_lane(), tid = wid * 64 + lane;
    const int K = g.K;
    unsigned voffB[2];
#pragma unroll
    for (int i = 0; i < 2; ++i) { int R, C; stage_rc(tid * 16 + i * 8192, R, C); const int Rb = Epi::PERM ? ((R & ~31) + perm32(R & 31)) : R; voffB[i] = (unsigned)(Rb * K + C) * 2u; }
    const size_t kstep = (size_t)(BK * 2); const ptrdiff_t krot = (ptrdiff_t)g.k0 * (ptrdiff_t)kstep;
    const size_t hstep = (size_t)HALF * K * 2, tstep = 2 * hstep;
    Unit cur; if (!S.next(0, cur)) return;
    const char* cB = (const char*)g.Bt + (size_t)cur.pn * tstep + krot;
    const unsigned ldsw = (unsigned)wid * 1024u, lds_u32 = (unsigned)(__UINTPTR_TYPE__)lds;
    pg8_stage2_s((const void*)cB, voffB[0], voffB[1], lds_u32 + (unsigned)((4 + 0) * HTB) + ldsw);
    pg8_stage2_s((const void*)(cB + hstep), voffB[0], voffB[1], lds_u32 + (unsigned)((4 + 1) * HTB) + ldsw);
}

template <class Epi, class Sched>
__device__ __forceinline__ void gemm_phase2(PG8_LAS unsigned char* lds, const Gemm g, const Gemm ga, const Sched& S, const Epi& E, const int wave_id) {
    const int wid = wave_id, lane = mk_lane(), tid = wid * 64 + lane, wr = wid >> 2, wc = wid & 3, fr = lane & 15, fq = lane >> 4;
    unsigned rA[2], rB[2], c2[2];
#pragma unroll
    for (int i = 0; i < 2; ++i) { int R, C; stage_rc(tid * 16 + i * 8192, R, C); rA[i] = (unsigned)R; rB[i] = (unsigned)(Epi::PERM ? ((R & ~31) + perm32(R & 31)) : R); c2[i] = (unsigned)C * 2u; }
    const size_t kstep = (size_t)(BK * 2);
    const unsigned ldsw = (unsigned)wid * 1024u;
    const int aoff = lds_byte(wr * 64 + fr, fq * 8), boff = lds_byte(wc * 32 + fr, fq * 8);
#define PG8_SA(b, h) (((b) * 2 + (h)) * HTB)
#define PG8_SB(b, h) ((4 + (b) * 2 + (h)) * HTB)
#define PG8_STAGE2(bufoff, gbase, rr, pitch) do { _Pragma("unroll") for (int _i = 0; _i < 2; ++_i) \
        __builtin_amdgcn_global_load_lds((const unsigned*)((const char*)(gbase) + ((rr)[_i] * (pitch) + c2[_i])), (PG8_LAS unsigned*)(lds + (bufoff) + ldsw + _i * 8192), 16, 0, 0); } while (0)
#define PG8_LDA(dst, b, h) do { _Pragma("unroll") for (int m = 0; m < 4; ++m) _Pragma("unroll") for (int k = 0; k < 2; ++k) dst[m][k] = *(const PG8_LAS bf16x8*)(lds + PG8_SA(b, h) + aoff + m * 2048 + k * 1024); } while (0)
#define PG8_LDB(dst, b, h) do { _Pragma("unroll") for (int n = 0; n < 2; ++n) _Pragma("unroll") for (int k = 0; k < 2; ++k) dst[n][k] = *(const PG8_LAS bf16x8*)(lds + PG8_SB(b, h) + boff + n * 2048 + k * 1024); } while (0)
#define PG8_MMA(ai, bj, At, Bt) do { __builtin_amdgcn_s_setprio(1); _Pragma("unroll") for (int m = 0; m < 4; ++m) _Pragma("unroll") for (int n = 0; n < 2; ++n) _Pragma("unroll") for (int k = 0; k < 2; ++k) \
        acc[ai][bj][m][n] = __builtin_amdgcn_mfma_f32_16x16x32_bf16(Bt[n][k], At[m][k], acc[ai][bj][m][n], 0, 0, 0); __builtin_amdgcn_s_setprio(0); } while (0)
#define PG8_WAIT_V(n) asm volatile("s_waitcnt vmcnt(" #n ")" ::: "memory")
#define PG8_WAIT_L(n) asm volatile("s_waitcnt lgkmcnt(" #n ")" ::: "memory")
#define PG8_BAR __builtin_amdgcn_s_barrier()
#define PG8_SCHED __builtin_amdgcn_sched_barrier(0)
#define PG8_UA(u) ((const char*)((u).alt ? ga.A : g.A) + (size_t)(u).pm * ((size_t)BM * (size_t)((u).alt ? ga.K : g.K) * 2))
#define PG8_UB(u) ((const char*)((u).alt ? ga.Bt : g.Bt) + (size_t)(u).pn * ((size_t)BM * (size_t)((u).alt ? ga.K : g.K) * 2))
    Unit cur, nxt; int ui = 0;
    if (!S.next(0, cur)) return;
    f32x4 acc[2][2][4][2];
#pragma unroll
    for (int a = 0; a < 2; ++a)
#pragma unroll
        for (int b = 0; b < 2; ++b)
#pragma unroll
            for (int m = 0; m < 4; ++m)
#pragma unroll
                for (int n = 0; n < 2; ++n) acc[a][b][m][n] = (f32x4){0.f, 0.f, 0.f, 0.f};
    bf16x8 At[4][2], B0[2][2], B1[2][2];
    const char* cA = PG8_UA(cur); const char* cB = PG8_UB(cur);
    unsigned cp = (unsigned)(cur.alt ? ga.K : g.K) * 2u;
    int cnt = (cur.alt ? ga.K : g.K) / BK;
    { const size_t hs = (size_t)HALF * cp;
      PG8_STAGE2(PG8_SB(0, 0), cB, rB, cp); PG8_STAGE2(PG8_SB(0, 1), cB + hs, rB, cp); PG8_STAGE2(PG8_SA(0, 0), cA, rA, cp); PG8_STAGE2(PG8_SA(0, 1), cA + hs, rA, cp);
      if (wr == 1) PG8_BAR;
      PG8_WAIT_V(2); PG8_BAR;
      PG8_STAGE2(PG8_SB(1, 0), cB + kstep, rB, cp); PG8_STAGE2(PG8_SA(1, 0), cA + kstep, rA, cp); PG8_STAGE2(PG8_SB(1, 1), cB + hs + kstep, rB, cp);
      PG8_WAIT_V(6); PG8_BAR; }
    for (;;) {
        const bool has_next = S.next(ui + 1, nxt);
        const char* nA = has_next ? PG8_UA(nxt) : cA; const char* nB = has_next ? PG8_UB(nxt) : cB;
        const unsigned np = has_next ? (unsigned)(nxt.alt ? ga.K : g.K) * 2u : cp;
        const int nnt = has_next ? (nxt.alt ? ga.K : g.K) / BK : cnt;
        const size_t chs = (size_t)HALF * cp;
        for (int t = 0; t < cnt; t += 2) {
            const bool last = (t == cnt - 2);
            const char* a1 = cA + (size_t)(t + 1) * kstep;
            const char* a2 = last ? nA : cA + (size_t)(t + 2) * kstep; const char* b2 = last ? nB : cB + (size_t)(t + 2) * kstep;
            const char* a3 = a2 + kstep; const char* b3 = b2 + kstep;
            const unsigned p2 = last ? np : cp; const size_t hs2 = (size_t)HALF * p2;
            PG8_LDB(B0, 0, 0); PG8_LDB(B1, 0, 1); PG8_SCHED; PG8_LDA(At, 0, 0); PG8_STAGE2(PG8_SA(1, 1), a1 + chs, rA, cp);
            PG8_WAIT_V(8); PG8_WAIT_L(0); PG8_BAR; PG8_MMA2(0); PG8_BAR; PG8_SCHED;
            PG8_LDA(At, 0, 1); PG8_STAGE2(PG8_SB(0, 0), b2, rB, p2); PG8_STAGE2(PG8_SB(0, 1), b2 + hs2, rB, p2); PG8_STAGE2(PG8_SA(0, 0), a2, rA, p2);
            PG8_WAIT_V(8); PG8_WAIT_L(0); PG8_BAR; PG8_MMA2(1); PG8_BAR; PG8_SCHED;
            PG8_LDB(B0, 1, 0); PG8_LDB(B1, 1, 1); PG8_SCHED; PG8_LDA(At, 1, 0); PG8_STAGE2(PG8_SA(0, 1), a2 + hs2, rA, p2);
            PG8_WAIT_V(8); PG8_WAIT_L(0); PG8_BAR; PG8_MMA2(0); PG8_BAR; PG8_SCHED;
            PG8_LDA(At, 1, 1); PG8_STAGE2(PG8_SB(1, 0), b3, rB, p2); PG8_STAGE2(PG8_SB(1, 1), b3 + hs2, rB, p2); PG8_STAGE2(PG8_SA(1, 0), a3, rA, p2);
            PG8_WAIT_V(8); PG8_WAIT_L(0); PG8_BAR; PG8_MMA2(1); PG8_BAR; PG8_SCHED;
        }
        if (wr == 0) PG8_BAR;
        E(acc, cur, wr, wc, fr, fq);
        if (!has_next) break;
#pragma unroll
        for (int a = 0; a < 2; ++a)
#pragma unroll
            for (int b = 0; b < 2; ++b)
#pragma unroll
                for (int m = 0; m < 4; ++m)
#pragma unroll
                    for (int n = 0; n < 2; ++n) acc[a][b][m][n] = (f32x4){0.f, 0.f, 0.f, 0.f};
        cur = nxt; cA = nA; cB = nB; cp = np; cnt = nnt; ++ui;
        if (wr == 1) PG8_BAR;
    }
    PG8_WAIT_V(0);
    PG8_BAR;
#undef PG8_UA
#undef PG8_UB
#undef PG8_SA
#undef PG8_SB
#undef PG8_STAGE2
#undef PG8_LDA
#undef PG8_LDB
#undef PG8_MMA
#undef PG8_WAIT_V
#undef PG8_WAIT_L
#undef PG8_BAR
#undef PG8_SCHED
}
}
#ifndef DA_MFMA_SUM
#define DA_MFMA_SUM 1
#endif
namespace da {
#if defined(MK_SILU_LATE)
__device__ __forceinline__ float gatev(float z) { return z * __builtin_amdgcn_rcpf(1.0f + __builtin_amdgcn_exp2f(-1.4426950408889634f * z)); }
#else
__device__ __forceinline__ float gatev(float z) { return z; }
#endif
#if defined(DA_SETPRIO)
#define DA_PRIO(x) __builtin_amdgcn_s_setprio(x)
#else
#define DA_PRIO(x) do {} while (0)
#endif
using bf16x8 = __attribute__((ext_vector_type(8))) short;
using s16x4  = __attribute__((ext_vector_type(4))) short;
using f32x16 = __attribute__((ext_vector_type(16))) float;
using f32x4  = __attribute__((ext_vector_type(4))) float;
using u32x4  = __attribute__((ext_vector_type(4))) unsigned;
typedef unsigned short bf16_t;
constexpr int SEQ = 2048, QROWS = 128, KVBLK = 64, NT = SEQ / KVBLK;
constexpr int SHM_V = 16384, SHM_K = 16384;
#if defined(MK_DA_STAG)
static_assert(DA_MFMA_SUM == 1, "stagger map has no per-wave scratch");
constexpr int NSLOT = 4, LDS_K = 0, LDS_V = 5 * SHM_K, LDS_OST = 0, OSTRIDE = 132, LDS_TBL = 147456, LDS_WS = LDS_TBL, LDS_END = LDS_TBL + 2048;
#else
#if defined(MK_DA_PAIR)
constexpr int NSLOT = 4,
#else
constexpr int NSLOT = 3,
#endif
#if defined(MK_DA_WS_HI)
    LDS_K = 0, LDS_V = NSLOT * SHM_K, LDS_OST = 0, OSTRIDE = 132, LDS_TBL = 2 * NSLOT * SHM_K, LDS_WS = 147456  , LDS_END = LDS_WS + 8 * 128;
#else
    LDS_K = 0, LDS_V = NSLOT * SHM_K, LDS_OST = 0, OSTRIDE = 132, LDS_TBL = 2 * NSLOT * SHM_K, LDS_WS = LDS_TBL + 2048, LDS_END = LDS_WS + 8 * 128;
#endif
#endif
constexpr int DA_DUMMY_ = 0;
constexpr float LOG2E = 1.4426950408889634f;
#define DA_KSWZ(row, colB) ((row) * 256 + ((colB) ^ (((row) & 15) << 4)))
#if defined(DA_NOSBAR)
#define DA_SBAR() do {} while (0)
#else
#define DA_SBAR() __builtin_amdgcn_sched_barrier(0)
#endif
__device__ __forceinline__ int crow(int r, int hi) { return (r & 3) + 8 * (r >> 2) + 4 * hi; }
__device__ __forceinline__ unsigned cvtpk(float lo, float hi) { unsigned r; asm volatile("v_cvt_pk_bf16_f32 %0, %1, %2" : "=v"(r) : "v"(lo), "v"(hi)); return r; }
__device__ __forceinline__ float bf2f(unsigned short v) { return __uint_as_float(((unsigned)v) << 16); }
__device__ __forceinline__ int t5_bucket(int rel) {
    const int ret = rel > 0 ? 16 : 0; const int n = rel < 0 ? -rel : rel;
    int v;
    if (n < 8) v = n; else { const int l2 = 31 - __builtin_clz((unsigned)(n * n)); v = 8 + (l2 - 6); v = v < 15 ? v : 15; }
    return ret + v;
}
__device__ __forceinline__ void qkt(f32x16& p0, f32x16& p1, const char* Ks, const bf16x8* qr, int r32, int hi, int mapB) {
    p0 = f32x16{}; p1 = f32x16{};
#pragma unroll
    for (int d0 = 0; d0 < 4; ++d0) { const int cb = mapB + (d0 * 16 + hi * 8) * 2;
        const bf16x8 b0 = *reinterpret_cast<const bf16x8*>(Ks + DA_KSWZ(r32, cb));
        const bf16x8 b1 = *reinterpret_cast<const bf16x8*>(Ks + DA_KSWZ(32 + r32, cb));
        p0 = __builtin_amdgcn_mfma_f32_32x32x16_bf16(b0, qr[d0], p0, 0, 0, 0);
        p1 = __builtin_amdgcn_mfma_f32_32x32x16_bf16(b1, qr[d0], p1, 0, 0, 0); }
}
__device__ __forceinline__ void addbias(f32x16& p0, f32x16& p1, const float* tbl, int tb) {
#pragma unroll
    for (int r = 0; r < 16; ++r) { p0[r] += tbl[tb + (r & 3) + 8 * (r >> 2)]; p1[r] += tbl[tb + 32 + (r & 3) + 8 * (r >> 2)]; }
}
__device__ __forceinline__ void exp_half(f32x16& p) {
#pragma unroll
    for (int r = 0; r < 16; ++r) p[r] = __builtin_amdgcn_exp2f(p[r]);
}
__device__ __forceinline__ void finishSM(f32x16& p0, f32x16& p1, float& l_reg, bf16x8& pa0, bf16x8& pa1, bf16x8& pa2, bf16x8& pa3) {
    exp_half(p1);
#if !DA_MFMA_SUM
    { float ps = 0.f;
      _Pragma("unroll") for (int r = 0; r < 16; ++r) ps += p0[r];
      _Pragma("unroll") for (int r = 0; r < 16; ++r) ps += p1[r];
      l_reg += ps; }
#endif
#define DA_PK8(P, BASE, OUT) do { u32x4 w = {cvtpk(P[BASE + 0], P[BASE + 1]), cvtpk(P[BASE + 2], P[BASE + 3]), cvtpk(P[BASE + 4], P[BASE + 5]), cvtpk(P[BASE + 6], P[BASE + 7])}; OUT = *reinterpret_cast<bf16x8*>(&w); } while (0)
    DA_PK8(p0, 0, pa0); DA_PK8(p0, 8, pa1); DA_PK8(p1, 0, pa2); DA_PK8(p1, 8, pa3);
#undef DA_PK8
}
__device__ __forceinline__ int v_st(int k, int c) { const int kk = k; return ((kk >> 3) * 4 + (c >> 5)) * 512 + ((kk & 7) * 32 + (c & 31)) * 2; }
__device__ __forceinline__ int v_rd_base(int lane) { return ((lane & 3) << 3) | (((lane >> 2) & 3) << 6) | (((lane >> 4) & 1) << 5) | (((lane >> 5) & 1) << 8); }
constexpr int v_rd_off(int d0, int ks, int half) { return d0 * 512 + ks * 4096 + half * 2048; }
template <int OFF> __device__ __forceinline__ s16x4 tr_read(int vb) {
    s16x4 r; asm volatile("ds_read_b64_tr_b16 %0, %1 offset:%2" : "=&v"(r) : "v"(vb), "i"(OFF) : "memory"); return r;
}
#define DA_TRD(D0, L0, H0, L1, H1, L2, H2, L3, H3) do { L0 = tr_read<v_rd_off(D0, 0, 0)>(vb); H0 = tr_read<v_rd_off(D0, 0, 1)>(vb); L1 = tr_read<v_rd_off(D0, 1, 0)>(vb); H1 = tr_read<v_rd_off(D0, 1, 1)>(vb); \
    L2 = tr_read<v_rd_off(D0, 2, 0)>(vb); H2 = tr_read<v_rd_off(D0, 2, 1)>(vb); L3 = tr_read<v_rd_off(D0, 3, 0)>(vb); H3 = tr_read<v_rd_off(D0, 3, 1)>(vb); } while (0)
#define DA_PK(L, H) (bf16x8){L[0], L[1], L[2], L[3], H[0], H[1], H[2], H[3]}
#define DA_MM4(OD, L0, H0, L1, H1, L2, H2, L3, H3) do { DA_PRIO(1); OD = __builtin_amdgcn_mfma_f32_32x32x16_bf16(pa0, DA_PK(L0, H0), OD, 0, 0, 0); OD = __builtin_amdgcn_mfma_f32_32x32x16_bf16(pa1, DA_PK(L1, H1), OD, 0, 0, 0); \
    OD = __builtin_amdgcn_mfma_f32_32x32x16_bf16(pa2, DA_PK(L2, H2), OD, 0, 0, 0); OD = __builtin_amdgcn_mfma_f32_32x32x16_bf16(pa3, DA_PK(L3, H3), OD, 0, 0, 0); DA_PRIO(0); } while (0)
#define DA_EX4(B) do { e[B] = __builtin_amdgcn_exp2f(e[B]); e[B + 1] = __builtin_amdgcn_exp2f(e[B + 1]); e[B + 2] = __builtin_amdgcn_exp2f(e[B + 2]); e[B + 3] = __builtin_amdgcn_exp2f(e[B + 3]); } while (0)
template <class H1, class H2>
__device__ __forceinline__ void pv_d0(f32x16* o, int vb, bf16x8 pa0, bf16x8 pa1, bf16x8 pa2, bf16x8 pa3, bf16x8 ones, f32x16& e, const H1& h1, const H2& h2) {
    s16x4 a0, a1, a2, a3, a4, a5, a6, a7, b0, b1, b2, b3, b4, b5, b6, b7;
    DA_TRD(0, a0, a1, a2, a3, a4, a5, a6, a7);
    DA_TRD(1, b0, b1, b2, b3, b4, b5, b6, b7);
#if DA_MFMA_SUM
    o[4] = __builtin_amdgcn_mfma_f32_32x32x16_bf16(pa0, ones, o[4], 0, 0, 0); o[4] = __builtin_amdgcn_mfma_f32_32x32x16_bf16(pa1, ones, o[4], 0, 0, 0);
#endif
    asm volatile("s_waitcnt lgkmcnt(8)" ::: "memory"); DA_SBAR();
    DA_MM4(o[0], a0, a1, a2, a3, a4, a5, a6, a7); DA_EX4(0);
    DA_SBAR(); h1(); DA_TRD(2, a0, a1, a2, a3, a4, a5, a6, a7);
    asm volatile("s_waitcnt lgkmcnt(8)" ::: "memory"); DA_SBAR();
    DA_MM4(o[1], b0, b1, b2, b3, b4, b5, b6, b7); DA_EX4(4);
    DA_SBAR(); h2(); DA_TRD(3, b0, b1, b2, b3, b4, b5, b6, b7);
#if DA_MFMA_SUM
    o[4] = __builtin_amdgcn_mfma_f32_32x32x16_bf16(pa2, ones, o[4], 0, 0, 0); o[4] = __builtin_amdgcn_mfma_f32_32x32x16_bf16(pa3, ones, o[4], 0, 0, 0);
#endif
    asm volatile("s_waitcnt lgkmcnt(8)" ::: "memory"); DA_SBAR();
    DA_MM4(o[2], a0, a1, a2, a3, a4, a5, a6, a7); DA_EX4(8);
    asm volatile("s_waitcnt lgkmcnt(0)" ::: "memory"); DA_SBAR();
    DA_MM4(o[3], b0, b1, b2, b3, b4, b5, b6, b7); DA_EX4(12);
}
#undef DA_EX4
#undef DA_TRD
#undef DA_MM4
#undef DA_PK

__device__ __forceinline__ void glds16(const void* gsrc, unsigned lds_dst) { unsigned keep;
    asm volatile("s_mov_b32 %0, m0\n\ts_mov_b32 m0, %2\n\ts_nop 0\n\tglobal_load_lds_dwordx4 %1, off\n\ts_mov_b32 m0, %0" : "=&s"(keep) : "v"(gsrc), "s"(lds_dst) : "memory"); }

__device__ __forceinline__ void glds16x2(const void* g0, const void* g1, unsigned lds_dst) { unsigned keep;
    asm volatile("s_mov_b32 %0, m0\n\ts_mov_b32 m0, %3\n\ts_nop 0\n\tglobal_load_lds_dwordx4 %1, off\n\ts_addk_i32 m0, 0x400\n\ts_nop 0\n\tglobal_load_lds_dwordx4 %2, off\n\ts_mov_b32 m0, %0" : "=&s"(keep) : "v"(g0), "v"(g1), "s"(lds_dst) : "memory", "scc"); }

__device__ __forceinline__ void glds16x2_s(const void* sbase, unsigned off0, unsigned off1, unsigned lds_dst) { unsigned keep;
    asm volatile("s_mov_b32 %0, m0\n\ts_mov_b32 m0, %4\n\ts_nop 0\n\tglobal_load_lds_dwordx4 %1, %3\n\ts_addk_i32 m0, 0x400\n\ts_nop 0\n\tglobal_load_lds_dwordx4 %2, %3\n\ts_mov_b32 m0, %0" : "=&s"(keep) : "v"(off0), "v"(off1), "s"(sbase), "s"(lds_dst) : "memory", "scc"); }

struct Params {
    const bf16_t* QA; const bf16_t* KA; const bf16_t* VA; const bf16_t* ZA;
    const float* sc;
    const float* tblg;
    const float* subg;
    bf16_t* CAT;
};

__device__ __forceinline__ float wave_sum(float v) {
#pragma unroll
    for (int o = 1; o < 64; o <<= 1) v += __shfl_xor(v, o);
    return v;
}
__device__ __forceinline__ float wave_max(float v) {
#pragma unroll
    for (int o = 1; o < 64; o <<= 1) v = fmaxf(v, __shfl_xor(v, o));
    return v;
}

__device__ __forceinline__ void unit(const Params& P, int b, int h, int qb, char* lds, const int wave_id) {
    int tid_ = wave_id * 64 + mk_lane(); asm volatile("" : "+v"(tid_));
    const int tid = tid_, lane = tid & 63, r32 = lane & 31, hi = lane >> 5;
    const int wid = wave_id, map = wid >> 2, wq = wid & 3;
    char* V_lds = lds + LDS_V; char* K_lds = lds + LDS_K;
    float* tbl = (float*)(lds + LDS_TBL);
    const int Q0 = qb * QROWS;
    const size_t tok0 = (size_t)b * SEQ;
    const float lam = P.sc[0], cL = P.sc[8 + h], cR = P.sc[12 + h];
#if defined(MK_LATETBL) && (defined(MK_DA_PRE2) || defined(MK_DA_QF2))
    float tblv_; asm volatile("global_load_dword %0, %1, off" : "=v"(tblv_) : "v"(P.tblg + h * 512 + tid) : "memory");
#elif defined(MK_LATETBL)
    const float tblv_ = P.tblg[h * 512 + tid];
#else
    tbl[tid] = P.tblg[h * 512 + tid];
#endif
    const int mapB = map * 128;
    const char* Kh = (const char*)(P.KA + tok0 * 512 + h * 128); const char* Vh = (const char*)(P.VA + tok0 * 512 + h * 128);
    unsigned koff[2], voff[2];
#pragma unroll
    for (int i = 0; i < 2; ++i) { const int B_ = (2 * wid + i) * 1024 + lane * 16;
        const int row = B_ >> 8, cB = B_ & 255; koff[i] = (unsigned)(row * 1024 + (cB ^ ((row & 15) << 4)));
        const int st = B_ >> 9, rem = B_ & 511, k = (st >> 2) * 8 + (rem >> 6), c = (st & 3) * 32 + ((rem & 63) >> 1);
        voff[i] = (unsigned)(k * 1024 + c * 2); }
    const unsigned lds0 = (unsigned)(uintptr_t)lds;
    const unsigned kdst = lds0 + LDS_K + wid * 2048, vdst = lds0 + LDS_V + wid * 2048;
#if defined(MK_DA_SADDR)
#define DA_DMA_K(t, slot) do { const char* kt_ = Kh + (size_t)(t) * 65536; glds16x2_s(kt_, koff[0], koff[1], (unsigned)__builtin_amdgcn_readfirstlane(kdst + (slot))); } while (0)
#define DA_DMA_V(t, slot) do { const char* vt_ = Vh + (size_t)(t) * 65536; glds16x2_s(vt_, voff[0], voff[1], (unsigned)__builtin_amdgcn_readfirstlane(vdst + (slot))); } while (0)
#else
#define DA_DMA_K(t, slot) do { const char* kt_ = Kh + (size_t)(t) * 65536; glds16(kt_ + koff[0], (unsigned)__builtin_amdgcn_readfirstlane(kdst + (slot))); glds16(kt_ + koff[1], (unsigned)__builtin_amdgcn_readfirstlane(kdst + (slot) + 1024)); } while (0)
#define DA_DMA_V(t, slot) do { const char* vt_ = Vh + (size_t)(t) * 65536; glds16x2(vt_ + voff[0], vt_ + voff[1], (unsigned)__builtin_amdgcn_readfirstlane(vdst + (slot))); } while (0)
#endif
#if defined(DA_STAMP)
#define DA_WAITBAR(N) do { const unsigned long long tw0_ = __builtin_amdgcn_s_memtime(); asm volatile("s_waitcnt vmcnt(" #N ") lgkmcnt(0)\n\ts_barrier" ::: "memory"); wacc_ += __builtin_amdgcn_s_memtime() - tw0_; } while (0)
#else
#define DA_WAITBAR(N) asm volatile("s_waitcnt vmcnt(" #N ") lgkmcnt(0)\n\ts_barrier" ::: "memory")
#endif
#if defined(DA_STAMP)
    unsigned long long wacc_ = 0; const unsigned long long tu0_ = __builtin_amdgcn_s_memtime();
#endif
#if defined(MK_DA_QFIRST)
    bf16x8 qr[4];
    { const bf16_t* Qw = P.QA + (tok0 + Q0 + wq * 32 + r32) * 512 + h * 128 + map * 64 + hi * 8;
#pragma unroll
      for (int d0 = 0; d0 < 4; ++d0) qr[d0] = *reinterpret_cast<const bf16x8*>(Qw + d0 * 16); }
    asm volatile("" ::: "memory");
    DA_DMA_K(0, 0); DA_DMA_V(0, 0); DA_DMA_K(1, SHM_K);
#else
#if !defined(MK_DA_QF2)
    DA_DMA_K(0, 0); DA_DMA_V(0, 0); DA_DMA_K(1, SHM_K);
#endif
    bf16x8 qr[4];
    { const bf16_t* Qw = P.QA + (tok0 + Q0 + wq * 32 + r32) * 512 + h * 128 + map * 64 + hi * 8;
#if defined(MK_DA_PRE2) || defined(MK_DA_QF2)
      asm volatile("global_load_dwordx4 %0, %1, off" : "=v"(qr[0]) : "v"(Qw) : "memory");
      asm volatile("global_load_dwordx4 %0, %1, off offset:32" : "=v"(qr[1]) : "v"(Qw) : "memory");
      asm volatile("global_load_dwordx4 %0, %1, off offset:64" : "=v"(qr[2]) : "v"(Qw) : "memory");
      asm volatile("global_load_dwordx4 %0, %1, off offset:96" : "=v"(qr[3]) : "v"(Qw) : "memory");
#else
#pragma unroll
      for (int d0 = 0; d0 < 4; ++d0) qr[d0] = *reinterpret_cast<const bf16x8*>(Qw + d0 * 16);
#endif
    }
#if defined(MK_DA_QF2)
    DA_DMA_K(0, 0); DA_DMA_V(0, 0); DA_DMA_K(1, SHM_K);
#endif
#endif
    const int vb0 = (int)(uintptr_t)V_lds + v_rd_base(lane);
    const int tbase = -Q0 - 32 * wq - r32 + 4 * hi + 255;
#define DA_CVAL(t) ((64 * (t) - Q0 <= -192) ? cL : ((64 * (t) - Q0 >= 256) ? cR : 0.0f))
#define DA_RESC(t) do { const float cn_ = DA_CVAL(t); if (cn_ != ccur) { const float f_ = __builtin_amdgcn_exp2f(ccur - cn_); ccur = cn_; \
        l_reg *= f_; _Pragma("unroll") for (int d_ = 0; d_ < 4 + DA_MFMA_SUM; ++d_) _Pragma("unroll") for (int r_ = 0; r_ < 16; ++r_) o[d_][r_] *= f_; } } while (0)
#define DA_NEAR(t) (64 * (t) - Q0 > -192 && 64 * (t) - Q0 < 256)
#define DA_PART(P0, P1, t) do { if (DA_NEAR(t)) addbias(P0, P1, tbl, tbase + 64 * (t)); exp_half(P0); } while (0)
#define DA_BIAS(P0, P1, t) do { if (DA_NEAR(t)) addbias(P0, P1, tbl, tbase + 64 * (t)); } while (0)
#define DA_ROT() do { const unsigned r_ = s0; s0 = s1; s1 = s2; s2 = r_; } while (0)
    f32x16 o[5]; float ccur = DA_CVAL(0), l_reg = 0.f;
    const bf16x8 ones = (bf16x8){0x3F80, 0x3F80, 0x3F80, 0x3F80, 0x3F80, 0x3F80, 0x3F80, 0x3F80};
#pragma unroll
    for (int d = 0; d < 5; ++d)
#pragma unroll
        for (int r = 0; r < 16; ++r) o[d][r] = 0.f;
#if defined(MK_DA_STATPRIO)
    if (wid >= 4) __builtin_amdgcn_s_setprio(MK_DA_STATPRIO);
#endif
    f32x16 pA0, pA1, pB0, pB1; bf16x8 pa0, pa1, pa2, pa3;
    unsigned s0 = 2 * SHM_K, s1 = 0, s2 = SHM_K;
#if defined(MK_LATETBL) && defined(MK_DA_PRE2)
    DA_DMA_K(2, 2 * SHM_K); DA_DMA_V(1, SHM_K);
    asm volatile("s_waitcnt vmcnt(4)" : "+v"(tblv_), "+v"(qr[0]), "+v"(qr[1]), "+v"(qr[2]), "+v"(qr[3]) :: "memory");
    tbl[tid] = tblv_;
#elif defined(MK_LATETBL) && defined(MK_DA_QF2)
    asm volatile("s_waitcnt vmcnt(4)" : "+v"(tblv_), "+v"(qr[0]), "+v"(qr[1]), "+v"(qr[2]), "+v"(qr[3]) :: "memory");
    tbl[tid] = tblv_;
#elif defined(MK_LATETBL)
    tbl[tid] = tblv_;
#endif
#if defined(MK_DA_QFIRST)
    asm volatile("s_waitcnt vmcnt(4)" ::: "memory");
#else
#if !defined(MK_DA_PRE2) && !defined(MK_DA_QF2)
    asm volatile("s_waitcnt vmcnt(0)" ::: "memory");
#endif
#endif
#if defined(MK_DA_QFIRST) || defined(MK_DA_PRE2) || defined(MK_DA_QF2)
    DA_WAITBAR(4);
#else
    DA_WAITBAR(0);
#endif
#if defined(MK_DA_STAG)
#define KSL(t_) ((unsigned)(((unsigned)(t_) % 5u) * SHM_K))
#define VSL(t_) ((unsigned)(((t_) & 3) * SHM_V))
    DA_DMA_K(2, KSL(2)); DA_DMA_K(3, KSL(3)); DA_DMA_V(1, VSL(1));
    qkt(pA0, pA1, K_lds + KSL(0), qr, r32, hi, mapB); DA_PART(pA0, pA1, 0);
    for (int t = 1; t + 1 < NT; t += 2) {
        if (wid < 4) DA_WAITBAR(0);
#if MK_DA_STAG == 2
        DA_SBAR(); qkt(pB0, pB1, K_lds + KSL(t), qr, r32, hi, mapB);
        finishSM(pA0, pA1, l_reg, pa0, pa1, pa2, pa3); DA_SBAR();
        if (wid >= 4) DA_WAITBAR(0);
#else
        DA_SBAR(); qkt(pB0, pB1, K_lds + KSL(t), qr, r32, hi, mapB); DA_SBAR();
        if (wid >= 4) DA_WAITBAR(0);
        finishSM(pA0, pA1, l_reg, pa0, pa1, pa2, pa3); DA_SBAR();
#endif
        DA_BIAS(pB0, pB1, t); DA_RESC(t - 1);
        pv_d0(o, vb0 + (int)VSL(t - 1), pa0, pa1, pa2, pa3, ones, pB0,
              [&]() { if (t + 3 < NT) DA_DMA_K(t + 3, KSL(t + 3)); if (t + 4 < NT) DA_DMA_K(t + 4, KSL(t + 4)); },
              [&]() { DA_DMA_V(t + 1, VSL(t + 1)); if (t + 2 < NT) DA_DMA_V(t + 2, VSL(t + 2)); });
        DA_SBAR(); qkt(pA0, pA1, K_lds + KSL(t + 1), qr, r32, hi, mapB);
        finishSM(pB0, pB1, l_reg, pa0, pa1, pa2, pa3); DA_SBAR();
        DA_BIAS(pA0, pA1, t + 1); DA_RESC(t);
        pv_d0(o, vb0 + (int)VSL(t), pa0, pa1, pa2, pa3, ones, pA0, []() {}, []() {});
    }
    if (wid < 4) DA_WAITBAR(0);
#if MK_DA_STAG == 2
    DA_SBAR(); qkt(pB0, pB1, K_lds + KSL(NT - 1), qr, r32, hi, mapB);
    finishSM(pA0, pA1, l_reg, pa0, pa1, pa2, pa3); DA_SBAR();
    if (wid >= 4) DA_WAITBAR(0);
#else
    DA_SBAR(); qkt(pB0, pB1, K_lds + KSL(NT - 1), qr, r32, hi, mapB); DA_SBAR();
    if (wid >= 4) DA_WAITBAR(0);
    finishSM(pA0, pA1, l_reg, pa0, pa1, pa2, pa3); DA_SBAR();
#endif
    DA_BIAS(pB0, pB1, NT - 1); DA_RESC(NT - 2); pv_d0(o, vb0 + (int)VSL(NT - 2), pa0, pa1, pa2, pa3, ones, pB0, []() {}, []() {});
    finishSM(pB0, pB1, l_reg, pa0, pa1, pa2, pa3); DA_SBAR();
    { f32x16 dmy = f32x16{}; DA_RESC(NT - 1); pv_d0(o, vb0 + (int)VSL(NT - 1), pa0, pa1, pa2, pa3, ones, dmy, []() {}, []() {}); }
#undef KSL
#undef VSL
#elif defined(MK_DA_PAIR)
#define KSL(t_) ((unsigned)(((t_) & 3) * SHM_K))
#if !defined(MK_DA_PRE2)
    DA_DMA_K(2, KSL(2)); DA_DMA_V(1, KSL(1));
#endif
    qkt(pA0, pA1, K_lds + KSL(0), qr, r32, hi, mapB); DA_PART(pA0, pA1, 0);
    for (int t = 1; t + 1 < NT; t += 2) {
        DA_WAITBAR(0);
        DA_SBAR(); qkt(pB0, pB1, K_lds + KSL(t), qr, r32, hi, mapB);
        finishSM(pA0, pA1, l_reg, pa0, pa1, pa2, pa3); DA_SBAR();
        DA_BIAS(pB0, pB1, t); DA_RESC(t - 1);
        pv_d0(o, vb0 + (int)KSL(t - 1), pa0, pa1, pa2, pa3, ones, pB0,
              [&]() { if (t + 2 < NT) DA_DMA_K(t + 2, KSL(t + 2)); if (t + 3 < NT) DA_DMA_K(t + 3, KSL(t + 3)); },
              [&]() { DA_DMA_V(t + 1, KSL(t + 1)); if (t + 2 < NT) DA_DMA_V(t + 2, KSL(t + 2)); });
        DA_SBAR(); qkt(pA0, pA1, K_lds + KSL(t + 1), qr, r32, hi, mapB);
        finishSM(pB0, pB1, l_reg, pa0, pa1, pa2, pa3); DA_SBAR();
        DA_BIAS(pA0, pA1, t + 1); DA_RESC(t);
        pv_d0(o, vb0 + (int)KSL(t), pa0, pa1, pa2, pa3, ones, pA0, []() {}, []() {});
    }
    DA_WAITBAR(0);
    DA_SBAR(); qkt(pB0, pB1, K_lds + KSL(NT - 1), qr, r32, hi, mapB);
    finishSM(pA0, pA1, l_reg, pa0, pa1, pa2, pa3); DA_SBAR();
    DA_BIAS(pB0, pB1, NT - 1); DA_RESC(NT - 2); pv_d0(o, vb0 + (int)KSL(NT - 2), pa0, pa1, pa2, pa3, ones, pB0, []() {}, []() {});
    finishSM(pB0, pB1, l_reg, pa0, pa1, pa2, pa3); DA_SBAR();
    { f32x16 dmy = f32x16{}; DA_RESC(NT - 1); pv_d0(o, vb0 + (int)KSL(NT - 1), pa0, pa1, pa2, pa3, ones, dmy, []() {}, []() {}); }
#undef KSL
#else
    DA_DMA_K(2, s0); DA_DMA_V(1, s2);
    qkt(pA0, pA1, K_lds + s1, qr, r32, hi, mapB); DA_PART(pA0, pA1, 0);
    DA_ROT();
    for (int t = 1; t + 1 < NT; t += 2) {
        DA_WAITBAR(4);
#if defined(DA_DUPQK)
        qkt(pB0, pB1, K_lds + s1, qr, r32, hi, mapB); asm volatile("" : "+v"(pB0), "+v"(pB1));
#endif
#if defined(DA_XBAR)
        asm volatile("s_waitcnt lgkmcnt(0)\n\ts_barrier" ::: "memory");
#endif
        DA_SBAR(); qkt(pB0, pB1, K_lds + s1, qr, r32, hi, mapB);
        finishSM(pA0, pA1, l_reg, pa0, pa1, pa2, pa3); DA_SBAR();
#if defined(DA_DMAPOS) && DA_DMAPOS == 1
        DA_DMA_K(t + 2, s0); DA_DMA_V(t + 1, s2); DA_SBAR();
        DA_BIAS(pB0, pB1, t); DA_RESC(t - 1);
        pv_d0(o, vb0 + (int)s0, pa0, pa1, pa2, pa3, ones, pB0, []() {}, []() {});
#else
        DA_BIAS(pB0, pB1, t); DA_RESC(t - 1);
        { const unsigned ks_ = s0, vs_ = s2; pv_d0(o, vb0 + (int)s0, pa0, pa1, pa2, pa3, ones, pB0, [&]() { DA_DMA_K(t + 2, ks_); }, [&]() { DA_DMA_V(t + 1, vs_); }); }
#endif
        DA_ROT();
        DA_WAITBAR(4);
#if defined(DA_DUPQK)
        qkt(pA0, pA1, K_lds + s1, qr, r32, hi, mapB); asm volatile("" : "+v"(pA0), "+v"(pA1));
#endif
#if defined(DA_XBAR)
        asm volatile("s_waitcnt lgkmcnt(0)\n\ts_barrier" ::: "memory");
#endif
        DA_SBAR(); qkt(pA0, pA1, K_lds + s1, qr, r32, hi, mapB);
        finishSM(pB0, pB1, l_reg, pa0, pa1, pa2, pa3); DA_SBAR();
#if defined(DA_DMAPOS) && DA_DMAPOS == 1
        if (t + 3 < NT) DA_DMA_K(t + 3, s0); DA_DMA_V(t + 2, s2); DA_SBAR();
        DA_BIAS(pA0, pA1, t + 1); DA_RESC(t);
        pv_d0(o, vb0 + (int)s0, pa0, pa1, pa2, pa3, ones, pA0, []() {}, []() {});
#else
        DA_BIAS(pA0, pA1, t + 1); DA_RESC(t);
        { const unsigned ks_ = s0, vs_ = s2; pv_d0(o, vb0 + (int)s0, pa0, pa1, pa2, pa3, ones, pA0, [&]() { if (t + 3 < NT) DA_DMA_K(t + 3, ks_); }, [&]() { DA_DMA_V(t + 2, vs_); }); }
#endif
        DA_ROT();
    }
    DA_WAITBAR(2);
    DA_SBAR(); qkt(pB0, pB1, K_lds + s1, qr, r32, hi, mapB);
    finishSM(pA0, pA1, l_reg, pa0, pa1, pa2, pa3); DA_SBAR();
    DA_BIAS(pB0, pB1, NT - 1); DA_RESC(NT - 2); pv_d0(o, vb0 + (int)s0, pa0, pa1, pa2, pa3, ones, pB0, []() {}, []() {});
    DA_ROT();
    DA_WAITBAR(0);
    finishSM(pB0, pB1, l_reg, pa0, pa1, pa2, pa3); DA_SBAR();
    { f32x16 dmy = f32x16{}; DA_RESC(NT - 1); pv_d0(o, vb0 + (int)s0, pa0, pa1, pa2, pa3, ones, dmy, []() {}, []() {}); }
#endif
#if defined(DA_STAMP)
    if (blockIdx.x == 17 && wave_id == DA_STAMP && mk_lane() == 0) { const unsigned long long tot_ = __builtin_amdgcn_s_memtime() - tu0_;
        const_cast<float*>(P.sc)[100] = (float)((int)((double)wacc_ / (double)tot_ * 20.0 + 0.5) * 500);
        const_cast<float*>(P.sc)[101] = (float)((int)((double)tot_ / 20000.0 + 0.5) * 1000); }
#endif
#undef DA_RESC
#undef DA_DMA_K
#undef DA_DMA_V
#undef DA_WAITBAR
#undef DA_ROT
#undef DA_CVAL
#undef DA_NEAR
#undef DA_PART
#undef DA_BIAS
#if defined(MK_DA_STATPRIO)
    __builtin_amdgcn_s_setprio(0);
#endif
#if !DA_MFMA_SUM
    { auto rr = __builtin_amdgcn_permlane32_swap(__float_as_uint(l_reg), __float_as_uint(l_reg), false, false); l_reg = __uint_as_float(rr[0]) + __uint_as_float(rr[1]); }
    float* li_l = (float*)(lds + LDS_WS) + wid * 32;
    if (hi == 0) li_l[r32] = (map ? lam : 1.0f) / l_reg;
#endif
    int te_ = wave_id * 64 + mk_lane(); asm volatile("" : "+v"(te_));
    const int elane = te_ & 63, er32 = elane & 31, ehi = elane >> 5;
    const int erow = wid * 16 + (elane >> 2), eqtr = elane & 3;
    u32x4 zw[4];
    { const bf16_t* zp = P.ZA + (tok0 + Q0 + erow) * 512 + h * 128 + 32 * eqtr;
#pragma unroll
      for (int c8 = 0; c8 < 4; ++c8) zw[c8] = *reinterpret_cast<const u32x4*>(zp + 8 * c8); }
#if defined(MK_DA_GPRE)
    f32x4 gpre_[8];
    { const float* gp0_ = P.subg + 32 * eqtr;
#pragma unroll
      for (int i = 0; i < 8; ++i) gpre_[i] = *reinterpret_cast<const f32x4*>(gp0_ + 4 * i); }
#endif
    __syncthreads();
    float* OST = (float*)(lds + LDS_OST);
    const float lsc = map ? lam : 1.0f;
#if defined(MK_DA_OX2)
    float* ob = OST + (map ? (OSTRIDE * 128) : 0) + (wq * 32 + 4 * ehi) * OSTRIDE + er32;
    {
#pragma unroll
        for (int r = 0; r < 16; ++r) {
#if DA_MFMA_SUM
            const float sc_ = lsc * __builtin_amdgcn_rcpf(o[4][r]);
#else
            const float sc_ = ((const float*)(lds + LDS_WS) + wid * 32 + 4 * ehi)[(r & 3) + 8 * (r >> 2)];
#endif
#pragma unroll
            for (int d0 = 0; d0 < 4; ++d0) ob[((r & 3) + 8 * (r >> 2)) * OSTRIDE + d0 * 32] = o[d0][r] * sc_; }
    }
    __syncthreads();
    { const int row = erow, qtr = eqtr;
      const float* rp = OST + row * OSTRIDE + 32 * qtr;
      f32x4 v[8]; float ss = 0.f;
#pragma unroll
      for (int i = 0; i < 8; ++i) { v[i] = *reinterpret_cast<const f32x4*>(rp + 4 * i) - *reinterpret_cast<const f32x4*>(rp + OSTRIDE * 128 + 4 * i); ss += (v[i][0] * v[i][0] + v[i][1] * v[i][1]) + (v[i][2] * v[i][2] + v[i][3] * v[i][3]); }
#else
    float* ob = OST + (wq * 32 + 4 * ehi) * OSTRIDE + er32;
    if (map == 1) {
#pragma unroll
        for (int r = 0; r < 16; ++r) {
#if DA_MFMA_SUM
            const float sc_ = lsc * __builtin_amdgcn_rcpf(o[4][r]);
#else
            const float sc_ = ((const float*)(lds + LDS_WS) + wid * 32 + 4 * ehi)[(r & 3) + 8 * (r >> 2)];
#endif
#pragma unroll
            for (int d0 = 0; d0 < 4; ++d0) ob[((r & 3) + 8 * (r >> 2)) * OSTRIDE + d0 * 32] = o[d0][r] * sc_; }
    }
    __syncthreads();
    if (map == 0) {
#pragma unroll
        for (int r = 0; r < 16; ++r) {
#if DA_MFMA_SUM
            const float sc_ = lsc * __builtin_amdgcn_rcpf(o[4][r]);
#else
            const float sc_ = ((const float*)(lds + LDS_WS) + wid * 32 + 4 * ehi)[(r & 3) + 8 * (r >> 2)];
#endif
#pragma unroll
            for (int d0 = 0; d0 < 4; ++d0) { float* pp_ = &ob[((r & 3) + 8 * (r >> 2)) * OSTRIDE + d0 * 32]; *pp_ = o[d0][r] * sc_ - *pp_; } }
    }
    __syncthreads();
    { const int row = erow, qtr = eqtr;
      const float* rp = OST + row * OSTRIDE + 32 * qtr;
      f32x4 v[8]; float ss = 0.f;
#pragma unroll
      for (int i = 0; i < 8; ++i) { v[i] = *reinterpret_cast<const f32x4*>(rp + 4 * i); ss += (v[i][0] * v[i][0] + v[i][1] * v[i][1]) + (v[i][2] * v[i][2] + v[i][3] * v[i][3]); }
#endif
      ss += __shfl_xor(ss, 1); ss += __shfl_xor(ss, 2);
      const float rs = rsqrtf(ss * (1.0f / 128.0f) + 1e-6f) * 0.8f;
      const size_t tok = tok0 + Q0 + row;
      bf16_t* cp = P.CAT + tok * 1024 + h * 128 + 32 * qtr;
      const float* gp = P.subg + 32 * qtr;
#pragma unroll
      for (int c8 = 0; c8 < 4; ++c8) {
#if defined(MK_DA_GPRE)
          const f32x4 g0 = gpre_[2 * c8], g1 = gpre_[2 * c8 + 1];
#else
          const f32x4 g0 = *reinterpret_cast<const f32x4*>(gp + 8 * c8), g1 = *reinterpret_cast<const f32x4*>(gp + 8 * c8 + 4);
#endif
          const f32x4 a = v[2 * c8], bq = v[2 * c8 + 1];
          float y[8];
          y[0] = a[0] * rs * g0[0] * gatev(__uint_as_float(zw[c8].x << 16)); y[1] = a[1] * rs * g0[1] * gatev(__uint_as_float(zw[c8].x & 0xffff0000u));
          y[2] = a[2] * rs * g0[2] * gatev(__uint_as_float(zw[c8].y << 16)); y[3] = a[3] * rs * g0[3] * gatev(__uint_as_float(zw[c8].y & 0xffff0000u));
          y[4] = bq[0] * rs * g1[0] * gatev(__uint_as_float(zw[c8].z << 16)); y[5] = bq[1] * rs * g1[1] * gatev(__uint_as_float(zw[c8].z & 0xffff0000u));
          y[6] = bq[2] * rs * g1[2] * gatev(__uint_as_float(zw[c8].w << 16)); y[7] = bq[3] * rs * g1[3] * gatev(__uint_as_float(zw[c8].w & 0xffff0000u));
          u32x4 w; w.x = cvtpk(y[0], y[1]); w.y = cvtpk(y[2], y[3]); w.z = cvtpk(y[4], y[5]); w.w = cvtpk(y[6], y[7]);
          *reinterpret_cast<u32x4*>(cp + 8 * c8) = w; }
    }
    __syncthreads();
}

constexpr int LDS_LI2 = 139264, OST2_BYTES = 8 * 32 * OSTRIDE * 4;
static_assert(OST2_BYTES <= LDS_LI2 && LDS_LI2 + 8 * 64 * 4 <= 147456, "unit2 LDS map");
#define DA_PK8(P, BASE, OUT) do { u32x4 w = {cvtpk(P[BASE + 0], P[BASE + 1]), cvtpk(P[BASE + 2], P[BASE + 3]), cvtpk(P[BASE + 4], P[BASE + 5]), cvtpk(P[BASE + 6], P[BASE + 7])}; OUT = *reinterpret_cast<bf16x8*>(&w); } while (0)
__device__ __forceinline__ float softmax_pack(f32x16& p0, f32x16& p1, bf16x8& a0, bf16x8& a1, bf16x8& a2, bf16x8& a3) {
    exp_half(p0); exp_half(p1);
    float ps = 0.f;
#pragma unroll
    for (int r = 0; r < 16; ++r) ps += p0[r];
#pragma unroll
    for (int r = 0; r < 16; ++r) ps += p1[r];
    DA_PK8(p0, 0, a0); DA_PK8(p0, 8, a1); DA_PK8(p1, 0, a2); DA_PK8(p1, 8, a3);
    return ps;
}
#undef DA_PK8
#define DA_TRD(D0, L0, H0, L1, H1, L2, H2, L3, H3) do { L0 = tr_read<v_rd_off(D0, 0, 0)>(vb); H0 = tr_read<v_rd_off(D0, 0, 1)>(vb); L1 = tr_read<v_rd_off(D0, 1, 0)>(vb); H1 = tr_read<v_rd_off(D0, 1, 1)>(vb); \
    L2 = tr_read<v_rd_off(D0, 2, 0)>(vb); H2 = tr_read<v_rd_off(D0, 2, 1)>(vb); L3 = tr_read<v_rd_off(D0, 3, 0)>(vb); H3 = tr_read<v_rd_off(D0, 3, 1)>(vb); } while (0)
#define DA_PK(L, H) (bf16x8){L[0], L[1], L[2], L[3], H[0], H[1], H[2], H[3]}
#define DA_MM8(D0, L0, H0, L1, H1, L2, H2, L3, H3) do { \
    o1[D0] = __builtin_amdgcn_mfma_f32_32x32x16_bf16(a0, DA_PK(L0, H0), o1[D0], 0, 0, 0); o2[D0] = __builtin_amdgcn_mfma_f32_32x32x16_bf16(b0, DA_PK(L0, H0), o2[D0], 0, 0, 0); \
    o1[D0] = __builtin_amdgcn_mfma_f32_32x32x16_bf16(a1, DA_PK(L1, H1), o1[D0], 0, 0, 0); o2[D0] = __builtin_amdgcn_mfma_f32_32x32x16_bf16(b1, DA_PK(L1, H1), o2[D0], 0, 0, 0); \
    o1[D0] = __builtin_amdgcn_mfma_f32_32x32x16_bf16(a2, DA_PK(L2, H2), o1[D0], 0, 0, 0); o2[D0] = __builtin_amdgcn_mfma_f32_32x32x16_bf16(b2, DA_PK(L2, H2), o2[D0], 0, 0, 0); \
    o1[D0] = __builtin_amdgcn_mfma_f32_32x32x16_bf16(a3, DA_PK(L3, H3), o1[D0], 0, 0, 0); o2[D0] = __builtin_amdgcn_mfma_f32_32x32x16_bf16(b3, DA_PK(L3, H3), o2[D0], 0, 0, 0); } while (0)
__device__ __forceinline__ void pv2(f32x16* o1, f32x16* o2, int vb, bf16x8 a0, bf16x8 a1, bf16x8 a2, bf16x8 a3, bf16x8 b0, bf16x8 b1, bf16x8 b2, bf16x8 b3) {
    s16x4 x0, x1, x2, x3, x4, x5, x6, x7;
    DA_TRD(0, x0, x1, x2, x3, x4, x5, x6, x7); asm volatile("s_waitcnt lgkmcnt(0)" ::: "memory"); DA_SBAR(); DA_MM8(0, x0, x1, x2, x3, x4, x5, x6, x7); DA_SBAR();
    DA_TRD(1, x0, x1, x2, x3, x4, x5, x6, x7); asm volatile("s_waitcnt lgkmcnt(0)" ::: "memory"); DA_SBAR(); DA_MM8(1, x0, x1, x2, x3, x4, x5, x6, x7); DA_SBAR();
    DA_TRD(2, x0, x1, x2, x3, x4, x5, x6, x7); asm volatile("s_waitcnt lgkmcnt(0)" ::: "memory"); DA_SBAR(); DA_MM8(2, x0, x1, x2, x3, x4, x5, x6, x7); DA_SBAR();
    DA_TRD(3, x0, x1, x2, x3, x4, x5, x6, x7); asm volatile("s_waitcnt lgkmcnt(0)" ::: "memory"); DA_SBAR(); DA_MM8(3, x0, x1, x2, x3, x4, x5, x6, x7);
}
#undef DA_TRD
#undef DA_MM8
#undef DA_PK

__device__ __forceinline__ void addbias2(f32x16& p0, f32x16& p1, const float* tbl, int tb) {
#pragma unroll
    for (int r = 0; r < 16; ++r) { p0[r] += tbl[tb + (r & 3) + 8 * (r >> 2)]; p1[r] += tbl[tb + 32 + (r & 3) + 8 * (r >> 2)]; if ((r & 3) == 3) DA_SBAR(); }
}
__device__ __forceinline__ void qkt2(f32x16& p0, f32x16& p1, const char* Ks, const char* Qp, int r32, int hi, int mapB) {
    p0 = f32x16{}; p1 = f32x16{};
    const int sw = (r32 & 7) << 4;
#pragma unroll
    for (int d0 = 0; d0 < 4; ++d0) { const char* kp = Ks + r32 * 256 + (((d0 * 16 + hi * 8) * 2) ^ sw) + mapB;
        const bf16x8 b0 = *reinterpret_cast<const bf16x8*>(kp);
        const bf16x8 b1 = *reinterpret_cast<const bf16x8*>(kp + 32 * 256);
        const bf16x8 q = *reinterpret_cast<const bf16x8*>(Qp + d0 * 1024);
        p0 = __builtin_amdgcn_mfma_f32_32x32x16_bf16(b0, q, p0, 0, 0, 0);
        p1 = __builtin_amdgcn_mfma_f32_32x32x16_bf16(b1, q, p1, 0, 0, 0);
        if (d0 == 1) DA_SBAR(); }
}
constexpr int U2_K = 0, U2_V = 2 * SHM_K, U2_Q = 4 * SHM_K, U2_TBL = U2_Q + 8 * 8192;
struct Params2 { const char* bufb; const float* scal; const float* subg; };
constexpr size_t U2_BSB = (size_t)16384 * 512 * 2, U2_CAT = 8 * U2_BSB;
__device__ __forceinline__ void unit2(const Params2& P, int b, int h, int qb, char* lds, const int wave_id) {
    int tid_ = wave_id * 64 + mk_lane(); asm volatile("" : "+v"(tid_));
    const int tid = tid_, lane = tid & 63, r32 = lane & 31, hi = lane >> 5;
    const int wid = wave_id;
    char* V_lds = lds + U2_V; char* K_lds = lds + U2_K;
    float* tbl = (float*)(lds + U2_TBL);
    char* Qf = lds + U2_Q + wid * 8192 + lane * 16;
    const int Q0 = qb * 256, Qw0 = Q0 + 32 * wid;
    const size_t tok0 = (size_t)b * SEQ;
    const float cL = P.scal[8 + h], cR = P.scal[12 + h];
    tbl[tid] = P.scal[768 + h * 512 + tid];
    const char* Kh = P.bufb + U2_BSB + (tok0 * 512 + h * 128) * 2;
    const unsigned lds0 = (unsigned)(uintptr_t)lds;
    const unsigned kdst = lds0 + U2_K + wid * 2048, vdst = lds0 + U2_V + wid * 2048;
#define DA_DMA_KV(t, slot) do { const char* kt_ = Kh + (size_t)(t) * 65536; const char* vt_ = kt_ + U2_BSB; int ln_ = mk_lane(); asm volatile("" : "+v"(ln_)); \
    unsigned ko_[2], vo_[2]; \
    _Pragma("unroll") for (int i_ = 0; i_ < 2; ++i_) { const int B_ = (2 * wid + i_) * 1024 + ln_ * 16; \
        const int row_ = B_ >> 8, cB_ = B_ & 255; ko_[i_] = (unsigned)(row_ * 1024 + (cB_ ^ ((row_ & 7) << 4))); \
        const int st_ = B_ >> 9, rem_ = B_ & 511, k_ = (st_ >> 2) * 8 + (rem_ >> 6), c_ = (st_ & 3) * 32 + ((rem_ & 63) >> 1); vo_[i_] = (unsigned)(k_ * 1024 + c_ * 2); } \
    glds16x2_s(kt_, ko_[0], ko_[1], (unsigned)__builtin_amdgcn_readfirstlane(kdst + (slot))); glds16x2_s(vt_, vo_[0], vo_[1], (unsigned)__builtin_amdgcn_readfirstlane(vdst + (slot))); } while (0)
#define DA_WAITBAR(N) asm volatile("s_waitcnt vmcnt(" #N ") lgkmcnt(0)\n\ts_barrier" ::: "memory")
    DA_DMA_KV(0, 0);
    { const bf16_t* Qw = (const bf16_t*)P.bufb + (tok0 + Qw0 + r32) * 512 + h * 128 + hi * 8;
#pragma unroll
      for (int f = 0; f < 8; ++f) { const bf16x8 qv = *reinterpret_cast<const bf16x8*>(Qw + (f >> 2) * 64 + (f & 3) * 16); *reinterpret_cast<bf16x8*>(Qf + f * 1024) = qv; } }
#define DA_CVAL(t) ((64 * (t) - Qw0 <= -192) ? cL : ((64 * (t) - Qw0 >= 160) ? cR : 0.0f))
#define DA_NEAR(t) (64 * (t) - Qw0 > -192 && 64 * (t) - Qw0 < 160)
    f32x16 o1[4], o2[4]; float l1 = 0.f, l2 = 0.f, ccur = DA_CVAL(0);
#pragma unroll
    for (int d = 0; d < 4; ++d)
#pragma unroll
        for (int r = 0; r < 16; ++r) { o1[d][r] = 0.f; o2[d][r] = 0.f; }
    for (int t = 0; t < NT; ++t) {
        const unsigned sc_ = (unsigned)(t & 1) * SHM_K;
        DA_WAITBAR(0);
        if (t + 1 < NT) DA_DMA_KV(t + 1, sc_ ^ SHM_K);
        { const float cn_ = DA_CVAL(t);
          if (cn_ != ccur) { const float f_ = __builtin_amdgcn_exp2f(ccur - cn_); ccur = cn_; l1 *= f_; l2 *= f_;
#pragma unroll
              for (int d_ = 0; d_ < 4; ++d_)
#pragma unroll
                  for (int r_ = 0; r_ < 16; ++r_) { o1[d_][r_] *= f_; o2[d_][r_] *= f_; } } }
        f32x16 p0, p1; bf16x8 a0, a1, a2, a3, b0, b1, b2, b3;
        { int ln_ = mk_lane(); const int r32_ = ln_ & 31, hi_ = ln_ >> 5; const char* qf_ = lds + U2_Q + wid * 8192 + ln_ * 16; const int tb_ = -Qw0 - r32_ + 4 * hi_ + 255 + 64 * t;
          DA_SBAR(); qkt2(p0, p1, K_lds + sc_, qf_, r32_, hi_, 0);
          if (DA_NEAR(t)) addbias2(p0, p1, tbl, tb_);
          l1 += softmax_pack(p0, p1, a0, a1, a2, a3);
          asm volatile("" ::: "memory");
          DA_SBAR(); qkt2(p0, p1, K_lds + sc_, qf_ + 4096, r32_, hi_, 128);
          if (DA_NEAR(t)) addbias2(p0, p1, tbl, tb_);
          l2 += softmax_pack(p0, p1, b0, b1, b2, b3); }
        { const int vb_ = (int)(uintptr_t)V_lds + v_rd_base(mk_lane()) + (int)sc_;
          DA_SBAR(); pv2(o1, o2, vb_, a0, a1, a2, a3, b0, b1, b2, b3); }
    }
#undef DA_DMA_KV
#undef DA_WAITBAR
#undef DA_CVAL
#undef DA_NEAR
    { auto rr = __builtin_amdgcn_permlane32_swap(__float_as_uint(l1), __float_as_uint(l1), false, false); l1 = __uint_as_float(rr[0]) + __uint_as_float(rr[1]); }
    { auto rr = __builtin_amdgcn_permlane32_swap(__float_as_uint(l2), __float_as_uint(l2), false, false); l2 = __uint_as_float(rr[0]) + __uint_as_float(rr[1]); }
    int te_ = wave_id * 64 + mk_lane(); asm volatile("" : "+v"(te_));
    const int elane = te_ & 63, er32 = elane & 31, ehi = elane >> 5;
    float* li = (float*)(lds + LDS_LI2) + wid * 64;
    { const float lam = P.scal[0]; if (ehi == 0) { li[er32] = 1.0f / l1; li[32 + er32] = lam / l2; } }
    const int prow = elane >> 1, phalf = elane & 1;
    const size_t ptok = tok0 + Qw0 + prow;
    u32x4 zw[8];
    { const bf16_t* zp = (const bf16_t*)(P.bufb + 3 * U2_BSB) + ptok * 512 + h * 128 + 64 * phalf;
#pragma unroll
      for (int c8 = 0; c8 < 8; ++c8) zw[c8] = *reinterpret_cast<const u32x4*>(zp + 8 * c8); }
    __syncthreads();
    float* OSTw = (float*)(lds) + wid * (32 * OSTRIDE);
    { const float* lib = li + 4 * ehi; float* ob = OSTw + (4 * ehi) * OSTRIDE + er32;
#pragma unroll
      for (int r = 0; r < 16; ++r) { const float s1 = lib[(r & 3) + 8 * (r >> 2)], s2 = lib[32 + (r & 3) + 8 * (r >> 2)];
#pragma unroll
          for (int d0 = 0; d0 < 4; ++d0) ob[((r & 3) + 8 * (r >> 2)) * OSTRIDE + d0 * 32] = o1[d0][r] * s1 - o2[d0][r] * s2; } }
    asm volatile("s_waitcnt lgkmcnt(0)" ::: "memory");
    __builtin_amdgcn_wave_barrier();
    { const float* rp = OSTw + prow * OSTRIDE + 64 * phalf;
      f32x4 v[16]; float ss = 0.f;
#pragma unroll
      for (int i = 0; i < 16; ++i) { v[i] = *reinterpret_cast<const f32x4*>(rp + 4 * i); ss += (v[i][0] * v[i][0] + v[i][1] * v[i][1]) + (v[i][2] * v[i][2] + v[i][3] * v[i][3]); }
      ss += __shfl_xor(ss, 1);
      const float rs = rsqrtf(ss * (1.0f / 128.0f) + 1e-6f) * 0.8f;
      bf16_t* cp = (bf16_t*)(const_cast<char*>(P.bufb) + U2_CAT) + ptok * 1024 + h * 128 + 64 * phalf;
      const float* gp = P.subg + 64 * phalf;
#pragma unroll
      for (int c8 = 0; c8 < 8; ++c8) {
          const f32x4 g0 = *reinterpret_cast<const f32x4*>(gp + 8 * c8), g1 = *reinterpret_cast<const f32x4*>(gp + 8 * c8 + 4);
          const f32x4 a = v[2 * c8], bq = v[2 * c8 + 1];
          float y[8];
          y[0] = a[0] * rs * g0[0] * gatev(__uint_as_float(zw[c8].x << 16)); y[1] = a[1] * rs * g0[1] * gatev(__uint_as_float(zw[c8].x & 0xffff0000u));
          y[2] = a[2] * rs * g0[2] * gatev(__uint_as_float(zw[c8].y << 16)); y[3] = a[3] * rs * g0[3] * gatev(__uint_as_float(zw[c8].y & 0xffff0000u));
          y[4] = bq[0] * rs * g1[0] * gatev(__uint_as_float(zw[c8].z << 16)); y[5] = bq[1] * rs * g1[1] * gatev(__uint_as_float(zw[c8].z & 0xffff0000u));
          y[6] = bq[2] * rs * g1[2] * gatev(__uint_as_float(zw[c8].w << 16)); y[7] = bq[3] * rs * g1[3] * gatev(__uint_as_float(zw[c8].w & 0xffff0000u));
          u32x4 w; w.x = cvtpk(y[0], y[1]); w.y = cvtpk(y[2], y[3]); w.z = cvtpk(y[4], y[5]); w.w = cvtpk(y[6], y[7]);
          *reinterpret_cast<u32x4*>(cp + 8 * c8) = w; }
    }
    __syncthreads();
}
#undef DA_KSWZ
#undef DA_SBAR
}

namespace na {
#if defined(MK_SILU_LATE)
__device__ __forceinline__ float gatev(float z) { return z * __builtin_amdgcn_rcpf(1.0f + __builtin_amdgcn_exp2f(-1.4426950408889634f * z)); }
#else
__device__ __forceinline__ float gatev(float z) { return z; }
#endif
using bf16x8 = __attribute__((ext_vector_type(8))) short;
using s16x4  = __attribute__((ext_vector_type(4))) short;
using f32x4  = __attribute__((ext_vector_type(4))) float;
using u32x4  = __attribute__((ext_vector_type(4))) unsigned;
using u32x2  = __attribute__((ext_vector_type(2))) unsigned;
typedef unsigned short bf16_t;
constexpr int SEQ = 2048, NSLOT = 9, SLOTB = 16384, LDS_RPB = NSLOT * SLOTB  , LDS_END = LDS_RPB + 15 * 32 * 4;
constexpr float LOG2E = 1.4426950408889634f;
typedef float f32x2_t __attribute__((ext_vector_type(2))); typedef __bf16 bf16x2_t __attribute__((ext_vector_type(2)));
__device__ __forceinline__ unsigned cvtpk(float lo, float hi) { f32x2_t v = {lo, hi}; bf16x2_t b = __builtin_convertvector(v, bf16x2_t); return __builtin_bit_cast(unsigned, b); }
__device__ __forceinline__ int clampi(int v, int lo, int hi) { return v < lo ? lo : (v > hi ? hi : v); }
__device__ __forceinline__ int rs_of(int r) { return clampi(r - 4, 0, 24); }
typedef short v4i16_t __attribute__((ext_vector_type(4)));
__device__ __forceinline__ s16x4 tr_read0(int addr) { return __builtin_bit_cast(s16x4, __builtin_amdgcn_ds_read_tr16_b64_v4i16((__attribute__((address_space(3))) v4i16_t*)(unsigned)addr)); }
__device__ __forceinline__ float wave_max(float v) {
#pragma unroll
    for (int o = 1; o < 64; o <<= 1) v = fmaxf(v, __shfl_xor(v, o));
    return v;
}
struct Params {
    const bf16_t* QB; const bf16_t* KB; const bf16_t* VB; const bf16_t* ZB;
    const float* rpbg;
    bf16_t* CAT;
};

__device__ __forceinline__ void glds16_s(const void* sbase, unsigned off, unsigned lds_dst) { unsigned keep;
    asm volatile("s_mov_b32 %0, m0\n\ts_mov_b32 m0, %3\n\ts_nop 0\n\tglobal_load_lds_dwordx4 %1, %2\n\ts_mov_b32 m0, %0" : "=&s"(keep) : "v"(off), "s"(sbase), "s"(lds_dst) : "memory"); }
__device__ __forceinline__ void glds16(const void* gsrc, unsigned lds_dst) { unsigned keep;
    asm volatile("s_mov_b32 %0, m0\n\ts_mov_b32 m0, %2\n\ts_nop 0\n\tglobal_load_lds_dwordx4 %1, off\n\ts_mov_b32 m0, %0" : "=&s"(keep) : "v"(gsrc), "s"(lds_dst) : "memory"); }

__device__ __forceinline__ void unit(const Params& P, int b, int h, int seg, char* lds, const int wave_id) {
    int tid_ = wave_id * 64 + mk_lane(); asm volatile("" : "+v"(tid_));
    const int tid = tid_, lane = tid & 63, l15 = lane & 15, g = lane >> 4;
#ifndef NA_STAMPOFF
#define NA_STAMPOFF 0.0
#endif
#if defined(NA_STAMP)
    const unsigned long long st0_ = __builtin_amdgcn_s_memrealtime(); unsigned long long st1_ = 0, st2_ = 0;
#endif
    const int wid = wave_id, rr = wid >> 2, qt = wid & 3;
    float* RPB = (float*)(lds + LDS_RPB);
    const size_t tok0 = (size_t)b * SEQ;
#if defined(MK_LATETBL)
    float rpbv_ = -1.0e30f; if (tid < 480 && (tid & 31) < 31) rpbv_ = P.rpbg[h * 480 + tid];
#else
    if (tid < 480) RPB[tid] = ((tid & 31) < 31) ? P.rpbg[h * 480 + tid] : -1.0e30f;
#endif
    const int r0 = seg * 8;
    const int c0 = 16 * qt, kc0 = clampi(c0 - 8, 0, 32);
    const int qc = c0 + l15, cs = clampi(qc - 8, 0, 48);
    int dci[2][4];
#pragma unroll
    for (int blk = 0; blk < 2; ++blk)
#pragma unroll
        for (int e = 0; e < 4; ++e) { const int kc = kc0 + 16 * blk + 4 * g + e; dci[blk][e] = ((kc >= cs) && (kc < cs + 16)) ? (kc - qc + 15) : 31; }
    const int skc = 8 * wid + (lane >> 3), sch = lane & 7;
    const unsigned koff = (unsigned)((skc * 512 + h * 64 + ((sch ^ (skc & 7)) << 3)) * 2);
    const unsigned voff = (unsigned)((skc * 512 + h * 64 + ((((sch >> 1) ^ ((skc >> 1) & 3)) << 1 | (sch & 1)) << 3)) * 2);
    const char* Kb = (const char*)(P.KB + tok0 * 512); const char* Vb = (const char*)(P.VB + tok0 * 512);
    const unsigned lds0 = (unsigned)(uintptr_t)lds;
    const unsigned kdst = lds0 + wid * 1024, vdst = lds0 + 8192 + wid * 1024;
#if defined(MK_NA_SADDR)
#define NA_GLDS(b_, o_, d_) glds16_s((b_), (o_), (d_))
#else
#define NA_GLDS(b_, o_, d_) glds16((b_) + (o_), (d_))
#endif
#define NA_DMA_ROW(kr) do { const unsigned so_ = (unsigned)(((kr) % NSLOT) * SLOTB); const size_t ro_ = (size_t)(kr) * 65536; \
    NA_GLDS(Kb + ro_, koff, (unsigned)__builtin_amdgcn_readfirstlane(kdst + so_)); NA_GLDS(Vb + ro_, voff, (unsigned)__builtin_amdgcn_readfirstlane(vdst + so_)); } while (0)
    int kad[2][2];
#pragma unroll
    for (int blk = 0; blk < 2; ++blk)
#pragma unroll
        for (int ks = 0; ks < 2; ++ks) { const int row = kc0 + 16 * blk + l15; kad[blk][ks] = row * 128 + (((4 * ks + g) ^ (row & 7)) << 4); }
    int vad[2][4];
#pragma unroll
    for (int blk = 0; blk < 2; ++blk)
#pragma unroll
        for (int d = 0; d < 4; ++d) { const int row = kc0 + 16 * blk + 4 * g + (l15 >> 2); vad[blk][d] = (int)lds0 + 8192 + row * 128 + 8 * (l15 & 3) + ((d ^ ((row >> 1) & 3)) << 5); }
    const bf16x8 ones = (bf16x8){0x3F80, 0x3F80, 0x3F80, 0x3F80, 0x3F80, 0x3F80, 0x3F80, 0x3F80};
#if defined(MK_NA_FILLSPLIT)
    for (int kr = rs_of(r0); kr <= rs_of(r0 + 1) + 5; ++kr) NA_DMA_ROW(kr);
#else
    for (int kr = rs_of(r0); kr <= rs_of(r0 + 1) + 7; ++kr) NA_DMA_ROW(kr);
#endif
    int loaded_hi = rs_of(r0 + 1) + 7;
#if defined(NA_SLEEPFILL)
    for (int sl_ = 0; sl_ < NA_SLEEPFILL; ++sl_) __builtin_amdgcn_s_sleep(28);
#endif
    bf16x8 qf[2]; u32x2 zw[4];
    { const size_t qtok = tok0 + (size_t)(r0 + rr) * 64 + c0 + l15;
#pragma unroll
      for (int ks = 0; ks < 2; ++ks) qf[ks] = *reinterpret_cast<const bf16x8*>(P.QB + qtok * 512 + h * 64 + 32 * ks + 8 * g);
#pragma unroll
      for (int d = 0; d < 4; ++d) zw[d] = *reinterpret_cast<const u32x2*>(P.ZB + qtok * 512 + h * 64 + 16 * d + 4 * g); }
#if defined(MK_NA_FILLSPLIT)
    asm volatile("" ::: "memory");
    NA_DMA_ROW(loaded_hi - 1); NA_DMA_ROW(loaded_hi);
#endif
#if defined(MK_LATETBL)
    if (tid < 480) RPB[tid] = rpbv_;
#endif
    u32x2 pend[4]; size_t pend_tok = 0;
#pragma unroll
    for (int d = 0; d < 4; ++d) pend[d] = (u32x2){0u, 0u};
#if defined(MK_NA_BREG)
    f32x4 breg_[MK_NA_BREG][2]; int boff_ = 1000;
#endif
#if defined(MK_NA_XSTEP)
    bf16x8 kA[4], kB[4]; s16x4 vA[8], vB[8]; f32x4 bA[2], bB[2];
#endif
    for (int t = 0; t < 4; ++t) {
        const int ra = r0 + 2 * t, r = ra + rr, rs = rs_of(r);
#if defined(MK_NA_LATEWAIT)
        if (t == 0)
#endif
#if defined(MK_NA_FILLSPLIT)
        asm volatile("s_waitcnt vmcnt(4) lgkmcnt(0)\n\ts_barrier" ::: "memory");
#else
        asm volatile("s_waitcnt vmcnt(0) lgkmcnt(0)\n\ts_barrier" ::: "memory");
#endif
#if defined(NA_STAMP)
        if (t == 0) st1_ = __builtin_amdgcn_s_memrealtime();
#endif
        const size_t qtok = tok0 + (size_t)r * 64 + c0 + l15;
        if (t > 0) { bf16_t* cp = P.CAT + pend_tok * 1024 + 512 + h * 64 + 4 * g;
#pragma unroll
            for (int d = 0; d < 4; ++d) *reinterpret_cast<u32x2*>(cp + 16 * d) = pend[d]; }
        bf16x8 qn[2]; u32x2 zn[4];
#if defined(MK_NA_NOLOOP)
        qn[0] = qf[0]; qn[1] = qf[1];
#pragma unroll
        for (int d = 0; d < 4; ++d) zn[d] = zw[d];
#endif
#if defined(MK_NA_NOLOOP)
        if (t < 3)
#endif
        { const size_t ntok = tok0 + (size_t)(t < 3 ? r + 2 : r) * 64 + c0 + l15;
#pragma unroll
          for (int ks = 0; ks < 2; ++ks) qn[ks] = *reinterpret_cast<const bf16x8*>(P.QB + ntok * 512 + h * 64 + 32 * ks + 8 * g);
#pragma unroll
          for (int d = 0; d < 4; ++d) zn[d] = *reinterpret_cast<const u32x2*>(P.ZB + ntok * 512 + h * 64 + 16 * d + 4 * g); }
        f32x4 o[4], osum = (f32x4){0.f, 0.f, 0.f, 0.f};
#pragma unroll
        for (int d = 0; d < 4; ++d) o[d] = (f32x4){0.f, 0.f, 0.f, 0.f};
#if defined(MK_NA_SPLIT)
#if defined(MK_NA_BREG)
    { const int off_ = rs - r; if (off_ != boff_) { boff_ = off_; const float* bp0_ = RPB + (off_ + 7) * 32;
        _Pragma("unroll") for (int i_ = 0; i_ < MK_NA_BREG; ++i_) _Pragma("unroll") for (int e_ = 0; e_ < 4; ++e_) { breg_[i_][0][e_] = bp0_[i_ * 32 + dci[0][e_]]; breg_[i_][1][e_] = bp0_[i_ * 32 + dci[1][e_]]; } } }
#define NA_LOADK(KF, BF, i, RS_, R_) do { const int so_ = (((RS_) + (i)) % NSLOT) * SLOTB; const char* sp_ = lds + so_; \
    if ((i) >= MK_NA_BREG) { const float* bp_ = RPB + ((RS_) - (R_) + (i) + 7) * 32; _Pragma("unroll") for (int e_ = 0; e_ < 4; ++e_) { BF[0][e_] = bp_[dci[0][e_]]; BF[1][e_] = bp_[dci[1][e_]]; } } \
    KF[0] = *reinterpret_cast<const bf16x8*>(sp_ + kad[0][0]); KF[1] = *reinterpret_cast<const bf16x8*>(sp_ + kad[0][1]); KF[2] = *reinterpret_cast<const bf16x8*>(sp_ + kad[1][0]); KF[3] = *reinterpret_cast<const bf16x8*>(sp_ + kad[1][1]); } while (0)
#define NA_QK(KF, BF, S0, S1) do { S0 = (BF)[0]; S1 = (BF)[1]; \
    S0 = __builtin_amdgcn_mfma_f32_16x16x32_bf16(KF[0], qf[0], S0, 0, 0, 0); S1 = __builtin_amdgcn_mfma_f32_16x16x32_bf16(KF[2], qf[0], S1, 0, 0, 0); \
    S0 = __builtin_amdgcn_mfma_f32_16x16x32_bf16(KF[1], qf[1], S0, 0, 0, 0); S1 = __builtin_amdgcn_mfma_f32_16x16x32_bf16(KF[3], qf[1], S1, 0, 0, 0); } while (0)
#else
#define NA_LOADK(KF, BF, i, RS_, R_) do { const int so_ = (((RS_) + (i)) % NSLOT) * SLOTB; const char* sp_ = lds + so_; const float* bp_ = RPB + ((RS_) - (R_) + (i) + 7) * 32; \
    _Pragma("unroll") for (int e_ = 0; e_ < 4; ++e_) { BF[0][e_] = bp_[dci[0][e_]]; BF[1][e_] = bp_[dci[1][e_]]; } \
    KF[0] = *reinterpret_cast<const bf16x8*>(sp_ + kad[0][0]); KF[1] = *reinterpret_cast<const bf16x8*>(sp_ + kad[0][1]); KF[2] = *reinterpret_cast<const bf16x8*>(sp_ + kad[1][0]); KF[3] = *reinterpret_cast<const bf16x8*>(sp_ + kad[1][1]); } while (0)
#define NA_QK(KF, BF, S0, S1) do { S0 = BF[0]; S1 = BF[1]; \
    S0 = __builtin_amdgcn_mfma_f32_16x16x32_bf16(KF[0], qf[0], S0, 0, 0, 0); S1 = __builtin_amdgcn_mfma_f32_16x16x32_bf16(KF[2], qf[0], S1, 0, 0, 0); \
    S0 = __builtin_amdgcn_mfma_f32_16x16x32_bf16(KF[1], qf[1], S0, 0, 0, 0); S1 = __builtin_amdgcn_mfma_f32_16x16x32_bf16(KF[3], qf[1], S1, 0, 0, 0); } while (0)
#endif
#define NA_LOADV(VF, i, RS_) do { const int so_ = (((RS_) + (i)) % NSLOT) * SLOTB; \
    _Pragma("unroll") for (int d_ = 0; d_ < 4; ++d_) { const int va_ = so_ + vad[0][d_]; VF[2 * d_] = tr_read0(va_); VF[2 * d_ + 1] = tr_read0(va_ + 2048); } } while (0)
#define NA_SMPV(VF, S0, S1) do { \
    _Pragma("unroll") for (int e = 0; e < 4; ++e) { S0[e] = __builtin_amdgcn_exp2f(S0[e]); S1[e] = __builtin_amdgcn_exp2f(S1[e]); } \
    u32x4 pw; pw.x = cvtpk(S0[0], S0[1]); pw.y = cvtpk(S0[2], S0[3]); pw.z = cvtpk(S1[0], S1[1]); pw.w = cvtpk(S1[2], S1[3]); \
    const bf16x8 pb = *reinterpret_cast<const bf16x8*>(&pw); \
    osum = __builtin_amdgcn_mfma_f32_16x16x32_bf16(ones, pb, osum, 0, 0, 0); \
    _Pragma("unroll") for (int d_ = 0; d_ < 4; ++d_) { const s16x4 lo = VF[2 * d_], hi_ = VF[2 * d_ + 1]; \
        const bf16x8 va = (bf16x8){lo[0], lo[1], lo[2], lo[3], hi_[0], hi_[1], hi_[2], hi_[3]}; \
        o[d_] = __builtin_amdgcn_mfma_f32_16x16x32_bf16(va, pb, o[d_], 0, 0, 0); } } while (0)
#define NA_SB() __builtin_amdgcn_sched_barrier(0)
#if defined(MK_NA_BREG)
#define NA_BI(b_, i_) (((i_) < MK_NA_BREG) ? breg_[((i_) < MK_NA_BREG) ? (i_) : 0] : b_)
#else
#define NA_BI(b_, i_) b_
#endif
        f32x4 sA0, sA1, sB0, sB1;
        const int rn_ = r + 2, rsn_ = rs_of(rn_);
        if (t == 0) { NA_LOADK(kA, bA, 0, rs, r); NA_LOADV(vA, 0, rs); NA_LOADK(kB, bB, 1, rs, r); NA_LOADV(vB, 1, rs); }
        NA_SB();
        NA_QK(kA, NA_BI(bA, 0), sA0, sA1); NA_LOADK(kA, bA, 2, rs, r);
        NA_SB();
        NA_QK(kB, NA_BI(bB, 1), sB0, sB1); NA_LOADK(kB, bB, 3, rs, r); NA_SMPV(vA, sA0, sA1); NA_LOADV(vA, 2, rs);
        NA_SB();
        NA_QK(kA, NA_BI(bA, 2), sA0, sA1); NA_LOADK(kA, bA, 4, rs, r); NA_SMPV(vB, sB0, sB1); NA_LOADV(vB, 3, rs);
        NA_SB();
        NA_QK(kB, NA_BI(bB, 3), sB0, sB1); NA_LOADK(kB, bB, 5, rs, r); NA_SMPV(vA, sA0, sA1); NA_LOADV(vA, 4, rs);
        NA_SB();
        NA_QK(kA, NA_BI(bA, 4), sA0, sA1); NA_SMPV(vB, sB0, sB1); NA_LOADV(vB, 5, rs);
        NA_SB();
        asm volatile("s_waitcnt vmcnt(4)" ::: "memory");
        asm volatile("s_waitcnt lgkmcnt(0)\n\ts_barrier" ::: "memory");
        if (t < 3) { const int nh = rs_of(ra + 3) + 7; for (int kr = loaded_hi + 1; kr <= nh; ++kr) NA_DMA_ROW(kr); loaded_hi = nh; }
        NA_SB();
        NA_LOADK(kA, bA, 6, rs, r);
        NA_QK(kB, NA_BI(bB, 5), sB0, sB1); NA_LOADK(kB, bB, 7, rs, r); NA_SMPV(vA, sA0, sA1); NA_LOADV(vA, 6, rs);
        NA_SB();
        NA_QK(kA, NA_BI(bA, 6), sA0, sA1); if (t < 3) NA_LOADK(kA, bA, 0, rsn_, rn_); NA_SMPV(vB, sB0, sB1); NA_LOADV(vB, 7, rs);
        NA_SB();
        NA_QK(kB, NA_BI(bB, 7), sB0, sB1); if (t < 3) NA_LOADK(kB, bB, 1, rsn_, rn_); NA_SMPV(vA, sA0, sA1); if (t < 3) NA_LOADV(vA, 0, rsn_);
        NA_SB();
        NA_SMPV(vB, sB0, sB1); if (t < 3) NA_LOADV(vB, 1, rsn_);
#undef NA_LOADK
#undef NA_LOADV
#undef NA_QK
#undef NA_SMPV
#undef NA_SB
#undef NA_BI
#else
#if !defined(MK_NA_XSTEP)
        bf16x8 kA[4], kB[4]; s16x4 vA[8], vB[8]; f32x4 bA[2], bB[2];
#endif
#define NA_LOADF(KF, VF, BF, i) NA_LOADF2(KF, VF, BF, i, rs, r)
#define NA_LOADF2(KF, VF, BF, i, RS_, R_) do { const int so_ = (((RS_) + (i)) % NSLOT) * SLOTB; const char* sp_ = lds + so_; const float* bp_ = RPB + ((RS_) - (R_) + (i) + 7) * 32; \
    _Pragma("unroll") for (int e_ = 0; e_ < 4; ++e_) { BF[0][e_] = bp_[dci[0][e_]]; BF[1][e_] = bp_[dci[1][e_]]; } \
    KF[0] = *reinterpret_cast<const bf16x8*>(sp_ + kad[0][0]); KF[1] = *reinterpret_cast<const bf16x8*>(sp_ + kad[0][1]); KF[2] = *reinterpret_cast<const bf16x8*>(sp_ + kad[1][0]); KF[3] = *reinterpret_cast<const bf16x8*>(sp_ + kad[1][1]); \
    _Pragma("unroll") for (int d_ = 0; d_ < 4; ++d_) { const int va_ = so_ + vad[0][d_]; VF[2 * d_] = tr_read0(va_); VF[2 * d_ + 1] = tr_read0(va_ + 2048); } } while (0)
#if defined(MK_NA_PRIO)
#define NA_PRIO(x) __builtin_amdgcn_s_setprio(x)
#else
#define NA_PRIO(x) do {} while (0)
#endif
#define NA_ITEM(KF, VF, BF, i) do { f32x4 s0 = BF[0], s1 = BF[1]; NA_PRIO(1); \
    s0 = __builtin_amdgcn_mfma_f32_16x16x32_bf16(KF[0], qf[0], s0, 0, 0, 0); s1 = __builtin_amdgcn_mfma_f32_16x16x32_bf16(KF[2], qf[0], s1, 0, 0, 0); \
    s0 = __builtin_amdgcn_mfma_f32_16x16x32_bf16(KF[1], qf[1], s0, 0, 0, 0); s1 = __builtin_amdgcn_mfma_f32_16x16x32_bf16(KF[3], qf[1], s1, 0, 0, 0); \
    _Pragma("unroll") for (int e = 0; e < 4; ++e) { s0[e] = __builtin_amdgcn_exp2f(s0[e]); s1[e] = __builtin_amdgcn_exp2f(s1[e]); } \
    u32x4 pw; pw.x = cvtpk(s0[0], s0[1]); pw.y = cvtpk(s0[2], s0[3]); pw.z = cvtpk(s1[0], s1[1]); pw.w = cvtpk(s1[2], s1[3]); \
    const bf16x8 pb = *reinterpret_cast<const bf16x8*>(&pw); \
    osum = __builtin_amdgcn_mfma_f32_16x16x32_bf16(ones, pb, osum, 0, 0, 0); \
    _Pragma("unroll") for (int d_ = 0; d_ < 4; ++d_) { const s16x4 lo = VF[2 * d_], hi_ = VF[2 * d_ + 1]; \
        const bf16x8 va = (bf16x8){lo[0], lo[1], lo[2], lo[3], hi_[0], hi_[1], hi_[2], hi_[3]}; \
        o[d_] = __builtin_amdgcn_mfma_f32_16x16x32_bf16(va, pb, o[d_], 0, 0, 0); } NA_PRIO(0); } while (0)
#define NA_MID() do { asm volatile("s_waitcnt lgkmcnt(0)\n\ts_barrier" ::: "memory"); \
    if (t < 3) { const int nh = rs_of(ra + 3) + 7; for (int kr = loaded_hi + 1; kr <= nh; ++kr) NA_DMA_ROW(kr); loaded_hi = nh; } } while (0)
#if defined(MK_NA_XSTEP)
        if (t == 0) { NA_LOADF(kA, vA, bA, 0); NA_LOADF(kB, vB, bB, 1); }
        __builtin_amdgcn_sched_barrier(0); NA_ITEM(kA, vA, bA, 0);
#else
        NA_LOADF(kA, vA, bA, 0);
        NA_LOADF(kB, vB, bB, 1); __builtin_amdgcn_sched_barrier(0); NA_ITEM(kA, vA, bA, 0);
#endif
        NA_ITEM(kB, vB, bB, 1);
#if defined(NA_DUP01)
        for (int dp_ = 0; dp_ < NA_DUP01; ++dp_) {
#pragma unroll
            for (int d = 0; d < 4; ++d) asm volatile("" : "+v"(o[d]));
            asm volatile("" : "+v"(osum));
#pragma unroll
            for (int d = 0; d < 4; ++d) o[d] = (f32x4){0.f, 0.f, 0.f, 0.f};
            osum = (f32x4){0.f, 0.f, 0.f, 0.f};
            NA_LOADF(kA, vA, bA, 0);
            NA_LOADF(kB, vB, bB, 1); __builtin_amdgcn_sched_barrier(0); NA_ITEM(kA, vA, bA, 0);
            NA_ITEM(kB, vB, bB, 1); }
#endif
#if !(defined(MK_NA_LATEWAIT) && MK_NA_LATEWAIT == 2)
        NA_MID();
#endif
#if defined(NA_SLEEPMID)
        __builtin_amdgcn_s_sleep(NA_SLEEPMID);
#endif
        NA_LOADF(kA, vA, bA, 2);
        NA_LOADF(kB, vB, bB, 3); __builtin_amdgcn_sched_barrier(0); NA_ITEM(kA, vA, bA, 2);
        NA_LOADF(kA, vA, bA, 4); __builtin_amdgcn_sched_barrier(0); NA_ITEM(kB, vB, bB, 3);
        NA_LOADF(kB, vB, bB, 5); __builtin_amdgcn_sched_barrier(0); NA_ITEM(kA, vA, bA, 4);
#if defined(MK_NA_LATEWAIT)
#if MK_NA_LATEWAIT == 2
        __builtin_amdgcn_sched_barrier(0);
#if defined(MK_NA_FILLSPLIT)
        asm volatile("s_waitcnt vmcnt(4)" ::: "memory");
#else
        if (t > 0) asm volatile("s_waitcnt vmcnt(4)" ::: "memory");
#endif
        asm volatile("s_waitcnt lgkmcnt(0)\n\ts_barrier" ::: "memory");
        if (t < 3) { const int nh = rs_of(ra + 3) + 7; for (int kr = loaded_hi + 1; kr <= nh; ++kr) NA_DMA_ROW(kr); loaded_hi = nh; }
        __builtin_amdgcn_sched_barrier(0);
#else
        if (t > 0) { __builtin_amdgcn_sched_barrier(0); asm volatile("s_waitcnt vmcnt(4)\n\ts_barrier" ::: "memory"); __builtin_amdgcn_sched_barrier(0); }
#endif
#endif
        NA_LOADF(kA, vA, bA, 6); __builtin_amdgcn_sched_barrier(0); NA_ITEM(kB, vB, bB, 5);
        NA_LOADF(kB, vB, bB, 7); __builtin_amdgcn_sched_barrier(0); NA_ITEM(kA, vA, bA, 6);
#if defined(MK_NA_XSTEP)
        if (t < 3) { const int rn_ = r + 2, rsn_ = rs_of(rn_); NA_LOADF2(kA, vA, bA, 0, rsn_, rn_); }
        __builtin_amdgcn_sched_barrier(0); NA_ITEM(kB, vB, bB, 7);
        if (t < 3) { const int rn_ = r + 2, rsn_ = rs_of(rn_); NA_LOADF2(kB, vB, bB, 1, rsn_, rn_); }
#else
        NA_ITEM(kB, vB, bB, 7);
#endif
#undef NA_LOADF2
#undef NA_LOADF
#undef NA_ITEM
#undef NA_MID
#endif
        const float inv = __builtin_amdgcn_rcpf(osum[0]);
#pragma unroll
        for (int d = 0; d < 4; ++d) {
            pend[d].x = cvtpk(o[d][0] * inv * gatev(__uint_as_float(zw[d].x << 16)), o[d][1] * inv * gatev(__uint_as_float(zw[d].x & 0xffff0000u)));
            pend[d].y = cvtpk(o[d][2] * inv * gatev(__uint_as_float(zw[d].y << 16)), o[d][3] * inv * gatev(__uint_as_float(zw[d].y & 0xffff0000u))); }
        pend_tok = qtok;
        qf[0] = qn[0]; qf[1] = qn[1];
#pragma unroll
        for (int d = 0; d < 4; ++d) zw[d] = zn[d];
    }
#if defined(NA_STAMP)
    st2_ = __builtin_amdgcn_s_memrealtime();
#endif
    { bf16_t* cp = P.CAT + pend_tok * 1024 + 512 + h * 64 + 4 * g;
#pragma unroll
      for (int d = 0; d < 4; ++d) *reinterpret_cast<u32x2*>(cp + 16 * d) = pend[d]; }
#if !defined(MK_NA_NOENDBAR)
    asm volatile("s_waitcnt vmcnt(0) lgkmcnt(0)\n\ts_barrier" ::: "memory");
#endif
#if defined(NA_STAMP)
    if (blockIdx.x == 17 && wave_id == 0 && mk_lane() == 0) { const unsigned long long st3_ = __builtin_amdgcn_s_memrealtime();
        const unsigned long long dv_ = NA_STAMP == 1 ? st1_ - st0_ : NA_STAMP == 2 ? st2_ - st1_ : NA_STAMP == 3 ? st3_ - st2_ : st3_ - st0_;
        const_cast<float*>(P.rpbg)[4000] = (float)((int)(((double)dv_ + NA_STAMPOFF) / 200.0) * 200 * 40); }
#endif
#undef NA_DMA_ROW
}
}

#ifndef MK_ALIGN3
#define MK_ALIGN3 true
#endif
#ifndef MK_ALIGN4
#define MK_ALIGN4 true
#endif
constexpr int NWAVES = 8;
#ifndef MK_N_LAUNCHES
#define MK_N_LAUNCHES 1
#endif
constexpr int N_LAUNCHES = MK_N_LAUNCHES;
constexpr int PER_PHASE = 5;
constexpr int BATCH = 8, SEQ = 2048, D = 1024, M = BATCH * SEQ, DIN = 4096, PLE = 256;
constexpr size_t MiB = 1u << 20;
constexpr size_t WS_CTL = 0, CTL_ZERO_BYTES = 64 * 1024;
#if defined(MK_WSMAP) && MK_WSMAP == 1
constexpr size_t WS_BUF = 2 * MiB, WS_CAT = 130 * MiB, WS_PP = 162 * MiB, WS_XN = 194 * MiB, WS_PB = 226 * MiB;
constexpr size_t WS_WIN = 234 * MiB, WS_WOUT = 242 * MiB, WS_WG = 244 * MiB, WS_WP = 246 * MiB, WS_END = 247 * MiB;
#elif defined(MK_WSMAP) && MK_WSMAP == 2
constexpr size_t WS_WIN = 1 * MiB, WS_WOUT = 9 * MiB, WS_WG = 11 * MiB, WS_WP = 13 * MiB, WS_PB = 14 * MiB, WS_XN = 22 * MiB;
constexpr size_t WS_PP = 54 * MiB, WS_CAT = 86 * MiB, WS_BUF = 118 * MiB, WS_END = 246 * MiB;
#else
constexpr size_t WS_WIN = 1 * MiB, WS_WOUT = 9 * MiB, WS_WG = 11 * MiB, WS_WP = 13 * MiB;
constexpr size_t WS_PB = 14 * MiB;
constexpr size_t WS_XN = 22 * MiB;
constexpr size_t WS_BUF = 54 * MiB;
constexpr size_t WS_CAT = 182 * MiB;
constexpr size_t WS_PP = 214 * MiB;
constexpr size_t WS_END = 246 * MiB;
#endif
constexpr size_t WS_GAINS = 128 * 1024;
constexpr size_t WS_SCAL = WS_GAINS + 1024, WS_TBLA = WS_GAINS + 4096, WS_RPBG = WS_GAINS + 16384;
constexpr size_t WS_INVRS = 256 * 1024;
constexpr int CW_BAR = 1024;
constexpr int RING_BYTES = 147456;
constexpr int NA_EXTRA = 2048;
constexpr int MISC_OFF = RING_BYTES + NA_EXTRA;
constexpr int LDS_BYTES = MISC_OFF + 256;
static_assert(pg8::STAGE_BYTES <= RING_BYTES && da::LDS_END <= MISC_OFF && na::LDS_END <= MISC_OFF && LDS_BYTES <= 163840, "LDS map");

#define GAS __attribute__((address_space(1)))
#define LAS __attribute__((address_space(3)))
typedef unsigned short bf16;
typedef unsigned v4u __attribute__((ext_vector_type(4)));
typedef float f32x4 __attribute__((ext_vector_type(4)));
#define LDS_WAIT() asm volatile("s_waitcnt lgkmcnt(0)" ::: "memory")
__device__ __forceinline__ unsigned f2bf(float f) { unsigned u = __builtin_bit_cast(unsigned, f); return (u + 0x7fffu + ((u >> 16) & 1u)) >> 16; }
__device__ __forceinline__ unsigned pk2(float lo, float hi) { return f2bf(lo) | (f2bf(hi) << 16); }

#define XB_TMO      128
#define XB_XCNT(j)  (256  + 64 * (j))
#define XB_XSUB(j)  (1280 + 64 * (j))
#define XB_XGEN(j)  (2304 + 64 * (j))
#define XB_TOP      3328
#define XB_TOPGEN   3392
#define XCD_BAR_WORDS 3456
#define XB_SPIN_CAP (1u << 18)
__device__ __forceinline__ unsigned xb_ld(unsigned* p)              { return __hip_atomic_load(p, __ATOMIC_RELAXED, __HIP_MEMORY_SCOPE_AGENT); }
__device__ __forceinline__ unsigned xb_add(unsigned* p, unsigned v) { return __hip_atomic_fetch_add(p, v, __ATOMIC_RELAXED, __HIP_MEMORY_SCOPE_AGENT); }
__device__ __forceinline__ unsigned xb_xcc_id() { return (unsigned)__builtin_amdgcn_s_getreg((3 << 11) | 20) & 0xFu; }
#if defined(MK_SPINFAST)
#define XB_SLEEP() do {} while (0)
#else
#define XB_SLEEP() __builtin_amdgcn_s_sleep(1)
#endif
#define XB_SPIN(cond, bar) do { unsigned _sp = 0; while (cond) { XB_SLEEP(); \
    if ((++_sp & 255u) == 0u) { if (xb_ld(&(bar)[XB_TMO])) break; if (_sp > XB_SPIN_CAP) { atomicAdd(&(bar)[XB_TMO], 1u); break; } } } } while (0)
struct XcdBarrier { unsigned* bar; unsigned x; volatile LAS unsigned* st; };
__device__ __forceinline__ XcdBarrier xcd_barrier_post(unsigned* bar, volatile LAS unsigned* st, const bool leader) {
    XcdBarrier b; b.bar = bar; b.x = xb_xcc_id(); b.st = st;
    if (leader) (void)xb_add(&bar[XB_XCNT(b.x)], 1u);
    return b;
}
__device__ __forceinline__ void xcd_barrier_complete(unsigned* bar, unsigned x, unsigned& nloc, unsigned& nx) {
    const unsigned G = gridDim.x * gridDim.y * gridDim.z;
    unsigned sum, cnt, mine, sp = 0u;
    for (;;) {
        sum = 0u; cnt = 0u; mine = 0u;
#pragma unroll
        for (unsigned j = 0; j < 16; ++j) { const unsigned c = xb_ld(&bar[XB_XCNT(j)]); sum += c; cnt += (c > 0u) ? 1u : 0u; mine = (j == x) ? c : mine; }
        if (sum == G) break;
        __builtin_amdgcn_s_sleep(1);
        if ((++sp & 255u) == 0u) { if (xb_ld(&bar[XB_TMO])) break; if (sp > XB_SPIN_CAP) { atomicAdd(&bar[XB_TMO], 1u); break; } }
    }
    nloc = mine > 0u ? mine : 1u; nx = cnt > 0u ? cnt : 1u;
}
__device__ __forceinline__ void xcd_barrier(const XcdBarrier& b, const bool leader) {
    asm volatile("s_waitcnt vmcnt(0)" ::: "memory");
    __syncthreads();
    if (leader) {
        unsigned* bar = b.bar;
        __builtin_amdgcn_s_waitcnt(0);
        unsigned nloc = b.st[0], nx = b.st[1];
        if (nloc == 0u) { xcd_barrier_complete(bar, b.x, nloc, nx); b.st[0] = nloc; b.st[1] = nx; }
        const unsigned old = xb_add(&bar[XB_XSUB(b.x)], 1u);
        const unsigned gen = old / nloc;
        if (old + 1u == (gen + 1u) * nloc) {
            __builtin_amdgcn_fence(__ATOMIC_RELEASE, "agent");
            asm volatile("s_waitcnt vmcnt(0)" ::: "memory");
            const unsigned og = xb_add(&bar[XB_TOP], 1u);
            const unsigned tg = og / nx;
            if (og + 1u == (tg + 1u) * nx) xb_add(&bar[XB_TOPGEN], 1u);
            else XB_SPIN(xb_ld(&bar[XB_TOPGEN]) == tg, bar);
            __builtin_amdgcn_fence(__ATOMIC_ACQUIRE, "agent");
            xb_add(&bar[XB_XGEN(b.x)], 1u);
            asm volatile("s_waitcnt vmcnt(0)" ::: "memory");
        } else {
            XB_SPIN(xb_ld(&bar[XB_XGEN(b.x)]) == gen, bar);
            __builtin_amdgcn_fence(__ATOMIC_ACQUIRE, "agent");
            asm volatile("s_waitcnt vmcnt(0)" ::: "memory");
        }
    }
    __syncthreads();
}

#define FB_DONE(j) (4096 + 64 * (j))
__device__ __forceinline__ void flat2_barrier(unsigned* bar, volatile LAS unsigned* st, unsigned& gen, const int wave_id, const unsigned x) {
    asm volatile("s_waitcnt vmcnt(0)" ::: "memory");
    __syncthreads();
    ++gen;
    if (wave_id == 0) {
        const int l = mk_lane();
#if defined(MK_ARRIVEFIRST)
        unsigned old_ = 0u; if (l == 0) old_ = xb_add(&bar[XB_XSUB(x)], 1u);
#endif
        if (st[0] == 0u) {
            const unsigned G = gridDim.x; unsigned sp = 0, c = 0;
            for (;;) { c = (l < 16) ? xb_ld(&bar[XB_XCNT(l)]) : 0u; unsigned s = c;
#pragma unroll
                for (int o = 8; o; o >>= 1) s += __shfl_xor(s, o);
                if (__builtin_amdgcn_readfirstlane(s) == G) break;
                __builtin_amdgcn_s_sleep(1);
                if ((++sp & 255u) == 0u) { if (xb_ld(&bar[XB_TMO])) break; if (sp > XB_SPIN_CAP) { if (l == 0) atomicAdd(&bar[XB_TMO], 1u); break; } } }
            if (l < 16) st[16 + l] = c;
            if (l == 0) st[0] = 1u;
            asm volatile("s_waitcnt lgkmcnt(0)" ::: "memory");
        }
        const unsigned cl = (l < 16) ? st[16 + l] : 0u; const unsigned nloc = st[16 + x];
#if defined(MK_ARRIVEFIRST)
        if (l == 0) { const unsigned old = old_;
#else
        if (l == 0) { const unsigned old = xb_add(&bar[XB_XSUB(x)], 1u);
#endif
#if defined(MK_EARLYWB)
            if (old == (gen - 1u) * nloc) asm volatile("buffer_wbl2 sc1" ::: "memory");
#endif
            if (old + 1u == gen * nloc) { __builtin_amdgcn_fence(__ATOMIC_RELEASE, "agent"); asm volatile("s_waitcnt vmcnt(0)" ::: "memory"); (void)xb_add(&bar[FB_DONE(x)], 1u); } }
#if defined(MK_EARLYINV)
        asm volatile("buffer_inv sc1" ::: "memory");
#endif
        unsigned sp = 0;
        for (;;) {
            const unsigned v = (cl > 0u) ? xb_ld(&bar[FB_DONE(l)]) : gen;
            if (__builtin_amdgcn_ballot_w64(v < gen) == 0ull) break;
            __builtin_amdgcn_s_sleep(1);
            if ((++sp & 255u) == 0u) { if (xb_ld(&bar[XB_TMO])) break; if (sp > XB_SPIN_CAP) { if (l == 0) atomicAdd(&bar[XB_TMO], 1u); break; } }
        }
#if defined(MK_EARLYINV)
        asm volatile("s_waitcnt vmcnt(0)" ::: "memory");
#else
        __builtin_amdgcn_fence(__ATOMIC_ACQUIRE, "agent");
#endif
    }
    __syncthreads();
}

#define FB_LOC(j) (8192 + 64 * (j))
__device__ __forceinline__ void local_barrier(unsigned* bar, unsigned& lgen, const int wave_id, const unsigned x, const unsigned nloc, const bool inv_l1 = true) {
    asm volatile("s_waitcnt vmcnt(0)" ::: "memory");
    __syncthreads();
    ++lgen;
    if (wave_id == 0) {
#if defined(MK_EARLYINV)
        if (inv_l1 && mk_lane() == 0) (void)xb_add(&bar[FB_LOC(x)], 1u);
        if (inv_l1) asm volatile("buffer_inv sc1" ::: "memory");
#endif
        if (mk_lane() == 0) {
#if defined(MK_LOCATOM)
            (void)__hip_atomic_fetch_add(&bar[FB_LOC(x)], 1u, __ATOMIC_RELAXED, __HIP_MEMORY_SCOPE_WORKGROUP);
            const unsigned target = lgen * nloc;
            XB_SPIN(__hip_atomic_fetch_add(&bar[FB_LOC(x)], 0u, __ATOMIC_RELAXED, __HIP_MEMORY_SCOPE_WORKGROUP) < target, bar);
#else
#if defined(MK_EARLYINV)
            if (!inv_l1)
#endif
            (void)xb_add(&bar[FB_LOC(x)], 1u);
            const unsigned target = lgen * nloc;
            XB_SPIN(xb_ld(&bar[FB_LOC(x)]) < target, bar);
#endif
        }
#if defined(MK_EARLYINV)
        asm volatile("s_waitcnt vmcnt(0)" ::: "memory");
#else
        if (inv_l1) { __builtin_amdgcn_fence(__ATOMIC_ACQUIRE, "agent"); asm volatile("s_waitcnt vmcnt(0)" ::: "memory"); }
#endif
    }
    __syncthreads();
}

template <class F>
__device__ __forceinline__ void local_barrier_pre(unsigned* bar, unsigned& lgen, const int wave_id, const unsigned x, const unsigned nloc, const bool inv_l1, F&& pre) {
    asm volatile("s_waitcnt vmcnt(0)" ::: "memory");
    __syncthreads();
    ++lgen;
    if (wave_id == 0) {
        if (mk_lane() == 0) (void)xb_add(&bar[FB_LOC(x)], 1u);
        if (inv_l1) asm volatile("buffer_inv sc1" ::: "memory");
        pre();
        if (mk_lane() == 0) { const unsigned target = lgen * nloc; XB_SPIN(xb_ld(&bar[FB_LOC(x)]) < target, bar); }
        asm volatile("s_waitcnt vmcnt(0)" ::: "memory");
    } else pre();
    __syncthreads();
}

#define FB_CNT(j) (4096 + 64 * (j))
__device__ __forceinline__ void flat_barrier(unsigned* bar, unsigned& gen, const int wave_id, const int bx, const unsigned per) {
    asm volatile("s_waitcnt vmcnt(0)" ::: "memory");
    __syncthreads();
    ++gen;
    if (wave_id == 0) {
        const int l = mk_lane();
        const unsigned target = gen * per;
        if (l == 0) { __builtin_amdgcn_fence(__ATOMIC_RELEASE, "agent"); (void)xb_add(&bar[FB_CNT(bx & 7)], 1u); }
        unsigned sp = 0;
        for (;;) {
            const unsigned v = (l < 8) ? xb_ld(&bar[FB_CNT(l)]) : target;
            if (__builtin_amdgcn_ballot_w64(v < target) == 0ull) break;
            __builtin_amdgcn_s_sleep(1);
            if ((++sp & 255u) == 0u) { if (xb_ld(&bar[XB_TMO])) break; if (sp > XB_SPIN_CAP) { if (l == 0) atomicAdd(&bar[XB_TMO], 1u); break; } }
        }
        __builtin_amdgcn_fence(__ATOMIC_ACQUIRE, "agent");
    }
    __syncthreads();
}

__device__ __forceinline__ float wave_sum_f(float v) {
#pragma unroll
    for (int o = 1; o < 64; o <<= 1) v += __shfl_xor(v, o);
    return v;
}
__device__ __forceinline__ float wave_max_f(float v) {
#pragma unroll
    for (int o = 1; o < 64; o <<= 1) v = fmaxf(v, __shfl_xor(v, o));
    return v;
}
template <bool PERMW>
__device__ __forceinline__ void p0_transpose_item64(const float* W, int K, int N, bf16* WT, LAS float* scr, int item, int lane, const float* rowscale = nullptr) {
    const int nblk = N / 64, kb = item / nblk, nb = item % nblk, k0 = 64 * kb, n0 = 64 * nb;
    const int kr = lane >> 4, col = (lane & 15) * 4;
    f32x4 wv[16];
#pragma unroll
    for (int i = 0; i < 16; ++i) wv[i] = __builtin_nontemporal_load((const GAS f32x4*)&W[(size_t)(k0 + 4 * i + kr) * N + n0 + col]);
#pragma unroll
    for (int i = 0; i < 16; ++i) { f32x4 v = wv[i]; if (rowscale) v *= rowscale[k0 + 4 * i + kr];
        LAS float* d = scr + (4 * i + kr) * 66 + col;
        typedef float f32x2_ __attribute__((ext_vector_type(2)));
        *(LAS f32x2_*)d = (f32x2_){v.x, v.y}; *(LAS f32x2_*)(d + 2) = (f32x2_){v.z, v.w}; }
    LDS_WAIT(); asm volatile("" ::: "memory");
    const int c = lane & 7;
#pragma unroll
    for (int j = 0; j < 8; ++j) { const int n = (lane >> 3) + 8 * j; const LAS float* s = scr + (8 * c) * 66 + n;
        v4u o; o.x = pk2(s[0 * 66], s[1 * 66]); o.y = pk2(s[2 * 66], s[3 * 66]); o.z = pk2(s[4 * 66], s[5 * 66]); o.w = pk2(s[6 * 66], s[7 * 66]);
        int row = n0 + n;
        if (PERMW) { const int l = row & 255; row = (row & ~255) + 128 * ((l >> 5) & 1) + 32 * (l >> 6) + (l & 31); }
#if defined(MK_P0NT)
        __builtin_nontemporal_store(o, (GAS v4u*)(WT + (size_t)row * K + k0 + 8 * c)); }
#else
        *(GAS v4u*)(WT + (size_t)row * K + k0 + 8 * c) = o; }
#endif
    LDS_WAIT(); asm volatile("" ::: "memory");
}
template <bool PERMW>
__device__ __forceinline__ void p0_transpose_item(const float* W, int K, int N, bf16* WT, LAS float* scr, int item, int lane, const float* rowscale = nullptr) {
    const int nblk = N / 32, kb = item / nblk, nb = item % nblk, k0 = 64 * kb, n0 = 32 * nb;
    int r0 = n0;
    if (PERMW) { const int l = n0 & 255, wc = l >> 6, bj = (l >> 5) & 1; int tb = n0 & ~255;
#if defined(MK_TBAL)
        if (tb >= 12 * 256) tb ^= 2 * 256;
#endif
        r0 = tb + 128 * bj + 32 * wc; }
    float wv[32];
#pragma unroll
    for (int i = 0; i < 32; ++i) { const int kk = 2 * i + (lane >> 5); wv[i] = __builtin_nontemporal_load(&W[(size_t)(k0 + kk) * N + n0 + (lane & 31)]); }
#pragma unroll
    for (int i = 0; i < 32; ++i) { const int kk = 2 * i + (lane >> 5); scr[kk * 33 + (lane & 31)] = rowscale ? wv[i] * rowscale[k0 + kk] : wv[i]; }
    LDS_WAIT(); asm volatile("" ::: "memory");
    const int c = lane & 7;
#pragma unroll
    for (int j = 0; j < 4; ++j) { const int n = (lane >> 3) + 8 * j; const LAS float* s = scr + (8 * c) * 33 + n;
        v4u o; o.x = pk2(s[0 * 33], s[1 * 33]); o.y = pk2(s[2 * 33], s[3 * 33]); o.z = pk2(s[4 * 33], s[5 * 33]); o.w = pk2(s[6 * 33], s[7 * 33]);
        *(GAS v4u*)(WT + (size_t)(r0 + n) * K + k0 + 8 * c) = o; }
    LDS_WAIT(); asm volatile("" ::: "memory");
}
template <int NR>
__device__ __forceinline__ void rms_rows_to_bf16(const float* x, const float* g, bf16* xn, int m0, int stride, int lane, float* inv = nullptr) {
    const GAS f32x4* gr = (const GAS f32x4*)g + lane;
    f32x4 v[NR][4];
#pragma unroll
    for (int r = 0; r < NR; ++r) { const GAS f32x4* xr = (const GAS f32x4*)(x + (size_t)(m0 + r * stride) * D) + lane;
#pragma unroll
        for (int j = 0; j < 4; ++j) v[r][j] = __builtin_nontemporal_load(&xr[64 * j]); }
    f32x4 gg[4];
#pragma unroll
    for (int j = 0; j < 4; ++j) gg[j] = gr[64 * j];
#pragma unroll
    for (int r = 0; r < NR; ++r) { float s = 0.f;
#pragma unroll
        for (int j = 0; j < 4; ++j) s += (v[r][j].x * v[r][j].x + v[r][j].y * v[r][j].y) + (v[r][j].z * v[r][j].z + v[r][j].w * v[r][j].w);
        const float ms_ = wave_sum_f(s) * (1.f / D) + 1e-6f;
        const float rstd = rsqrtf(ms_);
#if defined(MK_XNP)
        if (lane == 0) inv[m0 + r * stride] = sqrtf(ms_);
#endif
        GAS unsigned long long* o8 = (GAS unsigned long long*)(xn + (size_t)(m0 + r * stride) * D) + lane;
#pragma unroll
        for (int j = 0; j < 4; ++j)
#if defined(MK_XNP) && defined(MK_XN_SC1)
            { const unsigned long long val_ = (unsigned long long)pk2(v[r][j].x * rstd, v[r][j].y * rstd) | ((unsigned long long)pk2(v[r][j].z * rstd, v[r][j].w * rstd) << 32);
              asm volatile("global_store_dwordx2 %0, %1, off sc1" :: "v"(&o8[64 * j]), "v"(val_) : "memory"); } }
#elif defined(MK_XNP) && defined(MK_XN_NT)
            __builtin_nontemporal_store((unsigned long long)pk2(v[r][j].x * rstd, v[r][j].y * rstd) | ((unsigned long long)pk2(v[r][j].z * rstd, v[r][j].w * rstd) << 32), &o8[64 * j]); }
#elif defined(MK_XNP)
            o8[64 * j] = (unsigned long long)pk2(v[r][j].x * rstd, v[r][j].y * rstd) | ((unsigned long long)pk2(v[r][j].z * rstd, v[r][j].w * rstd) << 32); }
#else
            o8[64 * j] = (unsigned long long)pk2(v[r][j].x * rstd * gg[j].x, v[r][j].y * rstd * gg[j].y) | ((unsigned long long)pk2(v[r][j].z * rstd * gg[j].z, v[r][j].w * rstd * gg[j].w) << 32); }
#endif
}

template <int NR>
__device__ __forceinline__ void rms_load(const float* x, int m0, int stride, int lane, f32x4 (&v)[NR][4]) {
#pragma unroll
    for (int r = 0; r < NR; ++r) { const GAS f32x4* xr = (const GAS f32x4*)(x + (size_t)(m0 + r * stride) * D) + lane;
#pragma unroll
        for (int j = 0; j < 4; ++j) v[r][j] = __builtin_nontemporal_load(&xr[64 * j]); }
}
template <int NR>
__device__ __forceinline__ void rms_finish(const f32x4 (&v)[NR][4], const float* g, bf16* xn, int m0, int stride, int lane, float* inv) {
#if !defined(MK_XNP)
    const GAS f32x4* gr = (const GAS f32x4*)g + lane;
    f32x4 gg[4];
#pragma unroll
    for (int j = 0; j < 4; ++j) gg[j] = gr[64 * j];
#endif
#pragma unroll
    for (int r = 0; r < NR; ++r) { float s = 0.f;
#pragma unroll
        for (int j = 0; j < 4; ++j) s += (v[r][j].x * v[r][j].x + v[r][j].y * v[r][j].y) + (v[r][j].z * v[r][j].z + v[r][j].w * v[r][j].w);
        const float ms_ = wave_sum_f(s) * (1.f / D) + 1e-6f;
        const float rstd = rsqrtf(ms_);
#if defined(MK_XNP)
        if (lane == 0) inv[m0 + r * stride] = sqrtf(ms_);
#endif
        GAS unsigned long long* o8 = (GAS unsigned long long*)(xn + (size_t)(m0 + r * stride) * D) + lane;
#pragma unroll
        for (int j = 0; j < 4; ++j)
#if defined(MK_XNP)
            o8[64 * j] = (unsigned long long)pk2(v[r][j].x * rstd, v[r][j].y * rstd) | ((unsigned long long)pk2(v[r][j].z * rstd, v[r][j].w * rstd) << 32);
#else
            o8[64 * j] = (unsigned long long)pk2(v[r][j].x * rstd * gg[j].x, v[r][j].y * rstd * gg[j].y) | ((unsigned long long)pk2(v[r][j].z * rstd * gg[j].z, v[r][j].w * rstd * gg[j].w) << 32);
#endif
    }
}

__device__ __forceinline__ void l2_prefetch_tile(const void* base, size_t pitch, int row_bytes, int tid, unsigned dump_lds) {
    const int lines_per_row = row_bytes / 128, nlines = 256 * lines_per_row;
    const unsigned dst = (unsigned)__builtin_amdgcn_readfirstlane(dump_lds + (unsigned)(tid >> 6) * 1024u);
    for (int i = tid; i < nlines; i += NWAVES * 64) { const int r = i / lines_per_row, c = i % lines_per_row;
        na::glds16((const char*)base + (size_t)r * pitch + (size_t)c * 128, dst); }
}

struct Args { const float* in[18]; float* out; unsigned char* ws; int ph_lo, ph_hi, li, pad; };

__global__ void __launch_bounds__(NWAVES * 64, 2) mk_fwd(Args args) {
    extern __shared__ __attribute__((aligned(16))) unsigned char lds[];
    const int wave = __builtin_amdgcn_readfirstlane((int)threadIdx.x >> 6);
#define tid (wave * 64 + mk_lane())
#define lane (mk_lane())
#define leader_ (wave == 0 && mk_lane() == 0)
    const int G = gridDim.x; const int bx = blockIdx.x; const int vcu = (G % 8 == 0) ? (bx % 8) * (G / 8) + bx / 8 : bx;
    unsigned char* ws = args.ws;
    volatile LAS unsigned* MISC = (volatile LAS unsigned*)((LAS unsigned char*)lds + MISC_OFF);
    for (int u = tid; u < (LDS_BYTES - MISC_OFF) / 4; u += NWAVES * 64) MISC[u] = 0u;
#if !defined(MK_LATEREG)
    __syncthreads();
#endif
    XcdBarrier bar; bar.bar = (unsigned*)(ws + WS_CTL) + CW_BAR; bar.x = 0; bar.st = nullptr;
#if defined(MK_FLATBAR) && MK_FLATBAR == 2
    unsigned fb_gen = 0;
#if defined(MK_XLOCAL)
    unsigned xl_gen = 0; int xl_rank = 0; unsigned xl_rankv = 0;
    if (N_LAUNCHES != PER_PHASE) { bar.x = xb_xcc_id(); bar.st = MISC + 8;
#if defined(MK_LATEREG)
        if (leader_) xl_rankv = xb_add(&bar.bar[XB_XCNT(bar.x)], 1u); }
#else
        if (leader_) MISC[4] = xb_add(&bar.bar[XB_XCNT(bar.x)], 1u);
        __syncthreads(); xl_rank = __builtin_amdgcn_readfirstlane((int)MISC[4]); }
#endif
#else
    if (N_LAUNCHES != PER_PHASE) bar = xcd_barrier_post((unsigned*)(ws + WS_CTL) + CW_BAR, MISC + 8, leader_);
#endif
#define GRID_BARRIER() flat2_barrier((unsigned*)(ws + WS_CTL) + CW_BAR, MISC + 16, fb_gen, wave, bar.x)
#elif defined(MK_FLATBAR)
    unsigned fb_gen = 0; const unsigned fb_per = (unsigned)G / 8u;
#define GRID_BARRIER() flat_barrier((unsigned*)(ws + WS_CTL) + CW_BAR, fb_gen, wave, bx, fb_per)
#else
    if (N_LAUNCHES != PER_PHASE) bar = xcd_barrier_post((unsigned*)(ws + WS_CTL) + CW_BAR, MISC + 8, leader_);
#define GRID_BARRIER() xcd_barrier(bar, leader_)
#endif
    const int lo = args.ph_lo, hi = args.ph_hi;
#ifdef MK_ONLY_PHASE
#define IN(k) ((k) == MK_ONLY_PHASE && lo <= (k) && (k) < hi)
#else
#define IN(k) (lo <= (k) && (k) < hi)
#endif
#define BOTH(k) (IN(k) && IN((k) + 1))
    const float* x = args.in[0]; const float* p = args.in[1]; const float* norm_g = args.in[2]; const float* w_in = args.in[3]; const float* w_out = args.in[4];
    const float* w_gate = args.in[16]; const float* w_proj = args.in[17];
    bf16* Win_t = (bf16*)(ws + WS_WIN); bf16* Wout_t = (bf16*)(ws + WS_WOUT); bf16* Wg_t = (bf16*)(ws + WS_WG); bf16* Wp_t = (bf16*)(ws + WS_WP);
    bf16* PB = (bf16*)(ws + WS_PB); bf16* XN = (bf16*)(ws + WS_XN); bf16* BUF = (bf16*)(ws + WS_BUF); bf16* CAT = (bf16*)(ws + WS_CAT); bf16* PP = (bf16*)(ws + WS_PP);
    constexpr size_t BS = (size_t)M * 512;

#ifndef MK_REP0
#define MK_REP0 1
#endif
#ifndef MK_REP1
#define MK_REP1 1
#endif
#ifndef MK_REPDA
#define MK_REPDA 1
#endif
#ifndef MK_REPNA
#define MK_REPNA 1
#endif
#ifndef MK_REP3
#define MK_REP3 1
#endif
    if (IN(0)) {
      for (int rep_ = 0; rep_ < MK_REP0; ++rep_) {
        LAS float* scr = (LAS float*)((LAS unsigned char*)lds + wave * 16384);
        const int gw = vcu * NWAVES + wave, NGW = G * NWAVES;
        constexpr int I_IN = (D / 64) * (DIN / 32), I_SQ = (D / 64) * (D / 32), I_P = (PLE / 64) * (D / 32);
        constexpr int NITEMS = I_IN + 2 * I_SQ + I_P;
#ifndef MK_REP0W
#define MK_REP0W 1
#endif
#ifndef MK_REP0R
#define MK_REP0R 1
#endif
#if defined(MK_P0OVL)
        f32x4 xv0_[4][4], pv0_[4];
#pragma unroll
        for (int r = 0; r < 4; ++r) pv0_[r] = __builtin_nontemporal_load((const GAS f32x4*)(p + (size_t)(gw + r * NGW) * PLE) + lane);
        rms_load<4>(x, gw, NGW, lane, xv0_);
#endif
#if defined(MK_P0T64) && defined(MK_P0SPREAD)
#define P0_TASKW(k) (NGW - 1 - 8 * (k))
#else
#define P0_TASKW(k) (k)
#endif
#if defined(MK_P0T64)
        { LAS float* scr64 = (LAS float*)((LAS unsigned char*)lds + wave * 16896);
          constexpr int J_IN = (D / 64) * (DIN / 64), J_SQ = (D / 64) * (D / 64), J_P = (PLE / 64) * (D / 64), NJ = J_IN + 2 * J_SQ + J_P;
#if defined(MK_P0EVEN)
          for (int it = wave * G + vcu; it < NJ; it += NGW) { int r = it;
#else
          for (int it = gw; it < NJ; it += NGW) { int r = it;
#endif
#if defined(MK_XNP)
              if (r < J_IN) { p0_transpose_item64<true>(w_in, D, DIN, Win_t, scr64, r, lane, norm_g); continue; }
#else
              if (r < J_IN) { p0_transpose_item64<true>(w_in, D, DIN, Win_t, scr64, r, lane); continue; }
#endif
              r -= J_IN;
              if (r < J_SQ) { p0_transpose_item64<false>(w_out, D, D, Wout_t, scr64, r, lane); continue; } r -= J_SQ;
              if (r < J_SQ) { p0_transpose_item64<false>(w_gate, D, D, Wg_t, scr64, r, lane); continue; } r -= J_SQ;
              p0_transpose_item64<false>(w_proj, PLE, D, Wp_t, scr64, r, lane); } }
#else
        for (int rw_ = 0; rw_ < MK_REP0W; ++rw_)
        for (int it = gw; it < NITEMS; it += NGW) {
            int r = it;
            #if defined(MK_XNP)
            if (r < I_IN) { p0_transpose_item<true>(w_in, D, DIN, Win_t, scr, r, lane, norm_g); continue; }
#else
            if (r < I_IN) { p0_transpose_item<true>(w_in, D, DIN, Win_t, scr, r, lane); continue; }
#endif
            r -= I_IN;
            if (r < I_SQ) { p0_transpose_item<false>(w_out, D, D, Wout_t, scr, r, lane); continue; } r -= I_SQ;
            if (r < I_SQ) { p0_transpose_item<false>(w_gate, D, D, Wg_t, scr, r, lane); continue; } r -= I_SQ;
            p0_transpose_item<false>(w_proj, PLE, D, Wp_t, scr, r, lane);
        }
#endif
#if defined(MK_P0T64) && defined(MK_P0SPREAD) && MK_P0SPREAD == 2
        { constexpr int NJ_ = (D / 64) * (DIN / 64) + 2 * (D / 64) * (D / 64) + (PLE / 64) * (D / 64);
#if defined(MK_P0EVEN)
          const int iw = (wave == NWAVES - 1) ? vcu : -1;
#else
          const int iw = gw - NJ_;
#endif
          const float L2E = 1.4426950408889634f;
          static_assert(NJ_ + 106 <= 256 * NWAVES, "idle waves for the table tasks");
          if (iw >= 0 && iw < 32) { float* TB = (float*)(ws + WS_TBLA); const int i = iw * 64 + lane, h = i >> 9, idx = i & 511; TB[i] = args.in[12][da::t5_bucket(idx - 255) * 4 + h] * L2E; }
          else if (iw >= 32 && iw < 92) { float* RB = (float*)(ws + WS_RPBG); const int i = (iw - 32) * 64 + lane, h = i / 480, r = i % 480, dr = r >> 5, dc = r & 31; RB[i] = dc < 31 ? args.in[15][(h * 15 + dr) * 31 + dc] * L2E : 0.f; }
          else if (iw == 92) { float* GN = (float*)(ws + WS_GAINS); const float qs = 0.125f * L2E;
              GN[lane] = args.in[5][lane] * qs; GN[64 + lane] = args.in[6][lane]; GN[128 + lane] = args.in[13][lane] * qs; GN[192 + lane] = args.in[14][lane]; }
          else if (iw == 93) { float* SC = (float*)(ws + WS_SCAL);
              const float lam = __expf(wave_sum_f(args.in[7][lane] * args.in[8][lane])) - __expf(wave_sum_f(args.in[9][lane] * args.in[10][lane])) + 0.2f;
              if (lane == 0) SC[0] = lam; }
          else if (iw >= 94 && iw < 98) { float* SC = (float*)(ws + WS_SCAL); const int h = iw - 94;
              const float ga = wave_max_f(fabsf(args.in[5][lane])) * wave_max_f(fabsf(args.in[6][lane]));
              const float tm = wave_max_f(fabsf(args.in[12][(lane & 31) * 4 + h]));
              const float MB = fminf(8.0f * L2E * ga * 1.01f + tm * L2E + 0.1f, 64.0f);
              if (lane == 0) { SC[4 + h] = MB; SC[8 + h] = args.in[12][15 * 4 + h] * L2E; SC[12 + h] = args.in[12][31 * 4 + h] * L2E; } }
          else if (iw >= 98 && iw < 106) { float* SC = (float*)(ws + WS_SCAL); const int h = iw - 98;
              const float gb = wave_max_f(fabsf(args.in[13][lane])) * wave_max_f(fabsf(args.in[14][lane]));
              float bm = 0.f; for (int i = lane; i < 465; i += 64) bm = fmaxf(bm, fabsf(args.in[15][h * 465 + i])); bm = wave_max_f(bm);
              if (lane == 0) SC[16 + h] = fminf(8.0f * L2E * gb * 1.01f + bm * L2E + 0.1f, 64.0f); } }
#else
        if (gw == P0_TASKW(0)) { float* GN = (float*)(ws + WS_GAINS); const float qs = 0.125f * 1.4426950408889634f;
            GN[lane] = args.in[5][lane] * qs; GN[64 + lane] = args.in[6][lane]; GN[128 + lane] = args.in[13][lane] * qs; GN[192 + lane] = args.in[14][lane]; }
        if (gw == P0_TASKW(1)) {
            const float L2E = 1.4426950408889634f; float* SC = (float*)(ws + WS_SCAL);
            const float lam = __expf(wave_sum_f(args.in[7][lane] * args.in[8][lane])) - __expf(wave_sum_f(args.in[9][lane] * args.in[10][lane])) + 0.2f;
            const float ga = wave_max_f(fabsf(args.in[5][lane])) * wave_max_f(fabsf(args.in[6][lane])), gb = wave_max_f(fabsf(args.in[13][lane])) * wave_max_f(fabsf(args.in[14][lane]));
            if (lane == 0) SC[0] = lam;
            for (int h = 0; h < 4; ++h) { const float tm = wave_max_f(fabsf(args.in[12][(lane & 31) * 4 + h]));
                const float MB = fminf(8.0f * L2E * ga * 1.01f + tm * L2E + 0.1f, 64.0f);
                if (lane == 0) { SC[4 + h] = MB; SC[8 + h] = args.in[12][15 * 4 + h] * L2E; SC[12 + h] = args.in[12][31 * 4 + h] * L2E; } }
            for (int h = 0; h < 8; ++h) { float bm = 0.f; for (int i = lane; i < 465; i += 64) bm = fmaxf(bm, fabsf(args.in[15][h * 465 + i])); bm = wave_max_f(bm);
                if (lane == 0) SC[16 + h] = fminf(8.0f * L2E * gb * 1.01f + bm * L2E + 0.1f, 64.0f); }
        }
        if (gw == P0_TASKW(2)) { float* TB = (float*)(ws + WS_TBLA);
            for (int i = lane; i < 2048; i += 64) { const int h = i >> 9, idx = i & 511; TB[i] = args.in[12][da::t5_bucket(idx - 255) * 4 + h] * 1.4426950408889634f; } }
        if (gw == P0_TASKW(3)) { float* RB = (float*)(ws + WS_RPBG);
            for (int i = lane; i < 8 * 480; i += 64) { const int h = i / 480, r = i % 480, dr = r >> 5, dc = r & 31; RB[i] = dc < 31 ? args.in[15][(h * 15 + dr) * 31 + dc] * 1.4426950408889634f : 0.f; } }
#endif
#if defined(MK_P0LOCAL)
        for (int it_ = 0; it_ < 2; ++it_) { const int m = (M / NGW) * gw + 4 * it_; constexpr int RS = 1;
#else
#ifndef MK_P0ROWS
#define MK_P0ROWS 4
#endif
#if defined(MK_P0OVL)
        rms_finish<4>(xv0_, norm_g, XN, gw, NGW, lane, (float*)(ws + WS_INVRS));
#pragma unroll
        for (int r = 0; r < 4; ++r) *((GAS unsigned long long*)(PB + (size_t)(gw + r * NGW) * PLE) + lane) = (unsigned long long)pk2(pv0_[r].x, pv0_[r].y) | ((unsigned long long)pk2(pv0_[r].z, pv0_[r].w) << 32);
        for (int m = gw + 4 * NGW; m < M; m += MK_P0ROWS * NGW) { constexpr int RS = 0;
#else
        for (int rr_ = 0; rr_ < MK_REP0R; ++rr_)
        for (int m = gw; m < M; m += MK_P0ROWS * NGW) { constexpr int RS = 0;
#endif
#endif
            const int rs_ = RS ? 1 : NGW;
            f32x4 pv[MK_P0ROWS];
#pragma unroll
            for (int r = 0; r < MK_P0ROWS; ++r) pv[r] = __builtin_nontemporal_load((const GAS f32x4*)(p + (size_t)(m + r * rs_) * PLE) + lane);
            rms_rows_to_bf16<MK_P0ROWS>(x, norm_g, XN, m, rs_, lane, (float*)(ws + WS_INVRS));
#pragma unroll
#if defined(MK_P0NT)
            for (int r = 0; r < MK_P0ROWS; ++r) __builtin_nontemporal_store((unsigned long long)pk2(pv[r].x, pv[r].y) | ((unsigned long long)pk2(pv[r].z, pv[r].w) << 32), (GAS unsigned long long*)(PB + (size_t)(m + r * rs_) * PLE) + lane);
#else
            for (int r = 0; r < MK_P0ROWS; ++r) *((GAS unsigned long long*)(PB + (size_t)(m + r * rs_) * PLE) + lane) = (unsigned long long)pk2(pv[r].x, pv[r].y) | ((unsigned long long)pk2(pv[r].z, pv[r].w) << 32);
#endif
        }
      }
#if defined(MK_LATEREG) && defined(MK_XLOCAL)
        if (BOTH(0)) { if (leader_) MISC[4] = xl_rankv; GRID_BARRIER(); xl_rank = __builtin_amdgcn_readfirstlane((int)MISC[4]); }
#else
        if (BOTH(0)) GRID_BARRIER();
#endif
    }
    int vbx = bx; bool xl = false;
#if defined(MK_XLOCAL)
    if (fb_gen > 0u) { const int l_ = mk_lane(); const unsigned c_ = (l_ < 16) ? MISC[16 + 16 + l_] : 0u;
        const bool ok_ = (l_ >= 16) || (l_ < 8 ? c_ == (unsigned)G / 8u : c_ == 0u);
#if defined(MK_FORCE_FALLBACK)
        xl = false;
#else
        xl = (G % 8 == 0) && (__builtin_amdgcn_ballot_w64(!ok_) == 0ull) && bar.x < 8u;
#endif
        if (xl) vbx = xl_rank * 8 + (int)bar.x; }
#define PHASE_BARRIER() do { if (xl) local_barrier((unsigned*)(ws + WS_CTL) + CW_BAR, xl_gen, wave, bar.x, (unsigned)G / 8u); else GRID_BARRIER(); } while (0)
#if defined(MK_NOINV23)
#define PHASE_BARRIER_FT() do { if (xl) local_barrier((unsigned*)(ws + WS_CTL) + CW_BAR, xl_gen, wave, bar.x, (unsigned)G / 8u, false); else GRID_BARRIER(); } while (0)
#else
#define PHASE_BARRIER_FT() PHASE_BARRIER()
#endif
#else
#define PHASE_BARRIER() GRID_BARRIER()
#define PHASE_BARRIER_FT() GRID_BARRIER()
#endif
    const int vcu2 = (G % 8 == 0) ? (vbx % 8) * (G / 8) + vbx / 8 : vbx;
#if defined(MK_KROT)
#define KROT(K_) ((2 * (vbx % 8) * MK_KROT) % ((K_) / 64))
#else
#define KROT(K_) 0
#endif
#if defined(MK_CLKPROBE)
    unsigned long long pc0_ = 0, pr0_ = 0, pc1_ = 0, pr1_ = 0;
#define CLK_BEGIN(k) do { if (MK_CLKPROBE == (k)) { pc0_ = __builtin_amdgcn_s_memtime(); pr0_ = __builtin_amdgcn_s_memrealtime(); } } while (0)
#define CLK_END(k) do { if (MK_CLKPROBE == (k)) { pc1_ = __builtin_amdgcn_s_memtime(); pr1_ = __builtin_amdgcn_s_memrealtime(); } } while (0)
#else
#define CLK_BEGIN(k) do {} while (0)
#define CLK_END(k) do {} while (0)
#endif
#if defined(MK_PP_STAGGER) && MK_PP_STAGGER == 5
    const bool pp_late_ = ((vbx % 8) & 1) != 0;
#else
    const bool pp_late_ = false;
#endif
    if (IN(1)) {
#if defined(MK_P1SKEW)
#if defined(MK_P1SKEWX)
        { const int dsteps_ = ((vbx % 8) >> 1) * MK_P1SKEW; for (int i_ = 0; i_ < dsteps_; ++i_) __builtin_amdgcn_s_sleep(8); }
#else
        { const int dsteps_ = ((vbx / 8) & 3) * MK_P1SKEW; for (int i_ = 0; i_ < dsteps_; ++i_) __builtin_amdgcn_s_sleep(8); }
#endif
#endif
#if defined(MK_P1MERGE)
        { pg8::Gemm g{XN, Win_t, M, DIN, D}; pg8::Gemm ga{PB, Wp_t, M, D, PLE}; pg8::P1Order S; S.init(M, DIN, D, G, vbx, ((vbx % 8) & 1) == 0);
          pg8::EpiP1 E{pg8::EpiProj{BUF, (const float*)(ws + WS_GAINS)}, pg8::EpiBf16Plain{PP, D}};
          pg8::gemm_phase2<pg8::EpiP1, pg8::P1Order>((LAS unsigned char*)lds, g, ga, S, E, wave); }
        if (BOTH(1)) PHASE_BARRIER_FT();
    }
    if (false) {
#endif
#if defined(MK_P1LOOP)
        { const bool pp_first_ = ((vbx % 8) & 1) == 0;
#pragma nounroll
          for (int s_ = 0; s_ < 2; ++s_) { int sv_ = s_; asm volatile("" : "+s"(sv_));
              if ((sv_ == 0) == pp_first_) { pg8::Gemm g{PB, Wp_t, M, D, PLE, KROT(PLE)}; pg8::StaticOrder S; S.init(M, D, G, vbx);
                  pg8::EpiBf16Plain E{PP, D};
                  pg8::gemm_phase<pg8::EpiBf16Plain, pg8::StaticOrder, true, true>((LAS unsigned char*)lds, g, S, E, wave); }
              else { pg8::Gemm g{XN, Win_t, M, DIN, D, KROT(D)}; pg8::StaticOrder S; S.init(M, DIN, G, vbx);
                  pg8::EpiProj E{BUF, (const float*)(ws + WS_GAINS)};
                  pg8::gemm_phase<pg8::EpiProj, pg8::StaticOrder, true, true>((LAS unsigned char*)lds, g, S, E, wave); } } }
        if (BOTH(1)) PHASE_BARRIER_FT();
    }
    if (false) {
#endif
#if defined(MK_PP_FIRST)
        { pg8::Gemm g{PB, Wp_t, M, D, PLE, KROT(PLE)}; pg8::StaticOrder S; S.init(M, D, G, vbx);
          pg8::EpiBf16Plain E{PP, D};
          pg8::gemm_phase<pg8::EpiBf16Plain, pg8::StaticOrder, true, true>((LAS unsigned char*)lds, g, S, E, wave); }
#elif defined(MK_PP_STAGGER)
#if MK_PP_STAGGER == 2
        const bool pp_first_ = ((vbx / 8) & 1) == 0;
#elif MK_PP_STAGGER == 3
        const bool pp_first_ = ((vbx / 8) & 16) == 0;
#elif MK_PP_STAGGER == 4
        const bool pp_first_ = ((((vbx / 8) >> 3) ^ (vbx % 8)) & 1) == 0;
#elif MK_PP_STAGGER == 8
        const bool pp_first_ = (((vbx / 8) ^ (vbx % 8)) & 1) == 0;
#elif MK_PP_STAGGER == 6
        const bool pp_first_ = ((vbx % 8) & 4) == 0;
#elif MK_PP_STAGGER == 7
        const bool pp_first_ = ((vbx % 8) & 2) == 0;
#else
        const bool pp_first_ = ((vbx % 8) & 1) == 0;
#endif
        if (pp_first_)
        { pg8::Gemm g{PB, Wp_t, M, D, PLE, KROT(PLE)}; pg8::StaticOrder S; S.init(M, D, G, vbx);
          pg8::EpiBf16Plain E{PP, D};
          pg8::gemm_phase<pg8::EpiBf16Plain, pg8::StaticOrder, true, true>((LAS unsigned char*)lds, g, S, E, wave); }
#endif
        CLK_BEGIN(1);
#if defined(MK_PNROT)
        { pg8::Gemm g{XN, Win_t, M, DIN, D, KROT(D)}; pg8::StaticOrder S; S.init(M, DIN, G, vbx, ((vbx % 8) * MK_PNROT) % (DIN / 256));
#define P1ORDER pg8::StaticOrder
#else
#if defined(MK_DUPMAIN) && MK_DUPMAIN == 1
        { pg8::Gemm g{XN, Win_t, M, DIN, D, KROT(D)}; pg8::DupOrder S; S.init(M, DIN, G, vbx);
#define P1ORDER pg8::DupOrder
#else
        { pg8::Gemm g{XN, Win_t, M, DIN, D, KROT(D)}; pg8::StaticOrder S; S.init(M, DIN, G, vbx);
#define P1ORDER pg8::StaticOrder
#endif
#endif
#if defined(MK_GAINS_LDS)
          { if (tid < 256) ((LAS float*)((LAS unsigned char*)lds + 131072))[tid] = ((const float*)(ws + WS_GAINS))[tid]; __syncthreads(); }
          pg8::EpiProj E{BUF, (const float*)(ws + WS_GAINS), (const LAS float*)((LAS unsigned char*)lds + 131072)};
#else
          pg8::EpiProj E{BUF, (const float*)(ws + WS_GAINS)};
#endif
#if defined(MK_P1_NOALIGN)
          pg8::gemm_phase<pg8::EpiProj, P1ORDER, false, true>((LAS unsigned char*)lds, g, S, E, wave); }
#else
          pg8::gemm_phase<pg8::EpiProj, P1ORDER, true, true>((LAS unsigned char*)lds, g, S, E, wave); }
#endif
        CLK_END(1);
#if MK_REP1 == 2
        { pg8::Gemm g{XN, Win_t, M, DIN, D, KROT(D)}; pg8::StaticOrder S; S.init(M, DIN, G, vbx);
          pg8::EpiProj E{BUF, (const float*)(ws + WS_GAINS)};
          pg8::gemm_phase<pg8::EpiProj, pg8::StaticOrder, true, true>((LAS unsigned char*)lds, g, S, E, wave); }
#endif
#if defined(MK_PP_STAGGER)
        if (!pp_first_ && !pp_late_)
        { pg8::Gemm g{PB, Wp_t, M, D, PLE, KROT(PLE)}; pg8::StaticOrder S; S.init(M, D, G, vbx);
          pg8::EpiBf16Plain E{PP, D};
          pg8::gemm_phase<pg8::EpiBf16Plain, pg8::StaticOrder, true, true>((LAS unsigned char*)lds, g, S, E, wave); }
#elif !defined(MK_PP_FIRST)
        { pg8::Gemm g{PB, Wp_t, M, D, PLE, KROT(PLE)}; pg8::StaticOrder S; S.init(M, D, G, vbx);
          pg8::EpiBf16Plain E{PP, D};
          pg8::gemm_phase<pg8::EpiBf16Plain, pg8::StaticOrder, true, true>((LAS unsigned char*)lds, g, S, E, wave); }
#endif
#if MK_REP1 == 3
        { pg8::Gemm g{PB, Wp_t, M, D, PLE, KROT(PLE)}; pg8::StaticOrder S; S.init(M, D, G, vbx);
          pg8::EpiBf16Plain E{PP, D};
          pg8::gemm_phase<pg8::EpiBf16Plain, pg8::StaticOrder, true, true>((LAS unsigned char*)lds, g, S, E, wave); }
#endif
        if (BOTH(1)) PHASE_BARRIER_FT();
    }
    if (IN(2)) {
#if defined(MK_P2MIX)
        { da::Params PD{BUF, BUF + BS, BUF + 2 * BS, BUF + 3 * BS, (const float*)(ws + WS_SCAL), (const float*)(ws + WS_TBLA), args.in[11], CAT};
          na::Params PN{BUF + 4 * BS, BUF + 5 * BS, BUF + 6 * BS, BUF + 7 * BS, (const float*)(ws + WS_RPBG), CAT};
          const int slot_na = (G == 256) ? (MK_P2MIX == 7 ? 2 : MK_P2MIX == 8 ? (((vbx % 8) & 1) ? 0 : 2) : MK_P2MIX == 9 ? (((vbx % 8) & 2) ? 0 : 2) : MK_P2MIX == 2 ? (vcu2 & 1) * 2 : (vcu2 % MK_P2MIX) % 3) : 2;
          for (int s = 0; s < 3; ++s) {
              if (s == slot_na) { const int uidx = vcu2; if (uidx < 256) { const int bh = uidx >> 2, seg = uidx & 3; na::unit(PN, bh >> 3, bh & 7, seg, (char*)lds, wave); } }
              else { const int i = s < slot_na ? s : s - 1; const int uidx = (G == 256) ? (vcu2 >> 5) * 64 + i * 32 + (vcu2 & 31) : i * G + vcu2;
                  if (uidx < 512) { const int bh = uidx >> 4, qb = uidx & 15; da::unit(PD, bh >> 2, bh & 3, qb, (char*)lds, wave); } } } }
#elif defined(MK_NA_FIRST)
#ifndef MK_SKIP_NA
        { na::Params P{BUF + 4 * BS, BUF + 5 * BS, BUF + 6 * BS, BUF + 7 * BS, (const float*)(ws + WS_RPBG), CAT};
          for (int rep_ = 0; rep_ < MK_REPNA; ++rep_) for (int uidx = vcu2; uidx < 256; uidx += G) { const int bh = uidx >> 2, seg = uidx & 3; na::unit(P, bh >> 3, bh & 7, seg, (char*)lds, wave); } }
#endif
#ifndef MK_SKIP_DA
        CLK_BEGIN(2);
        { da::Params P{BUF, BUF + BS, BUF + 2 * BS, BUF + 3 * BS, (const float*)(ws + WS_SCAL), (const float*)(ws + WS_TBLA), args.in[11], CAT};
#if !defined(MK_DA_UNIT2)
          for (int rep_ = 0; rep_ < MK_REPDA; ++rep_) for (int i = 0; i < 2; ++i) { const int uidx = (G == 256) ? (vcu2 >> 5) * 64 + i * 32 + (vcu2 & 31) : i * G + vcu2; if (uidx >= 512) break; const int bh = uidx >> 4, qb = uidx & 15;     da::unit(P, bh >> 2, bh & 3, qb, (char*)lds, wave); } }
#else
          static_assert(WS_CAT - WS_BUF == da::U2_CAT && WS_TBLA - WS_SCAL == 768 * 4, "unit2 derives every tensor from one base");
          const da::Params2 P2{(const char*)(ws + WS_BUF), (const float*)(ws + WS_SCAL), args.in[11]};
          for (int rep_ = 0; rep_ < MK_REPDA; ++rep_) for (int uidx = vcu2; uidx < 256; uidx += G) { const int bh = uidx >> 3, qb = uidx & 7; da::unit2(P2, bh >> 2, bh & 3, qb, (char*)lds, wave); } }
#endif
        CLK_END(2);
#endif
#else
#if defined(MK_NASTAG)
        const bool na_first_ = (((vbx % 8) >> MK_NASTAG) & 1) != 0;
        if (na_first_)
        { na::Params P{BUF + 4 * BS, BUF + 5 * BS, BUF + 6 * BS, BUF + 7 * BS, (const float*)(ws + WS_RPBG), CAT};
          for (int rep_ = 0; rep_ < MK_REPNA; ++rep_) for (int uidx = vcu2; uidx < 256; uidx += G) { const int bh = uidx >> 2, seg = uidx & 3; na::unit(P, bh >> 3, bh & 7, seg, (char*)lds, wave); } }
#endif
#ifndef MK_SKIP_DA
        CLK_BEGIN(2);
        { da::Params P{BUF, BUF + BS, BUF + 2 * BS, BUF + 3 * BS, (const float*)(ws + WS_SCAL), (const float*)(ws + WS_TBLA), args.in[11], CAT};
#if !defined(MK_DA_UNIT2)
          for (int rep_ = 0; rep_ < MK_REPDA; ++rep_) for (int i = 0; i < 2; ++i) { const int uidx = (G == 256) ? (vcu2 >> 5) * 64 + i * 32 + (vcu2 & 31) : i * G + vcu2; if (uidx >= 512) break; const int bh = uidx >> 4, qb = uidx & 15;     da::unit(P, bh >> 2, bh & 3, qb, (char*)lds, wave); } }
#else
          static_assert(WS_CAT - WS_BUF == da::U2_CAT && WS_TBLA - WS_SCAL == 768 * 4, "unit2 derives every tensor from one base");
          const da::Params2 P2{(const char*)(ws + WS_BUF), (const float*)(ws + WS_SCAL), args.in[11]};
          for (int rep_ = 0; rep_ < MK_REPDA; ++rep_) for (int uidx = vcu2; uidx < 256; uidx += G) { const int bh = uidx >> 3, qb = uidx & 7; da::unit2(P2, bh >> 2, bh & 3, qb, (char*)lds, wave); } }
#endif
        CLK_END(2);
#endif
#if defined(MK_NASTAG)
        if (!na_first_)
#endif
#ifndef MK_SKIP_NA
        { na::Params P{BUF + 4 * BS, BUF + 5 * BS, BUF + 6 * BS, BUF + 7 * BS, (const float*)(ws + WS_RPBG), CAT};
#if defined(MK_NA_NOLOOP) && MK_REPNA == 1
          { const int uidx = vcu2 & 255; const int bh = uidx >> 2, seg = uidx & 3; na::unit(P, bh >> 3, bh & 7, seg, (char*)lds, wave); }
#else
          for (int rep_ = 0; rep_ < MK_REPNA; ++rep_) for (int uidx = vcu2; uidx < 256; uidx += G) { const int bh = uidx >> 2, seg = uidx & 3; na::unit(P, bh >> 3, bh & 7, seg, (char*)lds, wave); }
#endif
        }
#endif
#endif
#if defined(MK_WPREF)
        unsigned wpf3_ = 0;
        if (xl && BOTH(2)) { const char* wp_ = (const char*)Wout_t + (size_t)(vbx >> 3) * 65536 + (size_t)tid * 128; asm volatile("global_load_dword %0, %1, off" : "=v"(wpf3_) : "v"(wp_) : "memory"); }
#endif
#if defined(MK_PREB)
        if (BOTH(2) && xl) { pg8::Gemm gp_{CAT, Wout_t, M, D, D, KROT(D)}; pg8::StaticOrder Sp_; Sp_.init(M, D, G, vbx);
            local_barrier_pre((unsigned*)(ws + WS_CTL) + CW_BAR, xl_gen, wave, bar.x, (unsigned)G / 8u, false, [&]() { pg8::gemm_preissue_b<pg8::EpiX1, pg8::StaticOrder>((LAS unsigned char*)lds, gp_, Sp_, wave); }); }
        else
#endif
        if (BOTH(2)) PHASE_BARRIER_FT();
#if defined(MK_WPREF)
        asm volatile("s_waitcnt vmcnt(0)" : "+v"(wpf3_) :: "memory");
#endif
    }
    if (IN(3)) {
      for (int rep_ = 0; rep_ < MK_REP3; ++rep_) {
#if defined(MK_DUPMAIN) && MK_DUPMAIN == 3
        pg8::Gemm g{CAT, Wout_t, M, D, D, KROT(D)}; pg8::DupOrder S; S.init(M, D, G, vbx);
#define P3ORDER pg8::DupOrder
#else
        pg8::Gemm g{CAT, Wout_t, M, D, D, KROT(D)}; pg8::StaticOrder S; S.init(M, D, G, vbx);
#define P3ORDER pg8::StaticOrder
#endif
#if defined(MK_L2PF)
        { pg8::Unit u0; if (S.next(0, u0)) l2_prefetch_tile(x + (size_t)u0.pm * 256 * D + u0.pn * 256, (size_t)D * 4, 1024, tid, (unsigned)(uintptr_t)lds + 131072u); }
#endif
        pg8::EpiX1 E{x, args.out, XN, (const float*)(ws + WS_INVRS)};
#if defined(MK_PREB)
        pg8::gemm_phase<pg8::EpiX1, P3ORDER, MK_ALIGN3, true>((LAS unsigned char*)lds, g, S, E, wave, BOTH(2) && xl);
#else
        pg8::gemm_phase<pg8::EpiX1, P3ORDER, MK_ALIGN3, true>((LAS unsigned char*)lds, g, S, E, wave);
#endif
      }
#if defined(MK_WPREF)
        unsigned wpf4_ = 0;
        if (xl && BOTH(3)) { const char* wp_ = (const char*)Wg_t + (size_t)(vbx >> 3) * 65536 + (size_t)tid * 128; asm volatile("global_load_dword %0, %1, off" : "=v"(wpf4_) : "v"(wp_) : "memory"); }
#endif
#if defined(MK_PREB)
        if (BOTH(3) && xl) { pg8::Gemm gp_{XN, Wg_t, M, D, D, KROT(D)}; pg8::StaticOrder Sp_; Sp_.init(M, D, G, vbx);
            local_barrier_pre((unsigned*)(ws + WS_CTL) + CW_BAR, xl_gen, wave, bar.x, (unsigned)G / 8u, true, [&]() { pg8::gemm_preissue_b<pg8::EpiFinal, pg8::StaticOrder>((LAS unsigned char*)lds, gp_, Sp_, wave); }); }
        else
#endif
        if (BOTH(3)) PHASE_BARRIER();
#if defined(MK_WPREF)
        asm volatile("s_waitcnt vmcnt(0)" : "+v"(wpf4_) :: "memory");
#endif
    }
#ifndef MK_REP4
#define MK_REP4 1
#endif
#ifndef MK_XBAR
#define MK_XBAR 0
#endif
    if (IN(4)) {
      for (int xb_ = 0; xb_ < MK_XBAR; ++xb_) GRID_BARRIER();
#if defined(MK_PP_STAGGER) && MK_PP_STAGGER == 5
        if (pp_late_)
        { pg8::Gemm g{PB, Wp_t, M, D, PLE, KROT(PLE)}; pg8::StaticOrder S; S.init(M, D, G, vbx);
          pg8::EpiBf16Plain E{PP, D};
          pg8::gemm_phase<pg8::EpiBf16Plain, pg8::StaticOrder, true, true>((LAS unsigned char*)lds, g, S, E, wave); }
#endif
      for (int rep_ = 0; rep_ < MK_REP4; ++rep_) {
#if defined(MK_DUPMAIN) && MK_DUPMAIN == 4
        pg8::Gemm g{XN, Wg_t, M, D, D, KROT(D)}; pg8::DupOrder S; S.init(M, D, G, vbx);
#define P4ORDER pg8::DupOrder
#else
        pg8::Gemm g{XN, Wg_t, M, D, D, KROT(D)}; pg8::StaticOrder S; S.init(M, D, G, vbx);
#if defined(MK_P4KEND)
        { pg8::Unit u0_; if (S.next(0, u0_)) g.k0 = (4 * u0_.pn + 4) & 15; }
#endif
#define P4ORDER pg8::StaticOrder
#endif
#if defined(MK_L2PF)
        { pg8::Unit u0; if (S.next(0, u0)) l2_prefetch_tile(PP + (size_t)u0.pm * 256 * D + u0.pn * 256, (size_t)D * 2, 512, tid, (unsigned)(uintptr_t)lds + 131072u); }
#endif
        pg8::EpiFinal E{args.out, PP, XN};
#if defined(MK_PREB)
        pg8::gemm_phase<pg8::EpiFinal, P4ORDER, MK_ALIGN4, true>((LAS unsigned char*)lds, g, S, E, wave, BOTH(3) && xl);
#else
        pg8::gemm_phase<pg8::EpiFinal, P4ORDER, MK_ALIGN4, true>((LAS unsigned char*)lds, g, S, E, wave);
#endif
      }
    }
#if defined(NA_STAMP)
    if (bx == 17 && tid == 0) { __builtin_amdgcn_s_sleep(127); __builtin_amdgcn_s_sleep(127); asm volatile("s_waitcnt vmcnt(0)" ::: "memory"); args.out[0] = ((const float*)(ws + WS_RPBG))[4000]; }
#endif
#if defined(DA_STAMP)
    if (bx == 17 && tid == 0) { __builtin_amdgcn_s_sleep(127); __builtin_amdgcn_s_sleep(127); asm volatile("s_waitcnt vmcnt(0)" ::: "memory"); args.out[0] = ((const float*)(ws + WS_SCAL))[100 + DA_STAMPSEL]; }
#endif
#if defined(MK_CLKPROBE)
    if (bx == 17 && tid == 0) { const double ghz = (double)(pc1_ - pc0_) / (double)(pr1_ - pr0_) * 0.1;
        __builtin_amdgcn_s_sleep(127); asm volatile("s_waitcnt vmcnt(0)" ::: "memory");
#if MK_CLKVAL == 0
        args.out[0] = (float)((double)(int)(ghz * 5.0 + 0.5) * 2000.0);
#else
        args.out[0] = (float)((double)(pr1_ - pr0_) * 10.0);
#endif
    }
#endif
#undef GRID_BARRIER
#undef PHASE_BARRIER
#undef PHASE_BARRIER_FT
#undef IN
#undef BOTH
#undef tid
#undef lane
#undef leader_
}

#if defined(MK_NAIVE_ATTN)
namespace dbg {
typedef __hip_bfloat16 hb;
__device__ __forceinline__ float tof(hb v) { return __bfloat162float(v); }
__device__ __forceinline__ float wsum(float v) {
#pragma unroll
  for (int o = 32; o; o >>= 1) v += __shfl_xor(v, o);
  return v;
}
__device__ __forceinline__ float wmax(float v) {
#pragma unroll
  for (int o = 32; o; o >>= 1) v = fmaxf(v, __shfl_xor(v, o));
  return v;
}
__device__ __forceinline__ int t5b(int rel) {
  int ret = rel > 0 ? 16 : 0; int n = rel < 0 ? -rel : rel; int v;
  if (n < 8) v = n; else { float nf = (float)n; int large = 8 + (int)(logf(nf / 8.f) / 2.772588722239781f * 8.f); v = large < 15 ? large : 15; }
  return ret + v;
}
constexpr int S = 2048;
constexpr float QKS = 0.6931471805599453f;
__global__ __launch_bounds__(128) void k_diffattn(const hb* __restrict__ QA, const hb* __restrict__ KA, const hb* __restrict__ VA, const hb* __restrict__ ZA,
                                                  const float* __restrict__ t5, const float* __restrict__ lq1, const float* __restrict__ lk1, const float* __restrict__ lq2,
                                                  const float* __restrict__ lk2, const float* __restrict__ subg, hb* __restrict__ CAT) {
  __shared__ float a_s[2][2048];
  __shared__ float b_s[2][2048];
  __shared__ float q_s[2][128];
  const int w = threadIdx.x >> 6, lane = threadIdx.x & 63;
  const int task = blockIdx.x * 2 + w;
  const int q = task % S, h = (task / S) % 4, b = task / (S * 4);
  const float lam = __expf(wsum(lq1[lane] * lk1[lane])) - __expf(wsum(lq2[lane] * lk2[lane])) + 0.2f;
  const size_t tok = (size_t)b * S + q;
  q_s[w][lane] = tof(QA[tok * 512 + h * 128 + lane]);
  q_s[w][64 + lane] = tof(QA[tok * 512 + h * 128 + 64 + lane]);
  __syncthreads();
  float m1 = -1e30f, m2 = -1e30f;
  for (int i = 0; i < 32; ++i) {
    const int k = lane + 64 * i;
    const hb* kr = KA + ((size_t)b * S + k) * 512 + h * 128;
    float d1 = 0.f, d2 = 0.f;
    for (int d = 0; d < 64; ++d) { d1 += q_s[w][d] * tof(kr[d]); d2 += q_s[w][64 + d] * tof(kr[64 + d]); }
    const float bias = t5[t5b(k - q) * 4 + h];
    d1 = d1 * QKS + bias; d2 = d2 * QKS + bias;
    a_s[w][k] = d1; b_s[w][k] = d2;
    m1 = fmaxf(m1, d1); m2 = fmaxf(m2, d2);
  }
  m1 = wmax(m1); m2 = wmax(m2);
  float l1 = 0.f, l2 = 0.f;
  for (int i = 0; i < 32; ++i) {
    const int k = lane + 64 * i;
    const float e1 = __expf(a_s[w][k] - m1); a_s[w][k] = e1; l1 += e1;
    const float e2 = __expf(b_s[w][k] - m2); b_s[w][k] = e2; l2 += e2;
  }
  l1 = wsum(l1); l2 = wsum(l2);
  const float i1 = 1.f / l1, i2 = lam / l2;
  for (int i = 0; i < 32; ++i) { const int k = lane + 64 * i; a_s[w][k] = a_s[w][k] * i1 - b_s[w][k] * i2; }
  __syncthreads();
  float o0 = 0.f, o1 = 0.f;
  const hb* vb = VA + (size_t)b * S * 512 + h * 128;
  for (int k = 0; k < S; ++k) { const float a = a_s[w][k]; o0 += a * tof(vb[(size_t)k * 512 + lane]); o1 += a * tof(vb[(size_t)k * 512 + 64 + lane]); }
  const float ss = wsum(o0 * o0 + o1 * o1);
  const float r = rsqrtf(ss / 128.f + 1e-6f) * 0.8f;
  const float y0 = o0 * r * subg[lane] * tof(ZA[tok * 512 + h * 128 + lane]);
  const float y1 = o1 * r * subg[64 + lane] * tof(ZA[tok * 512 + h * 128 + 64 + lane]);
  CAT[tok * 1024 + h * 128 + lane] = __float2bfloat16(y0);
  CAT[tok * 1024 + h * 128 + 64 + lane] = __float2bfloat16(y1);
}
__global__ __launch_bounds__(256) void k_na(const hb* __restrict__ QB, const hb* __restrict__ KB, const hb* __restrict__ VB, const hb* __restrict__ ZB,
                                            const float* __restrict__ rpb, hb* __restrict__ CAT) {
  __shared__ float q_s[4][64];
  const int w = threadIdx.x >> 6, lane = threadIdx.x & 63;
  const int task = blockIdx.x * 4 + w;
  const int h = task & 7, tokl = task >> 3;
  const int b = tokl / S, s = tokl % S, r = s >> 6, c = s & 63;
  const int rs = min(max(r - 4, 0), 24), cs = min(max(c - 8, 0), 48);
  q_s[w][lane] = tof(QB[(size_t)tokl * 512 + h * 64 + lane]);
  __syncthreads();
  float sc[2]; int ktok[2];
#pragma unroll
  for (int t = 0; t < 2; ++t) {
    const int idx = lane + 64 * t, i = idx >> 4, j = idx & 15;
    const int krow = rs + i, kcol = cs + j;
    ktok[t] = b * S + krow * 64 + kcol;
    const hb* kr = KB + (size_t)ktok[t] * 512 + h * 64;
    float d = 0.f;
    for (int e = 0; e < 64; ++e) d += q_s[w][e] * tof(kr[e]);
    int dc = kcol - c; dc = min(max(dc, -15), 15) + 15;
    sc[t] = d * QKS + rpb[(h * 15 + (krow - r + 7)) * 31 + dc];
  }
  const float mx = wmax(fmaxf(sc[0], sc[1]));
  const float p0 = __expf(sc[0] - mx), p1 = __expf(sc[1] - mx);
  const float l = wsum(p0 + p1);
  float o = 0.f;
  for (int idx = 0; idx < 128; ++idx) {
    const float pp_ = __shfl(idx < 64 ? p0 : p1, idx & 63);
    const int kt = __shfl(idx < 64 ? ktok[0] : ktok[1], idx & 63);
    o += pp_ * tof(VB[(size_t)kt * 512 + h * 64 + lane]);
  }
  const float y = o / l * tof(ZB[(size_t)tokl * 512 + h * 64 + lane]);
  CAT[(size_t)tokl * 1024 + 512 + h * 64 + lane] = __float2bfloat16(y);
}
}
#endif

extern "C" void kernel_launch(void* const* d_in, const int* in_sizes, int n_in, void* d_out, int out_size, void* d_ws, size_t ws_size, hipStream_t stream) {
    static int grid = 0;
    if (grid == 0) {
        if (n_in != 18 || in_sizes[0] != M * D || out_size != M * D || ws_size < WS_END) { fprintf(stderr, "kernel_launch: unexpected shapes (n_in %d, in0 %d, out %d, ws %zu); nothing launched\n", n_in, n_in > 0 ? in_sizes[0] : -1, out_size, ws_size); grid = -1; return; }
        int dev = 0, cus = 0, per_cu = 0;
        if (hipGetDevice(&dev) != hipSuccess || hipDeviceGetAttribute(&cus, hipDeviceAttributeMultiprocessorCount, dev) != hipSuccess) { fprintf(stderr, "kernel_launch: device query failed\n"); grid = -1; return; }
        if (hipFuncSetAttribute((const void*)mk_fwd, hipFuncAttributeMaxDynamicSharedMemorySize, LDS_BYTES) != hipSuccess) { fprintf(stderr, "kernel_launch: hipFuncSetAttribute failed\n"); grid = -1; return; }
        if (hipOccupancyMaxActiveBlocksPerMultiprocessor(&per_cu, (const void*)mk_fwd, NWAVES * 64, LDS_BYTES) != hipSuccess || per_cu < 1) fprintf(stderr, "kernel_launch: note: occupancy query reports %d blocks per CU\n", per_cu);
        (void)hipGetLastError();
        if (cus != 256) { fprintf(stderr, "kernel_launch: built for a 256-CU device (the phase programs deal 256-row tiles to 256 workgroups); found %d; nothing launched\n", cus); grid = -1; return; }
        grid = cus;
    }
    if (grid < 0) return;
    if (hipMemsetAsync((char*)d_ws + WS_CTL, 0, CTL_ZERO_BYTES, stream) != hipSuccess) { fprintf(stderr, "kernel_launch: memset failed\n"); return; }
    Args a{};
    for (int i = 0; i < 18; ++i) a.in[i] = (const float*)d_in[i];
    a.out = (float*)d_out; a.ws = (unsigned char*)d_ws;
#if MK_N_LAUNCHES == 1
    a.ph_lo = 0; a.ph_hi = PER_PHASE; a.li = 0;
    hipLaunchKernelGGL(mk_fwd, dim3(grid), dim3(NWAVES * 64), LDS_BYTES, stream, a);
#if defined(MK_TWICE)
    (void)hipMemsetAsync((char*)d_ws + WS_CTL, 0, CTL_ZERO_BYTES, stream);
    hipLaunchKernelGGL(mk_fwd, dim3(grid), dim3(NWAVES * 64), LDS_BYTES, stream, a);
#endif
#else
    for (int ph = 0; ph < PER_PHASE; ++ph) {
        a.ph_lo = ph; a.ph_hi = ph + 1; a.li = ph;
        hipLaunchKernelGGL(mk_fwd, dim3(grid), dim3(NWAVES * 64), LDS_BYTES, stream, a);
#if defined(MK_NAIVE_ATTN)
        if (ph == 2) {
            typedef dbg::hb hb; hb* BUFh = (hb*)((char*)d_ws + WS_BUF); hb* CATh = (hb*)((char*)d_ws + WS_CAT); const size_t BS = (size_t)M * 512;
            if (MK_NAIVE_ATTN & 1) dbg::k_diffattn<<<BATCH * 4 * SEQ / 2, 128, 0, stream>>>(BUFh, BUFh + BS, BUFh + 2 * BS, BUFh + 3 * BS, (const float*)d_in[12], (const float*)d_in[7], (const float*)d_in[8], (const float*)d_in[9], (const float*)d_in[10], (const float*)d_in[11], CATh);
            if (MK_NAIVE_ATTN & 2) dbg::k_na<<<M * 8 / 4, 256, 0, stream>>>(BUFh + 4 * BS, BUFh + 5 * BS, BUFh + 6 * BS, BUFh + 7 * BS, (const float*)d_in[15], CATh);
        }
#endif
    }
#endif
    const hipError_t le = hipPeekAtLastError();
    if (le != hipSuccess) fprintf(stderr, "kernel_launch: launch failed: %s (grid %d)\n", hipGetErrorName(le), grid);
}
```
